# Optimizing an MI355X kernel written in HIP

```python
import math
import jax, jax.numpy as jnp
from jax import lax
import numpy as np

D_MODEL = 2048
BATCH = 1
SEQ = 16384
DEPTH = 1

GLA_HEADS = 4
GLA_DK = 128
GLA_DV = 256
GLA_RANK = 16
GLA_TAU = 16.0
GLA_CHUNK = 64
DIFF_HEADS = 4
DIFF_DQK = 128
DIFF_DV = 2 * DIFF_DQK
Q_BLOCK = 128
D_FF = 5632
CONV_W = 3
EPS = 1e-6

GLA_QK = GLA_HEADS * GLA_DK
GLA_V = GLA_HEADS * GLA_DV
DIFF_QK = DIFF_HEADS * 2 * DIFF_DQK
DIFF_V = DIFF_HEADS * DIFF_DV
MIX_WIDTH = GLA_V + DIFF_V
IN_SPLITS = (GLA_QK, GLA_QK, GLA_V, GLA_V, GLA_RANK, DIFF_QK, DIFF_QK, DIFF_V)
IN_COLS = sum(IN_SPLITS)

kernel_name = 'hybrid_gla_diffattn_convffn'


def rmsnorm(x, g):
    xf = x.astype(jnp.float32)
    y = xf * lax.rsqrt(jnp.mean(xf * xf, axis=-1, keepdims=True) + EPS)
    return (y * g.astype(jnp.float32)).astype(x.dtype)


def gla_chunked(q, k, v, log_a):
    B, S = q.shape[0], q.shape[1]
    n = S // GLA_CHUNK

    def to_chunks(t):
        t = t.astype(jnp.float32).reshape(B, n, GLA_CHUNK, GLA_HEADS, t.shape[-1])
        return jnp.transpose(t, (1, 0, 3, 2, 4))

    qc = to_chunks(q * (GLA_DK ** -0.5))
    kc, vc, ac = to_chunks(k), to_chunks(v), to_chunks(log_a)
    causal = jnp.tril(jnp.ones((GLA_CHUNK, GLA_CHUNK), dtype=bool))

    def step(state, inp):
        qi, ki, vi, ai = inp
        b = jnp.cumsum(ai, axis=2)
        o_inter = jnp.einsum('bhcd,bhde->bhce', qi * jnp.exp(b), state)
        diff = b[:, :, :, None, :] - b[:, :, None, :, :]
        decay = jnp.exp(jnp.where(causal[:, :, None], diff, -jnp.inf))
        scores = jnp.einsum('bhid,bhjd,bhijd->bhij', qi, ki, decay)
        o_intra = jnp.einsum('bhij,bhje->bhie', scores, vi)
        b_last = b[:, :, -1:, :]
        state = (jnp.exp(b_last[:, :, 0, :])[..., None] * state
                 + jnp.einsum('bhcd,bhce->bhde', ki * jnp.exp(b_last - b), vi))
        return state, o_inter + o_intra

    s0 = jnp.zeros((B, GLA_HEADS, GLA_DK, GLA_DV), jnp.float32)
    _, o = lax.scan(step, s0, (qc, kc, vc, ac))
    return jnp.transpose(o, (1, 0, 3, 2, 4)).reshape(B, S, GLA_HEADS, GLA_DV)


def diff_attention(q, k, v, lam):
    B, S = q.shape[0], q.shape[1]
    nb = S // Q_BLOCK
    slopes = jnp.asarray(2.0 ** (-8.0 * np.arange(1, DIFF_HEADS + 1) / DIFF_HEADS), jnp.float32)
    qb = jnp.transpose(q.reshape(B, nb, Q_BLOCK, DIFF_HEADS, 2, DIFF_DQK), (1, 0, 2, 3, 4, 5))
    k_pos = jnp.arange(S, dtype=jnp.int32)
    scale = DIFF_DQK ** -0.5

    def block(args):
        qi, bi = args
        q_pos = bi * Q_BLOCK + jnp.arange(Q_BLOCK, dtype=jnp.int32)
        dist = q_pos[:, None] - k_pos[None, :]
        bias = -slopes[:, None, None] * dist.astype(jnp.float32)
        s = jnp.einsum('bqhcd,bkhcd->bhcqk', qi, k,
                       preferred_element_type=jnp.float32) * scale + bias[None, :, None]
        s = jnp.where(dist >= 0, s, -jnp.inf)
        p = jax.nn.softmax(s, axis=-1)
        a = p[:, :, 0] - lam * p[:, :, 1]
        return jnp.einsum('bhqk,bkhe->bqhe', a, v.astype(jnp.float32))

    o = lax.map(block, (qb, jnp.arange(nb, dtype=jnp.int32)))
    return jnp.transpose(o, (1, 0, 2, 3, 4)).reshape(B, S, DIFF_HEADS, DIFF_DV)


def token_mixer(h, w_in, w_alpha_up, b_alpha, gla_norm, lambda_q1, lambda_k1,
                lambda_q2, lambda_k2, diff_norm, w_o, lambda_init):
    B, S, _ = h.shape
    proj = h @ w_in
    offs = np.cumsum((0,) + IN_SPLITS)
    gq, gk, gv, gg, ga, dq, dk, dv = [proj[..., int(offs[i]):int(offs[i + 1])]
                                      for i in range(len(IN_SPLITS))]
    log_a = jax.nn.log_sigmoid((ga @ w_alpha_up + b_alpha).astype(jnp.float32)) / GLA_TAU
    o_a = gla_chunked(gq.reshape(B, S, GLA_HEADS, GLA_DK), gk.reshape(B, S, GLA_HEADS, GLA_DK),
                      gv.reshape(B, S, GLA_HEADS, GLA_DV), log_a.reshape(B, S, GLA_HEADS, GLA_DK))
    gate = jax.nn.silu(gg.astype(jnp.float32)).reshape(B, S, GLA_HEADS, GLA_DV)
    o_a = (rmsnorm(o_a, gla_norm) * gate).reshape(B, S, GLA_V)
    f32 = jnp.float32
    lam = (jnp.exp(jnp.sum(lambda_q1.astype(f32) * lambda_k1.astype(f32)))
           - jnp.exp(jnp.sum(lambda_q2.astype(f32) * lambda_k2.astype(f32))) + lambda_init)
    o_b = diff_attention(dq.reshape(B, S, DIFF_HEADS, 2, DIFF_DQK),
                         dk.reshape(B, S, DIFF_HEADS, 2, DIFF_DQK),
                         dv.reshape(B, S, DIFF_HEADS, DIFF_DV), lam)
    o_b = (rmsnorm(o_b, diff_norm) * (1.0 - lambda_init)).reshape(B, S, DIFF_V)
    o = jnp.concatenate([o_a, o_b], axis=-1).astype(h.dtype)
    return o @ w_o


def conv_ffn(h, w_ffn_in, conv_w, conv_b, w_ffn_out):
    S = h.shape[1]
    up = h @ w_ffn_in
    a, b = up[..., :D_FF], up[..., D_FF:]
    a_pad = jnp.pad(a, ((0, 0), (CONV_W - 1, 0), (0, 0)))
    a = (conv_w[0] * a_pad[:, 0:S] + conv_w[1] * a_pad[:, 1:S + 1]
         + conv_w[2] * a_pad[:, 2:S + 2] + conv_b)
    return (jax.nn.gelu(a, approximate=True) * b) @ w_ffn_out


def setup_inputs(seed: int = 0) -> dict:
    key = jax.random.key(seed)
    ks = jax.random.split(key, 20)
    nrm = lambda k, shape: jax.random.normal(k, shape, jnp.float32)
    gain = lambda k, n: 1.0 + 0.1 * nrm(k, (DEPTH, n))
    return {
        'x': nrm(ks[0], (BATCH, SEQ, D_MODEL)),
        'attn_pre_norm': gain(ks[1], D_MODEL),
        'w_in': nrm(ks[2], (DEPTH, D_MODEL, IN_COLS)) * D_MODEL ** -0.5,
        'w_alpha_up': nrm(ks[3], (DEPTH, GLA_RANK, GLA_QK)) * GLA_RANK ** -0.5,
        'b_alpha': 0.1 * nrm(ks[4], (DEPTH, GLA_QK)),
        'gla_norm': gain(ks[5], GLA_DV),
        'lambda_q1': 0.1 * nrm(ks[6], (DEPTH, DIFF_DQK)),
        'lambda_k1': 0.1 * nrm(ks[7], (DEPTH, DIFF_DQK)),
        'lambda_q2': 0.1 * nrm(ks[8], (DEPTH, DIFF_DQK)),
        'lambda_k2': 0.1 * nrm(ks[9], (DEPTH, DIFF_DQK)),
        'diff_norm': gain(ks[10], DIFF_DV),
        'w_o': nrm(ks[11], (DEPTH, MIX_WIDTH, D_MODEL)) * MIX_WIDTH ** -0.5,
        'attn_post_norm': gain(ks[12], D_MODEL),
        'ffn_pre_norm': gain(ks[13], D_MODEL),
        'w_ffn_in': nrm(ks[14], (DEPTH, D_MODEL, 2 * D_FF)) * D_MODEL ** -0.5,
        'conv_w': nrm(ks[15], (DEPTH, CONV_W, D_FF)) * CONV_W ** -0.5,
        'conv_b': 0.02 * nrm(ks[16], (DEPTH, D_FF)),
        'w_ffn_out': nrm(ks[17], (DEPTH, D_FF, D_MODEL)) * D_FF ** -0.5,
        'ffn_post_norm': gain(ks[18], D_MODEL),
    }


def reference(x, attn_pre_norm, w_in, w_alpha_up, b_alpha, gla_norm, lambda_q1, lambda_k1,
              lambda_q2, lambda_k2, diff_norm, w_o, attn_post_norm, ffn_pre_norm, w_ffn_in,
              conv_w, conv_b, w_ffn_out, ffn_post_norm):
    for l in range(DEPTH):
        lambda_init = 0.8 - 0.6 * math.exp(-0.3 * l)
        h = rmsnorm(x, attn_pre_norm[l])
        m = token_mixer(h, w_in[l], w_alpha_up[l], b_alpha[l], gla_norm[l], lambda_q1[l],
                        lambda_k1[l], lambda_q2[l], lambda_k2[l], diff_norm[l], w_o[l], lambda_init)
        x = x + rmsnorm(m, attn_post_norm[l])
        h = rmsnorm(x, ffn_pre_norm[l])
        f = conv_ffn(h, w_ffn_in[l], conv_w[l], conv_b[l], w_ffn_out[l])
        x = x + rmsnorm(f, ffn_post_norm[l])
    return x
```

```cpp
#include <hip/hip_runtime.h>
#include <hip/hip_cooperative_groups.h>
#include <cstdio>
#include <cstdint>
namespace cg = cooperative_groups;

typedef unsigned short bf16_t;
typedef short bf16x8 __attribute__((ext_vector_type(8)));
typedef float f32x2 __attribute__((ext_vector_type(2)));
typedef float f32x4 __attribute__((ext_vector_type(4)));
typedef float f32x16 __attribute__((ext_vector_type(16)));
typedef unsigned u32x2 __attribute__((ext_vector_type(2)));
typedef unsigned u32x4 __attribute__((ext_vector_type(4)));
typedef __bf16 bf2_t __attribute__((ext_vector_type(2)));

#define DI __device__ __forceinline__
#define OPAQUE_TID(t) int t; asm volatile("v_mbcnt_lo_u32_b32 %0, -1, 0\n\tv_mbcnt_hi_u32_b32 %0, -1, %0\n\tv_add_u32 %0, %1, %0" : "=&v"(t) : "s"(g_wave64))
#define LAS __attribute__((address_space(3)))
#define LDSP(p) ((LAS unsigned*)(p))

constexpr int SEQ = 16384, DM = 2048, DFF = 5632, INC = 6160;
#ifndef OVH
#define OVH 6
#endif
#ifndef KR
#define KR 6
#endif
#ifndef VR
#define VR 8
#endif
constexpr int NT = 512;
constexpr int LDS_BYTES = 147456;
constexpr float EPS = 1e-6f;
constexpr float LOG2E = 1.4426950408889634f;

constexpr size_t MB = 1048576;
constexpr size_t WS_BAR = 1 * MB + 768 * 1024, WS_NRM = WS_BAR + 16384, WS_ML = 484 * MB, WS_SA0 = 486 * MB, WS_SB0 = 489 * MB, WS_SAL = 492 * MB, WS_END2 = 495 * MB;
constexpr size_t WS_GA = 0, WS_GDEC = 1 * MB, WS_WFI = 2 * MB, WS_WFO = 46 * MB, WS_H = 68 * MB, WS_R = 132 * MB;
constexpr size_t WS_WIN = WS_R, WS_WV = WS_R + 16 * MB, WS_WO = WS_R + 24 * MB, WS_PROJ = WS_R + 32 * MB, WS_VT = WS_R + 160 * MB,
                 WS_O = WS_R + 224 * MB, WS_PART2 = WS_R + 288 * MB, WS_M = WS_PROJ, WS_AUP = WS_R, WS_BUP = WS_R + 176 * MB, WS_F = WS_R + 96 * MB, WS_END = WS_R + 352 * MB;

struct Params { const float* in[19]; float* out; unsigned char* ws; };

DI unsigned pk_bf16(float lo, float hi) { f32x2 v = {lo, hi}; bf2_t r = __builtin_convertvector(v, bf2_t); return __builtin_bit_cast(unsigned, r); }
DI float bf2f(bf16_t u) { return __uint_as_float(((unsigned)u) << 16); }
DI float bflo(unsigned u) { return __uint_as_float(u << 16); }
DI float bfhi(unsigned u) { return __uint_as_float(u & 0xffff0000u); }
DI f32x16 mfma32(bf16x8 a, bf16x8 b, f32x16 c) { return __builtin_amdgcn_mfma_f32_32x32x16_bf16(a, b, c, 0, 0, 0); }
DI float shx(float v, const int mask, const int lane) { return __builtin_bit_cast(float, __builtin_amdgcn_ds_bpermute((lane ^ mask) << 2, __builtin_bit_cast(int, v))); }
DI float wave_sum_l(float v, const int lane) { for (int o = 32; o > 0; o >>= 1) v += __builtin_bit_cast(float, __builtin_amdgcn_ds_bpermute((lane ^ o) << 2, __builtin_bit_cast(int, v))); return v; }
DI float wave_sum(float v) { for (int o = 32; o > 0; o >>= 1) v += __shfl_xor(v, o); return v; }
DI bf16x8 pack8(float a0, float a1, float a2, float a3, float a4, float a5, float a6, float a7) {
  u32x4 p = {pk_bf16(a0, a1), pk_bf16(a2, a3), pk_bf16(a4, a5), pk_bf16(a6, a7)}; return __builtin_bit_cast(bf16x8, p);
}
DI int perm32(int rho) { const int n = rho >> 4, i = rho & 15; return 8 * (i >> 2) + 4 * n + (i & 3); }
DI float* part_slot(const Params& p, const int slot) { return slot < 256 ? p.out + (size_t)slot * 65536 : (float*)(p.ws + WS_PART2) + (size_t)(slot - 256) * 65536; }
DI int perm23(int r) { return (r & ~12) | ((r & 4) << 1) | ((r & 8) >> 1); }

constexpr int BM = 256, BK = 64, HALF = 128, HT = HALF * BK, NXCD = 8, WGM = 8;
DI int lds_byte(int r, int c) { int st = (r >> 4) * 2 + (c >> 5), rr = r & 15, cc = c & 31, ob = rr * 64 + cc * 2; return st * 1024 + (ob ^ (((ob >> 9) & 1) << 5)); }
DI void stage_rc(int b, int& R, int& C) { int st = b / 1024, sb = b % 1024, swz = sb ^ (((sb >> 9) & 1) << 5); R = (st >> 1) * 16 + swz / 64; C = (st & 1) * 32 + (swz % 64) / 2; }

struct ConvEpi { const float* cw; const float* cb; float* sa0; float* sb0; float* sal; };
template <bool OUT_F32, int M, int N, int K, int ldc, int split_pn, int EPI = 0>
__device__ __forceinline__ void gemm_phase(const bf16_t* __restrict__ A, const bf16_t* __restrict__ Bt, void* out0, void* out1, const int g_wave64, const ConvEpi ce = ConvEpi{}) {
  OPAQUE_TID(tidx);
  extern __shared__ __attribute__((aligned(16))) unsigned char shm_raw[];
  LAS unsigned char* ldsb = (LAS unsigned char*)shm_raw;
#define SA(b, h) (((b) * 2 + (h)) * (HT * 2))
#define SB(b, h) ((4 + (b) * 2 + (h)) * (HT * 2))
#define STAGE(P, BASE, br, kt) do { const char* _gb = (const char*)(BASE) + ((size_t)(br) * K + (size_t)(kt) * BK) * 2; \
      __builtin_amdgcn_global_load_lds((const unsigned*)(_gb + so0), (LAS unsigned*)(ldsb + (P) + ldsw), 16, 0, 0); \
      __builtin_amdgcn_global_load_lds((const unsigned*)(_gb + so1), (LAS unsigned*)(ldsb + (P) + ldsw + 8192), 16, 0, 0); } while (0)
#define STAGEB(P, BASE, br, kt) do { const char* _gb = (const char*)(BASE) + ((size_t)(br) * K + (size_t)(kt) * BK) * 2; \
      __builtin_amdgcn_global_load_lds((const unsigned*)(_gb + sb0), (LAS unsigned*)(ldsb + (P) + ldsw), 16, 0, 0); \
      __builtin_amdgcn_global_load_lds((const unsigned*)(_gb + sb1), (LAS unsigned*)(ldsb + (P) + ldsw + 8192), 16, 0, 0); } while (0)
#define LDA(dst, b, h) _Pragma("unroll") for (int m = 0; m < 4; ++m) _Pragma("unroll") for (int k = 0; k < 2; ++k) \
    dst[m][k] = *(const LAS bf16x8*)(ldsb + SA(b, h) + aoff + m * 2048 + k * 1024)
#define LDB(dst, b, h) _Pragma("unroll") for (int n = 0; n < 2; ++n) _Pragma("unroll") for (int k = 0; k < 2; ++k) \
    dst[n][k] = *(const LAS bf16x8*)(ldsb + SB(b, h) + boff + n * 2048 + k * 1024)
#define MMA(ai, bj, At, Bq) do { __builtin_amdgcn_s_setprio(1); \
    _Pragma("unroll") for (int m = 0; m < 4; ++m) _Pragma("unroll") for (int n = 0; n < 2; ++n) _Pragma("unroll") for (int k = 0; k < 2; ++k) \
      acc[ai][bj][m][n] = __builtin_amdgcn_mfma_f32_16x16x32_bf16(Bq[n][k], At[m][k], acc[ai][bj][m][n], 0, 0, 0); \
    __builtin_amdgcn_s_setprio(0); } while (0)
#define WAIT_V(n) asm volatile("s_waitcnt vmcnt(" #n ")" ::: "memory")
#define WAIT_L(n) asm volatile("s_waitcnt lgkmcnt(" #n ")" ::: "memory")
#define BAR __builtin_amdgcn_s_barrier()
#define SCHED __builtin_amdgcn_sched_barrier(0)
  const int nM = M / BM, nN = N / BM, nwg = nM * nN;
  const int wid = __builtin_amdgcn_readfirstlane(tidx >> 6), lane = tidx & 63, wr = wid >> 2, wc = wid & 3, fr = lane & 15, fq = lane >> 4;
  constexpr int nt = K / BK;
  unsigned so0, so1, sb0, sb1;
  { int _r, _c; stage_rc(tidx * 16, _r, _c); so0 = (unsigned)(_r * K + _c) * 2u; sb0 = (unsigned)(((_r & ~31) + perm32(_r & 31)) * K + _c) * 2u;
    stage_rc(tidx * 16 + 8192, _r, _c); so1 = (unsigned)(_r * K + _c) * 2u; sb1 = (unsigned)(((_r & ~31) + perm32(_r & 31)) * K + _c) * 2u; }
  const unsigned ldsw = (unsigned)wid * 1024u;
  const int aoff = lds_byte(wr * 64 + fr, fq * 8), boff = lds_byte(wc * 32 + fr, fq * 8);
#define UNIT_OF(L, PM, PN) do { int _w = (L); { const int _q = nwg / NXCD, _r = nwg % NXCD, _x = _w % NXCD, _o = _w / NXCD; _w = (_x < _r ? _x * (_q + 1) : _r * (_q + 1) + (_x - _r) * _q) + _o; } \
    const int _nig = WGM * nN, _gid = _w / _nig, _fm = _gid * WGM, _gsz = min(nM - _fm, WGM); PM = _fm + ((_w % _nig) % _gsz); PN = (_w % _nig) / _gsz; } while (0)
  if ((int)blockIdx.x < nwg) {
    int pm, pn; UNIT_OF((int)blockIdx.x, pm, pn);
    int brow = pm * BM, bcol = pn * BM;
    __syncthreads();
    f32x4 acc[2][2][4][2] = {};
    bf16x8 At[4][2], B0[2][2], B1[2][2];
    STAGEB(SB(0, 0), Bt, bcol, 0); STAGEB(SB(0, 1), Bt, bcol + HALF, 0); STAGE(SA(0, 0), A, brow, 0); STAGE(SA(0, 1), A, brow + HALF, 0);
    if (wr == 1) BAR;
    WAIT_V(2); BAR;
    STAGEB(SB(1, 0), Bt, bcol, 1); STAGE(SA(1, 0), A, brow, 1); STAGEB(SB(1, 1), Bt, bcol + HALF, 1);
    WAIT_V(6); BAR;
    for (int it = 0;; ++it) {
      const int Ln = (it + 1) * (int)gridDim.x + (int)blockIdx.x;
      const bool has_next = Ln < nwg;
      int npm = pm, npn = pn; if (has_next) UNIT_OF(Ln, npm, npn);
      const int nbrow = npm * BM, nbcol = npn * BM;
      for (int t = 0; t < nt; t += 2) {
        const bool last = (t == nt - 2);
        const int r2 = last ? nbrow : brow, c2 = last ? nbcol : bcol, k2 = last ? 0 : t + 2, k3 = k2 + 1;
        LDB(B0, 0, 0); LDB(B1, 0, 1); SCHED; LDA(At, 0, 0); STAGE(SA(1, 1), A, brow + HALF, t + 1);
        WAIT_V(8); WAIT_L(0); BAR; MMA(0, 0, At, B0); MMA(0, 1, At, B1); BAR; SCHED;
        LDA(At, 0, 1); STAGEB(SB(0, 0), Bt, c2, k2); STAGEB(SB(0, 1), Bt, c2 + HALF, k2); STAGE(SA(0, 0), A, r2, k2);
        WAIT_V(8); WAIT_L(0); BAR; MMA(1, 0, At, B0); MMA(1, 1, At, B1); BAR; SCHED;
        LDB(B0, 1, 0); LDB(B1, 1, 1); SCHED; LDA(At, 1, 0); STAGE(SA(0, 1), A, r2 + HALF, k2);
        WAIT_V(8); WAIT_L(0); BAR; MMA(0, 0, At, B0); MMA(0, 1, At, B1); BAR; SCHED;
        LDA(At, 1, 1); STAGEB(SB(1, 0), Bt, c2, k3); STAGEB(SB(1, 1), Bt, c2 + HALF, k3); STAGE(SA(1, 0), A, r2, k3);
        WAIT_V(8); WAIT_L(0); BAR; MMA(1, 0, At, B0); MMA(1, 1, At, B1); BAR; SCHED;
      }
      if (wr == 0) BAR;
      if constexpr (EPI == 2) {
        LAS float* halo = (LAS float*)(ldsb + 133120);
        const int cl = wc * 32 + fq * 8;
        if (fr >= 14) {
#pragma unroll
          for (int ai = 0; ai < 2; ++ai) { LAS float* hp = halo + ((ai * 2 + wr) * 2 + (fr - 14)) * 128 + cl; *(LAS f32x4*)hp = acc[ai][0][3][0]; *(LAS f32x4*)(hp + 4) = acc[ai][0][3][1]; }
          if (wr == 1) { float* sp = ce.sal + ((size_t)pm * 2 + (fr - 14)) * DFF + 128 * pn + cl; *(f32x4*)sp = acc[1][0][3][0]; *(f32x4*)(sp + 4) = acc[1][0][3][1]; }
        }
        if (wr == 0 && fr < 2) {
          float* sp = ce.sa0 + ((size_t)pm * 2 + fr) * DFF + 128 * pn + cl; *(f32x4*)sp = acc[0][0][0][0]; *(f32x4*)(sp + 4) = acc[0][0][0][1];
          float* sq = ce.sb0 + ((size_t)pm * 2 + fr) * DFF + 128 * pn + cl; *(f32x4*)sq = acc[0][1][0][0]; *(f32x4*)(sq + 4) = acc[0][1][0][1];
        }
        WAIT_L(0); BAR;
        float w0[8], w1[8], w2[8], cbv[8];
        {
          const float* wp = ce.cw + 128 * pn + cl; const float* bp = ce.cb + 128 * pn + cl;
#pragma unroll
          for (int x4 = 0; x4 < 2; ++x4) { const f32x4 a0 = *(const f32x4*)(wp + 4 * x4), a1 = *(const f32x4*)(wp + DFF + 4 * x4), a2 = *(const f32x4*)(wp + 2 * DFF + 4 * x4), a3 = *(const f32x4*)(bp + 4 * x4);
#pragma unroll
            for (int j = 0; j < 4; ++j) { w0[x4 * 4 + j] = a0[j]; w1[x4 * 4 + j] = a1[j]; w2[x4 * 4 + j] = a2[j]; cbv[x4 * 4 + j] = a3[j]; } }
        }
        bf16_t* gp = (bf16_t*)out0 + (size_t)(brow + wr * 64 + fr) * DFF + 128 * pn + cl;
#pragma unroll
        for (int ai = 0; ai < 2; ++ai) {
          const int blk = ai * 2 + wr;
          float h62[8], h63[8];
          if (blk > 0) {
            const LAS float* hq = halo + ((blk - 1) * 2) * 128 + cl;
            const f32x4 q0 = *(const LAS f32x4*)hq, q1 = *(const LAS f32x4*)(hq + 4), q2 = *(const LAS f32x4*)(hq + 128), q3 = *(const LAS f32x4*)(hq + 132);
#pragma unroll
            for (int j = 0; j < 4; ++j) { h62[j] = q0[j]; h62[4 + j] = q1[j]; h63[j] = q2[j]; h63[4 + j] = q3[j]; }
          } else {
#pragma unroll
            for (int j = 0; j < 8; ++j) { h62[j] = 0.f; h63[j] = 0.f; }
          }
#pragma unroll
          for (int m = 0; m < 4; ++m) {
            float gv[8];
#pragma unroll
            for (int x = 0; x < 8; ++x) {
              const float cur = acc[ai][0][m][x >> 2][x & 3], bb = acc[ai][1][m][x >> 2][x & 3];
              int o1, o2;
              if (m == 0) { o1 = __float_as_int(h63[x]); o2 = __float_as_int(fr == 0 ? h62[x] : h63[x]); }
              else { const int pv = __float_as_int(acc[ai][0][m - 1][x >> 2][x & 3]);
                     o1 = __builtin_amdgcn_update_dpp(pv, pv, 0x121, 0xf, 0xf, false); o2 = __builtin_amdgcn_update_dpp(pv, pv, 0x122, 0xf, 0xf, false); }
              const float a1 = __int_as_float(__builtin_amdgcn_update_dpp(o1, __float_as_int(cur), 0x111, 0xf, 0xf, false));
              const float a2 = __int_as_float(__builtin_amdgcn_update_dpp(o2, __float_as_int(cur), 0x112, 0xf, 0xf, false));
              const float y = w0[x] * a2 + w1[x] * a1 + w2[x] * cur + cbv[x];
              const float e = __builtin_amdgcn_exp2f(-2.302208198f * (y + 0.044715f * y * y * y));
              gv[x] = y * __builtin_amdgcn_rcpf(1.0f + e) * bb;
            }
            if (!(blk == 0 && m == 0 && fr < 2)) {
              u32x4 w = {pk_bf16(gv[0], gv[1]), pk_bf16(gv[2], gv[3]), pk_bf16(gv[4], gv[5]), pk_bf16(gv[6], gv[7])};
              *(u32x4*)(gp + (size_t)(ai * HALF + m * 16) * DFF) = w;
            }
          }
        }
#pragma unroll
        for (int ai = 0; ai < 2; ++ai)
#pragma unroll
          for (int bj = 0; bj < 2; ++bj)
#pragma unroll
            for (int m = 0; m < 4; ++m) { acc[ai][bj][m][0] = (f32x4){0.f, 0.f, 0.f, 0.f}; acc[ai][bj][m][1] = (f32x4){0.f, 0.f, 0.f, 0.f}; }
      } else {
      constexpr int ES = OUT_F32 ? 4 : 2;
      char* rp = (char*)((pn < split_pn) ? out0 : out1) +
                 ((size_t)(brow + wr * 64 + fr) * ldc + (size_t)(((pn < split_pn) ? bcol : bcol - split_pn * BM) + wc * 32 + fq * 8)) * ES;
#pragma unroll
      for (int ai = 0; ai < 2; ++ai) {
#pragma unroll
        for (int m = 0; m < 4; ++m) {
#pragma unroll
          for (int bj = 0; bj < 2; ++bj) {
            const f32x4 v0 = acc[ai][bj][m][0], v1 = acc[ai][bj][m][1];
            if (OUT_F32) { *(f32x4*)(rp + (bj * HALF) * ES) = v0; *(f32x4*)(rp + (bj * HALF + 4) * ES) = v1; }
            else { u32x4 w = {pk_bf16(v0[0], v0[1]), pk_bf16(v0[2], v0[3]), pk_bf16(v1[0], v1[1]), pk_bf16(v1[2], v1[3])}; *(u32x4*)(rp + (bj * HALF) * ES) = w; }
            acc[ai][bj][m][0] = (f32x4){0.f, 0.f, 0.f, 0.f}; acc[ai][bj][m][1] = (f32x4){0.f, 0.f, 0.f, 0.f};
          }
          rp += (size_t)16 * ldc * ES;
          asm volatile("" : "+v"(rp));
        }
        rp += (size_t)(HALF - 64) * ldc * ES;
      }
      }
      if (!has_next) break;
      pm = npm; pn = npn; brow = nbrow; bcol = nbcol;
      if (wr == 1) BAR;
    }
    WAIT_V(0);
    BAR;
  }
#undef UNIT_OF
  __syncthreads();
#undef SA
#undef SB
#undef STAGE
#undef STAGEB
#undef LDA
#undef LDB
#undef MMA
}

__device__ __forceinline__ void p0_norm_ga(const Params& p, const int g_wave64) {
  extern __shared__ __attribute__((aligned(16))) float ldsf[];
  const float* x = p.in[0]; const float* g = p.in[1]; const float* w_in = p.in[2];
  bf16_t* H = (bf16_t*)(p.ws + WS_H); float* GA = (float*)(p.ws + WS_GA);
  OPAQUE_TID(tid); const int lane = tid & 63, wave = tid >> 6;
  for (int idx = tid; idx < 32768; idx += NT) { const int k = idx >> 4, j = idx & 15; ldsf[j * 2052 + k] = w_in[(size_t)k * INC + 3072 + j]; }
  __syncthreads();
  for (int rb = blockIdx.x; rb < SEQ / 64; rb += gridDim.x) {
    for (int rp = 0; rp < 4; ++rp) {
      const int row0 = rb * 64 + wave * 8 + rp * 2;
      f32x4 xv[2][8];
#pragma unroll
      for (int q = 0; q < 2; ++q)
#pragma unroll
        for (int ii = 0; ii < 8; ++ii) xv[q][ii] = *(const f32x4*)(x + (size_t)(row0 + q) * DM + ii * 256 + lane * 4);
      float rs[2];
#pragma unroll
      for (int q = 0; q < 2; ++q) {
        float s = 0.f;
#pragma unroll
        for (int ii = 0; ii < 8; ++ii) s += xv[q][ii][0] * xv[q][ii][0] + xv[q][ii][1] * xv[q][ii][1] + xv[q][ii][2] * xv[q][ii][2] + xv[q][ii][3] * xv[q][ii][3];
        s = wave_sum_l(s, lane); rs[q] = rsqrtf(s * (1.0f / DM) + EPS);
      }
#pragma unroll
      for (int ii = 0; ii < 8; ++ii) {
        const f32x4 gv = *(const f32x4*)(g + ii * 256 + lane * 4);
#pragma unroll
        for (int q = 0; q < 2; ++q) {
          xv[q][ii] = xv[q][ii] * rs[q] * gv;
          u32x2 w = {pk_bf16(xv[q][ii][0], xv[q][ii][1]), pk_bf16(xv[q][ii][2], xv[q][ii][3])};
          *(u32x2*)(H + (size_t)(row0 + q) * DM + ii * 256 + lane * 4) = w;
        }
      }
      float a0[16], a1[16];
#pragma unroll
      for (int j = 0; j < 16; ++j) {
        float s0 = 0.f, s1 = 0.f;
#pragma unroll
        for (int ii = 0; ii < 8; ++ii) {
          const f32x4 wv = *(const f32x4*)(ldsf + j * 2052 + ii * 256 + lane * 4);
          s0 += xv[0][ii][0] * wv[0] + xv[0][ii][1] * wv[1] + xv[0][ii][2] * wv[2] + xv[0][ii][3] * wv[3];
          s1 += xv[1][ii][0] * wv[0] + xv[1][ii][1] * wv[1] + xv[1][ii][2] * wv[2] + xv[1][ii][3] * wv[3];
        }
        a0[j] = s0; a1[j] = s1;
        asm volatile("" : "+v"(a0[j]), "+v"(a1[j]) :: "memory");
      }
#define BFLY(N, MASK) _Pragma("unroll") for (int i = 0; i < (N) / 2; ++i) { const bool up = (lane & (MASK)) != 0; \
        const float sd0 = up ? a0[i] : a0[i + (N) / 2], kp0 = up ? a0[i + (N) / 2] : a0[i]; a0[i] = kp0 + shx(sd0, (MASK), lane); \
        const float sd1 = up ? a1[i] : a1[i + (N) / 2], kp1 = up ? a1[i + (N) / 2] : a1[i]; a1[i] = kp1 + shx(sd1, (MASK), lane); }
      BFLY(16, 32) BFLY(8, 16) BFLY(4, 8) BFLY(2, 4)
#undef BFLY
      float g0 = a0[0], g1 = a1[0];
      g0 += shx(g0, 2, lane); g1 += shx(g1, 2, lane);
      g0 += shx(g0, 1, lane); g1 += shx(g1, 1, lane);
      if ((lane & 3) == 0) { const int j = ((lane >> 5) & 1) * 8 + ((lane >> 4) & 1) * 4 + ((lane >> 3) & 1) * 2 + ((lane >> 2) & 1); GA[(size_t)row0 * 16 + j] = g0; GA[(size_t)(row0 + 1) * 16 + j] = g1; }
    }
  }
  __syncthreads();
}

struct TSeg { const float* src; int ld, col0, ncols, K; bf16_t* dst; };
__device__ __forceinline__ void p0_transposes(const Params& p, const int g_wave64) {
  extern __shared__ __attribute__((aligned(16))) float ldsf[];
  OPAQUE_TID(tid);
  const int ntile[8] = {32 * 16, 32 * 16, 32 * 32, 32 * 16, 32 * 16, 32 * 32, 32 * 176, 88 * 32};
  int total = 0;
  for (int i = 0; i < 8; ++i) total += ntile[i];
  const int lane = tid & 63, wave = __builtin_amdgcn_readfirstlane(tid >> 6);
  for (int tix = blockIdx.x * 8 + wave; tix < total; tix += gridDim.x * 8) {
    int s = 0, rem = tix;
    while (rem >= ntile[s]) { rem -= ntile[s]; ++s; }
    const float* src; int ld, col0, nct, K; bf16_t* dst;
    bf16_t* WinT = (bf16_t*)(p.ws + WS_WIN); bf16_t* WvT = (bf16_t*)(p.ws + WS_WV);
    switch (s) {
      case 0: src = p.in[2]; ld = INC; col0 = 0; nct = 16; K = 2048; dst = WinT; break;
      case 1: src = p.in[2]; ld = INC; col0 = 2048; nct = 16; K = 2048; dst = WinT + (size_t)1024 * 2048; break;
      case 2: src = p.in[2]; ld = INC; col0 = 3088; nct = 32; K = 2048; dst = WinT + (size_t)2048 * 2048; break;
      case 3: src = p.in[2]; ld = INC; col0 = 1024; nct = 16; K = 2048; dst = WvT; break;
      case 4: src = p.in[2]; ld = INC; col0 = 5136; nct = 16; K = 2048; dst = WvT + (size_t)1024 * 2048; break;
      case 5: src = p.in[11]; ld = 2048; col0 = 0; nct = 32; K = 2048; dst = (bf16_t*)(p.ws + WS_WO); break;
      case 6: src = p.in[14]; ld = 2 * DFF; col0 = 0; nct = 176; K = 2048; dst = (bf16_t*)(p.ws + WS_WFI); break;
      default: src = p.in[17]; ld = 2048; col0 = 0; nct = 32; K = DFF; dst = (bf16_t*)(p.ws + WS_WFO); break;
    }
    const int kt = rem / nct, ct = rem % nct;
    float* t = ldsf + wave * (64 * 65);
    f32x4 v[16];
#pragma unroll
    for (int i = 0; i < 16; ++i) v[i] = *(const f32x4*)(src + (size_t)(kt * 64 + i * 4 + (lane >> 4)) * ld + col0 + ct * 64 + (lane & 15) * 4);
#pragma unroll
    for (int i = 0; i < 16; ++i) { float* tp = t + (i * 4 + (lane >> 4)) * 65 + (lane & 15) * 4; tp[0] = v[i][0]; tp[1] = v[i][1]; tp[2] = v[i][2]; tp[3] = v[i][3]; }
    asm volatile("s_waitcnt lgkmcnt(0)" ::: "memory");
#pragma unroll
    for (int i = 0; i < 8; ++i) {
      const int nl = (lane >> 3) + 8 * i, kl = (lane & 7) * 8;
      const float* tp = t + kl * 65 + nl;
      u32x4 w = {pk_bf16(tp[0], tp[65]), pk_bf16(tp[130], tp[195]), pk_bf16(tp[260], tp[325]), pk_bf16(tp[390], tp[455])};
      int drow0 = ct * 64;
      if (s == 6) drow0 = (ct < 88) ? 256 * (ct >> 1) + 64 * (ct & 1) : 256 * ((ct - 88) >> 1) + 128 + 64 * ((ct - 88) & 1);
      *(u32x4*)(dst + (size_t)(drow0 + nl) * K + kt * 64 + kl) = w;
    }
    asm volatile("s_waitcnt lgkmcnt(0)" ::: "memory");
  }
  __syncthreads();
}

DI void gla_cumsum(const Params& p, float* Bs, float* tot, float* gas, int head, int chunk, int tid_in) {
  const float* GA = (const float*)(p.ws + WS_GA); const float* wup = p.in[3]; const float* ba = p.in[4];
  const int tid = tid_in, d = tid & 127, tg = tid >> 7;
  float w[16];
#pragma unroll
  for (int r = 0; r < 16; ++r) w[r] = wup[r * 512 + head * 128 + d];
  const float bias = ba[head * 128 + d];
  if (tid < 256) { const f32x4 gv = *(const f32x4*)(GA + (size_t)(chunk * 64 + (tid >> 2)) * 16 + (tid & 3) * 4); *(f32x4*)(gas + (tid >> 2) * 16 + (tid & 3) * 4) = gv; }
  __syncthreads();
  float run = 0.f;
#pragma unroll 4
  for (int tt = 0; tt < 16; ++tt) {
    const f32x4* gp = (const f32x4*)(gas + (tg * 16 + tt) * 16);
    const f32x4 g0 = gp[0], g1 = gp[1], g2 = gp[2], g3 = gp[3];
    float xx = bias;
    xx += g0[0] * w[0] + g0[1] * w[1] + g0[2] * w[2] + g0[3] * w[3];
    xx += g1[0] * w[4] + g1[1] * w[5] + g1[2] * w[6] + g1[3] * w[7];
    xx += g2[0] * w[8] + g2[1] * w[9] + g2[2] * w[10] + g2[3] * w[11];
    xx += g3[0] * w[12] + g3[1] * w[13] + g3[2] * w[14] + g3[3] * w[15];
    const float ls = -(fmaxf(-xx, 0.f) + __logf(1.0f + __expf(-fabsf(xx))));
    run += ls * (1.0f / 16.0f);
    Bs[(tg * 16 + tt) * 129 + d] = run;
  }
  tot[tg * 128 + d] = run;
  __syncthreads();
  float pre = 0.f;
  for (int gq = 0; gq < tg; ++gq) pre += tot[gq * 128 + d];
  for (int tt = 0; tt < 16; ++tt) Bs[(tg * 16 + tt) * 129 + d] += pre;
  __syncthreads();
}

constexpr int GL_QB = 0, GL_KB = 17408, GL_VT = 34816, GL_B = 71680, GL_TOT = GL_B + 33024, GL_ST = 71680, GL_RED = 141312, GL_GA = 142336;

DI void gla_load_vt(const Params& p, unsigned char* lds, int head, int chunk, int tid) {
  const bf16_t* VT = (const bf16_t*)(p.ws + WS_VT);
#pragma unroll
  for (int i = 0; i < 4; ++i) {
    const int id = tid + NT * i, row = id >> 3, c = id & 7;
    const u32x4 v = *(const u32x4*)(VT + (size_t)(head * 256 + row) * SEQ + chunk * 64 + c * 8);
    *(u32x4*)(lds + GL_VT + row * 144 + c * 16) = v;
  }
}

__device__ __forceinline__ void gla_g1(const Params& p, const int g_wave64) {
  extern __shared__ __attribute__((aligned(16))) unsigned char lds[];
  const bf16_t* PROJ = (const bf16_t*)(p.ws + WS_PROJ);
  float* UT = p.out; float* GDEC = (float*)(p.ws + WS_GDEC);
  OPAQUE_TID(tid); const int lane = tid & 63, wave = tid >> 6, r = lane & 31, h = lane >> 5;
  float* Bs = (float*)(lds + GL_B); float* tot = (float*)(lds + GL_TOT);
  for (int u = blockIdx.x; u < 1024; u += gridDim.x) {
    const int head = u >> 8, chunk = u & 255;
    __syncthreads();
    bf16_t kraw[16];
    {
      const int d = tid & 127, tg = tid >> 7;
#pragma unroll
      for (int tt = 0; tt < 16; ++tt) kraw[tt] = PROJ[(size_t)(chunk * 64 + tg * 16 + tt) * 4096 + 512 + head * 128 + d];
    }
    gla_load_vt(p, lds, head, chunk, tid);
    gla_cumsum(p, Bs, tot, (float*)(lds + GL_GA), head, chunk, tid);
    {
      const int d = tid & 127, tg = tid >> 7;
      const float bl = Bs[63 * 129 + d];
      float kv[16];
#pragma unroll
      for (int tt = 0; tt < 16; ++tt) {
        const int tl = tg * 16 + tt;
        const float kk = bf2f(kraw[tt]);
        kv[tt] = kk * __expf(bl - Bs[tl * 129 + d]);
      }
      u32x4 w0 = {pk_bf16(kv[0], kv[1]), pk_bf16(kv[2], kv[3]), pk_bf16(kv[4], kv[5]), pk_bf16(kv[6], kv[7])};
      u32x4 w1 = {pk_bf16(kv[8], kv[9]), pk_bf16(kv[10], kv[11]), pk_bf16(kv[12], kv[13]), pk_bf16(kv[14], kv[15])};
      *(u32x4*)(lds + GL_QB + d * 144 + tg * 32) = w0;
      *(u32x4*)(lds + GL_QB + d * 144 + tg * 32 + 16) = w1;
      if (tid < 128) GDEC[(size_t)u * 128 + d] = __expf(bl);
    }
    __syncthreads();
    f32x16 acc[4];
#pragma unroll
    for (int nb = 0; nb < 4; ++nb)
#pragma unroll
      for (int i = 0; i < 16; ++i) acc[nb][i] = 0.f;
#pragma unroll
    for (int s = 0; s < 4; ++s) {
      const bf16x8 a = *(const bf16x8*)(lds + GL_VT + (wave * 32 + r) * 144 + (16 * s + 8 * h) * 2);
#pragma unroll
      for (int nb = 0; nb < 4; ++nb) {
        const bf16x8 b = *(const bf16x8*)(lds + GL_QB + (nb * 32 + r) * 144 + (16 * s + 8 * h) * 2);
        acc[nb] = mfma32(a, b, acc[nb]);
      }
    }
    bf16_t* up = (bf16_t*)UT + (size_t)u * 32768;
#pragma unroll
    for (int nb = 0; nb < 4; ++nb)
#pragma unroll
      for (int gi = 0; gi < 16; ++gi) {
        const int e = wave * 32 + (gi & 3) + 8 * (gi >> 2) + 4 * h;
        up[e * 128 + nb * 32 + r] = (bf16_t)(pk_bf16(acc[nb][gi], 0.f) & 0xffffu);
      }
  }
  __syncthreads();
}

__device__ __forceinline__ void gla_g2(const Params& p, const int g_wave64) {
  const bf16_t* UB = (const bf16_t*)p.out; bf16_t* SB = (bf16_t*)p.out + (size_t)1024 * 32768; const float* GDEC = (const float*)(p.ws + WS_GDEC);
  OPAQUE_TID(tid);
  for (int el = blockIdx.x * NT + tid; el < 4 * 32768; el += gridDim.x * NT) {
    const int head = el >> 15, ed = el & 32767, d = ed & 127;
    const bf16_t* up = UB + (size_t)head * 256 * 32768 + ed;
    bf16_t* sp = SB + (size_t)head * 256 * 32768 + ed;
    const float* gp = GDEC + (size_t)head * 256 * 128 + d;
    float st = 0.f;
    for (int c0 = 0; c0 < 256; c0 += 32) {
      float uu[32], gg[32];
#pragma unroll
      for (int i = 0; i < 32; ++i) { uu[i] = bf2f(up[(size_t)(c0 + i) * 32768]); gg[i] = gp[(c0 + i) * 128]; }
#pragma unroll
      for (int i = 0; i < 32; ++i) { sp[(size_t)(c0 + i) * 32768] = (bf16_t)(pk_bf16(st, 0.f) & 0xffffu); st = gg[i] * st + uu[i]; }
    }
  }
}

__device__ __forceinline__ void gla_g3(const Params& p, const int g_wave64) {
  extern __shared__ __attribute__((aligned(16))) unsigned char lds[];
  const bf16_t* PROJ = (const bf16_t*)(p.ws + WS_PROJ);
  const float* ST = p.out; bf16_t* O = (bf16_t*)(p.ws + WS_O); const float* gnorm = p.in[5];
  OPAQUE_TID(tid); const int lane = tid & 63, wave = tid >> 6, r = lane & 31, h = lane >> 5;
  const int ib = wave & 1, eq = wave >> 1;
  float* Bs = (float*)(lds + GL_B); float* tot = (float*)(lds + GL_TOT); float* red = (float*)(lds + GL_RED);
  for (int u = blockIdx.x; u < 1024; u += gridDim.x) {
    const int head = u >> 8, chunk = u & 255;
    __syncthreads();
    u32x4 stv[8];
    {
      const bf16_t* sp = (const bf16_t*)ST + (size_t)1024 * 32768 + (size_t)u * 32768;
#pragma unroll
      for (int i = 0; i < 8; ++i) { const int id = tid + NT * i, e = id >> 4, c8 = id & 15; stv[i] = *(const u32x4*)(sp + e * 128 + c8 * 8); }
    }
    bf16_t qraw[16], kraw[16];
    {
      const int d = tid & 127, tg = tid >> 7;
#pragma unroll
      for (int tt = 0; tt < 16; ++tt) { const size_t ro = (size_t)(chunk * 64 + tg * 16 + tt) * 4096 + head * 128 + d; qraw[tt] = PROJ[ro]; kraw[tt] = PROJ[ro + 512]; }
    }
    gla_load_vt(p, lds, head, chunk, tid);
    gla_cumsum(p, Bs, tot, (float*)(lds + GL_GA), head, chunk, tid);
    {
      const int d = tid & 127, tg = tid >> 7;
#pragma unroll
      for (int tt = 0; tt < 16; ++tt) {
        const int tl = tg * 16 + tt;
        const float bb = Bs[tl * 129 + d];
        const float qq = bf2f(qraw[tt]) * 0.08838834764831845f * __expf(bb);
        const float kk = bf2f(kraw[tt]) * __expf(-bb);
        *(bf16_t*)(lds + GL_QB + tl * 272 + d * 2) = (bf16_t)(pk_bf16(qq, 0.f) & 0xffff);
        *(bf16_t*)(lds + GL_KB + tl * 272 + d * 2) = (bf16_t)(pk_bf16(kk, 0.f) & 0xffff);
      }
    }
    __syncthreads();
    {
#pragma unroll
      for (int i = 0; i < 8; ++i) { const int id = tid + NT * i, e = id >> 4, c8 = id & 15; *(u32x4*)(lds + GL_ST + e * 272 + c8 * 16) = stv[i]; }
    }
    __syncthreads();
    bf16x8 qf[8];
#pragma unroll
    for (int s = 0; s < 8; ++s) qf[s] = *(const bf16x8*)(lds + GL_QB + (ib * 32 + r) * 272 + (16 * s + 8 * h) * 2);
    f32x16 X[2];
#pragma unroll
    for (int jb = 0; jb < 2; ++jb) {
#pragma unroll
      for (int i = 0; i < 16; ++i) X[jb][i] = 0.f;
      if (jb <= ib) {
        const int jrow = jb * 32 + perm23(r);
#pragma unroll
        for (int s = 0; s < 8; ++s) {
          const bf16x8 a = *(const bf16x8*)(lds + GL_KB + jrow * 272 + (16 * s + 8 * h) * 2);
          X[jb] = mfma32(a, qf[s], X[jb]);
        }
        if (jb == ib) {
#pragma unroll
          for (int gi = 0; gi < 16; ++gi) {
            const int jj = (gi & 3) + 4 * ((gi >> 2) & 1) + 8 * h + 16 * ((gi >> 3) & 1);
            if (jj > r) X[jb][gi] = 0.f;
          }
        }
      }
    }
    f32x16 acc[2];
#pragma unroll
    for (int eb = 0; eb < 2; ++eb)
#pragma unroll
      for (int i = 0; i < 16; ++i) acc[eb][i] = 0.f;
    const int e0 = eq * 64;
#pragma unroll
    for (int jb = 0; jb < 2; ++jb) {
      if (jb <= ib) {
#pragma unroll
        for (int s2 = 0; s2 < 2; ++s2) {
          const bf16x8 pf = pack8(X[jb][8 * s2 + 0], X[jb][8 * s2 + 1], X[jb][8 * s2 + 2], X[jb][8 * s2 + 3],
                                  X[jb][8 * s2 + 4], X[jb][8 * s2 + 5], X[jb][8 * s2 + 6], X[jb][8 * s2 + 7]);
#pragma unroll
          for (int eb = 0; eb < 2; ++eb) {
            const bf16x8 a = *(const bf16x8*)(lds + GL_VT + (e0 + eb * 32 + r) * 144 + (jb * 32 + 16 * s2 + 8 * h) * 2);
            acc[eb] = mfma32(a, pf, acc[eb]);
          }
        }
      }
    }
#pragma unroll
    for (int s = 0; s < 8; ++s)
#pragma unroll
      for (int eb = 0; eb < 2; ++eb) {
        const bf16x8 a = *(const bf16x8*)(lds + GL_ST + (e0 + eb * 32 + r) * 272 + (16 * s + 8 * h) * 2);
        acc[eb] = mfma32(a, qf[s], acc[eb]);
      }
    float ss = 0.f;
#pragma unroll
    for (int eb = 0; eb < 2; ++eb)
#pragma unroll
      for (int i = 0; i < 16; ++i) ss += acc[eb][i] * acc[eb][i];
    ss += shx(ss, 32, lane);
    if (h == 0) red[eq * 64 + ib * 32 + r] = ss;
    __syncthreads();
    const int il = ib * 32 + r;
    const float tsum = red[il] + red[64 + il] + red[128 + il] + red[192 + il];
    const float rstd = rsqrtf(tsum * (1.0f / 256.0f) + EPS);
    const int token = chunk * 64 + il;
#pragma unroll
    for (int eb = 0; eb < 2; ++eb)
#pragma unroll
      for (int g4 = 0; g4 < 4; ++g4) {
        const int eb0 = e0 + eb * 32 + 8 * g4 + 4 * h;
        const u32x2 gt = *(const u32x2*)(PROJ + (size_t)token * 4096 + 1024 + head * 256 + eb0);
        const f32x4 gn = *(const f32x4*)(gnorm + eb0);
        float gv[4] = {bflo(gt[0]), bfhi(gt[0]), bflo(gt[1]), bfhi(gt[1])};
        float y[4];
#pragma unroll
        for (int j = 0; j < 4; ++j) { const float sg = gv[j] * __builtin_amdgcn_rcpf(1.0f + __expf(-gv[j])); y[j] = acc[eb][g4 * 4 + j] * rstd * gn[j] * sg; }
        u32x2 w = {pk_bf16(y[0], y[1]), pk_bf16(y[2], y[3])};
        *(u32x2*)(O + (size_t)token * DM + head * 256 + eb0) = w;
      }
  }
  __syncthreads();
}

#define LDSADDR(p) ((unsigned)(unsigned long)(p))
DI void lds_rd128(bf16x8& dst, const unsigned addr) { asm volatile("ds_read_b128 %0, %1" : "=v"(dst) : "v"(addr)); }
DI void lgkm_wait(const int n, bf16x8& reg) {
  switch (n) {
    case 0: asm volatile("s_waitcnt lgkmcnt(0)" : "+v"(reg)); break;
    case 1: asm volatile("s_waitcnt lgkmcnt(1)" : "+v"(reg)); break;
    case 2: asm volatile("s_waitcnt lgkmcnt(2)" : "+v"(reg)); break;
    case 3: asm volatile("s_waitcnt lgkmcnt(3)" : "+v"(reg)); break;
    case 4: asm volatile("s_waitcnt lgkmcnt(4)" : "+v"(reg)); break;
    case 5: asm volatile("s_waitcnt lgkmcnt(5)" : "+v"(reg)); break;
    case 6: asm volatile("s_waitcnt lgkmcnt(6)" : "+v"(reg)); break;
    default: asm volatile("s_waitcnt lgkmcnt(7)" : "+v"(reg)); break;
  }
}
__device__ __forceinline__ void attn_finish(f32x16 (&o)[8], const float l, const Params& p, unsigned char* lds, const int tid, const int pr, const int comp, const int q0, const int head) {
  bf16_t* O = (bf16_t*)(p.ws + WS_O); const float* dnorm = p.in[10];
  {
      int t3 = tid; asm volatile("" : "+v"(t3));
      const float lt = l + __builtin_bit_cast(float, __builtin_amdgcn_ds_bpermute(((t3 & 63) ^ 32) << 2, __builtin_bit_cast(int, l)));
      float* ex = (float*)lds + (size_t)pr * 8192;
      const int lane_e = t3 & 63, h_e = lane_e >> 5, qrow_e = q0 + pr * 32 + (lane_e & 31);
      if (comp == 1) {
        float lam;
        {
          const float* q1 = p.in[6]; const float* k1 = p.in[7]; const float* q2 = p.in[8]; const float* k2 = p.in[9];
          float s1 = q1[lane_e] * k1[lane_e] + q1[lane_e + 64] * k1[lane_e + 64];
          float s2 = q2[lane_e] * k2[lane_e] + q2[lane_e + 64] * k2[lane_e + 64];
          s1 = wave_sum_l(s1, lane_e); s2 = wave_sum_l(s2, lane_e);
          lam = expf(s1) - expf(s2) + 0.2f;
        }
        const float sc = lam / lt;
#pragma unroll
        for (int dvb = 0; dvb < 8; ++dvb)
#pragma unroll
          for (int gi = 0; gi < 16; ++gi) ex[(dvb * 16 + gi) * 64 + lane_e] = o[dvb][gi] * sc;
      }
      __syncthreads();
      if (comp == 0) {
        const float sc = 1.0f / lt;
        float ss = 0.f;
#pragma unroll
        for (int dvb = 0; dvb < 8; ++dvb) {
#pragma unroll
          for (int gi = 0; gi < 16; ++gi) { const float dv = o[dvb][gi] * sc - ex[(dvb * 16 + gi) * 64 + lane_e]; o[dvb][gi] = dv; ss += dv * dv; }
          asm volatile("" : "+v"(o[dvb]), "+v"(ss) :: "memory");
        }
        ss += __builtin_bit_cast(float, __builtin_amdgcn_ds_bpermute((lane_e ^ 32) << 2, __builtin_bit_cast(int, ss)));
        const float rstd = rsqrtf(ss * (1.0f / 256.0f) + EPS) * 0.8f;
#pragma unroll
        for (int dvb = 0; dvb < 8; ++dvb)
#pragma unroll
          for (int g4 = 0; g4 < 4; ++g4) {
            const int dv0 = dvb * 32 + 8 * g4 + 4 * h_e;
            const f32x4 gn = *(const f32x4*)(dnorm + dv0);
            u32x2 w = {pk_bf16(o[dvb][g4 * 4 + 0] * rstd * gn[0], o[dvb][g4 * 4 + 1] * rstd * gn[1]),
                       pk_bf16(o[dvb][g4 * 4 + 2] * rstd * gn[2], o[dvb][g4 * 4 + 3] * rstd * gn[3])};
            *(u32x2*)(O + (size_t)qrow_e * DM + 1024 + head * 256 + dv0) = w;
          }
      }
      __syncthreads();
  }
}

__device__ __forceinline__ void attn_norms(const Params& p, const int g_wave64) {
  extern __shared__ __attribute__((aligned(16))) unsigned char lds[];
  const bf16_t* PROJ = (const bf16_t*)(p.ws + WS_PROJ); unsigned* NRM = (unsigned*)(p.ws + WS_NRM);
  OPAQUE_TID(tid); const int lane = tid & 63, wave = tid >> 6;
  float* red = (float*)lds;
  float mx0 = 0.f, mx1 = 0.f, mx2 = 0.f;
  for (int rb = blockIdx.x; rb < SEQ / 64; rb += gridDim.x) {
    const int row = rb * 64 + (tid >> 3), j = tid & 7;
    const bf16_t* qp = PROJ + (size_t)row * 4096 + 2048 + j * 128;
    const bf16_t* kp = qp + 1024;
    float qq = 0.f, kk = 0.f, qk = 0.f;
#pragma unroll
    for (int c = 0; c < 16; ++c) { const u32x4 v = *(const u32x4*)(qp + c * 8), w = *(const u32x4*)(kp + c * 8);
#pragma unroll
      for (int e = 0; e < 4; ++e) { const float a = bflo(v[e]), bb = bfhi(v[e]), c2 = bflo(w[e]), d2 = bfhi(w[e]); qq += a * a + bb * bb; kk += c2 * c2 + d2 * d2; qk += a * c2 + bb * d2; } }
    mx0 = fmaxf(mx0, qq); mx1 = fmaxf(mx1, kk); mx2 = fmaxf(mx2, -qk);
  }
  for (int o = 8; o < 64; o <<= 1) { mx0 = fmaxf(mx0, shx(mx0, o, lane)); mx1 = fmaxf(mx1, shx(mx1, o, lane)); mx2 = fmaxf(mx2, shx(mx2, o, lane)); }
  __syncthreads();
  if (lane < 8) { red[wave * 24 + lane] = mx0; red[wave * 24 + 8 + lane] = mx1; red[wave * 24 + 16 + lane] = mx2; }
  __syncthreads();
  if (tid < 24) { float mm = 0.f; for (int w = 0; w < 8; ++w) mm = fmaxf(mm, red[w * 24 + tid]); atomicMax(NRM + tid, __float_as_uint(mm)); }
  __syncthreads();
}
__device__ __forceinline__ void attn_plan(const Params& p, int (&dh)[4]) {
  unsigned* NRM = (unsigned*)(p.ws + WS_NRM);
#pragma unroll
  for (int hh = 0; hh < 4; ++hh) {
    float bound = 0.f;
#pragma unroll
    for (int c = 0; c < 2; ++c) {
      const float qn = __uint_as_float(__hip_atomic_load(NRM + hh * 2 + c, __ATOMIC_RELAXED, __HIP_MEMORY_SCOPE_AGENT));
      const float kn = __uint_as_float(__hip_atomic_load(NRM + 8 + hh * 2 + c, __ATOMIC_RELAXED, __HIP_MEMORY_SCOPE_AGENT));
      const float dg = __uint_as_float(__hip_atomic_load(NRM + 16 + hh * 2 + c, __ATOMIC_RELAXED, __HIP_MEMORY_SCOPE_AGENT));
      bound = fmaxf(bound, (sqrtf(qn * kn) + dg) * (0.08838834764831845f * LOG2E * 1.02f));
    }
    const float slope2 = exp2f(-2.0f * (float)(hh + 1)) * LOG2E;
    const float D = (bound + 152.0f) / slope2;
    dh[hh] = __builtin_amdgcn_readfirstlane((D < 1.0e9f) ? (int)D : 1000000000);
  }
}
__device__ __forceinline__ int attn_nsteps(const int head, const int qb, const int (&dh)[4]) {
  const int d = dh[0] * (head == 0) + dh[1] * (head == 1) + dh[2] * (head == 2) + dh[3] * (head == 3);
  int ttmin = (128 * qb - d) / 64 - 1; ttmin = ttmin < 0 ? 0 : ttmin;
  return 2 * qb + 2 - ttmin;
}
constexpr int ATT_TAB = 132096;
__device__ __forceinline__ void attn_build_plan(const Params& p, unsigned char* lds, const int tid) {
  int* tab = (int*)(lds + ATT_TAB);
  __syncthreads();
  int dh[4]; attn_plan(p, dh);
  if (tid < 256) {
    const int r = tid >> 5, j = tid & 31;
    int v = attn_nsteps(r >> 1, 127 - (r & 1) * 32 - j, dh) + attn_nsteps(r >> 1, (r & 1) * 32 + j, dh) + 2 * OVH;
    for (int o = 1; o < 32; o <<= 1) { const int w = __builtin_amdgcn_ds_bpermute(((tid & 63) ^ o) << 2, v); v = w > v ? w : v; }
    if (j == 0) tab[128 + r] = v;
  }
  __syncthreads();
  if (tid == 0) {
    const int xg = (int)blockIdx.x & 7, jq = (int)blockIdx.x >> 3;
    int R = 0;
#pragma unroll 1
    for (int r = 0; r < 8; ++r) R += tab[128 + r];
    const int Xa = (xg * R) / 8, Xb = ((xg + 1) * R) / 8;
    int P = 0; int first = 1;
#pragma unroll 1
    for (int r = 0; r < 8; ++r) {
      const int head = r >> 1, pg = r & 1, rlen = tab[128 + r];
      const int ra = (Xa > P ? Xa : P) - P, rb = (Xb < P + rlen ? Xb : P + rlen) - P;
      int off = 0;
#pragma unroll 1
      for (int part = 0; part < 2; ++part) {
        const int qb = part == 0 ? pg * 32 + jq : 127 - pg * 32 - jq;
        const int nst = attn_nsteps(head, qb, dh);
        int t_lo = ra - off, t_hi = rb - off;
        t_lo = t_lo < 0 ? 0 : t_lo; t_hi = t_hi > nst ? nst : t_hi;
        int* e = tab + (r * 2 + part) * 8;
        e[2] = nst; e[6] = qb;
        if (ra >= rb || t_lo >= t_hi) { e[0] = 0; e[1] = 0; e[3] = 0; e[4] = 0; e[5] = 0; }
        else {
          e[0] = t_lo; e[1] = t_hi; e[3] = 2 * (int)blockIdx.x + (first ? 0 : 1); first = 0;
          int cflag = 0, xend = xg;
          if (t_lo == 0 && t_hi < nst) {
            cflag = 1;
            for (int xx = xg + 1; xx < 8; ++xx) { if ((xx * R) / 8 - (P + off) >= nst) break; xend = xx; }
          }
          e[4] = cflag; e[5] = xend;
        }
        off += nst + OVH;
      }
      P += rlen;
    }
  }
  __syncthreads();
}
__device__ __forceinline__ void attn_phase(const Params& p, const int g_wave64) {
  extern __shared__ __attribute__((aligned(16))) unsigned char lds[];
  const bf16_t* PROJ = (const bf16_t*)(p.ws + WS_PROJ); const bf16_t* VT = (const bf16_t*)(p.ws + WS_VT);
  OPAQUE_TID(tid); const int lane = tid & 63, wave = __builtin_amdgcn_readfirstlane(tid >> 6), r = lane & 31, h = lane >> 5;
  const int comp = wave & 1, pr = wave >> 1;
  LAS unsigned char* L = (LAS unsigned char*)lds;
  const int pr_r = perm23(r);
  const unsigned kbase = (unsigned)pr_r * 256u, khs_c = (unsigned)((h ^ (pr_r & 15)) << 4);
  const unsigned vbase = (unsigned)r * 128u, vhs_c = (unsigned)((h ^ ((r >> 1) & 7)) << 4);
  const float C1 = 0.08838834764831845f * LOG2E;
  attn_build_plan(p, lds, tid);
  const int jq = (int)blockIdx.x >> 3;
#pragma unroll 1
  for (int rr = 0; rr < 16; ++rr) {
    const int* e = (const int*)(lds + ATT_TAB) + rr * 8;
    const int t_lo = __builtin_amdgcn_readfirstlane(e[0]), t_hi = __builtin_amdgcn_readfirstlane(e[1]), nst = __builtin_amdgcn_readfirstlane(e[2]), slot = __builtin_amdgcn_readfirstlane(e[3]);
    if (t_lo >= t_hi) continue;
    const int head = rr >> 2, qb = __builtin_amdgcn_readfirstlane(e[6]);
    const float slope2 = exp2f(-2.0f * (float)(head + 1)) * LOG2E;
    {
      const int q0 = qb * 128, ntiles = 2 * qb + 2;
      const int qrow = q0 + pr * 32 + r;
      bf16x8 qf[8];
      {
        int t4 = tid; asm volatile("" : "+v"(t4));
        const bf16_t* qp = PROJ + (size_t)(q0 + pr * 32 + (t4 & 31)) * 4096 + 2048 + head * 256 + comp * 128 + 8 * ((t4 >> 5) & 1);
#pragma unroll
        for (int s = 0; s < 8; ++s) {
          const u32x4 raw = *(const u32x4*)(qp + 16 * s);
          u32x4 sc;
#pragma unroll
          for (int j = 0; j < 4; ++j) sc[j] = pk_bf16(bflo(raw[j]) * C1, bfhi(raw[j]) * C1);
          qf[s] = __builtin_bit_cast(bf16x8, sc);
        }
      }
      f32x16 o[8];
#pragma unroll
      for (int dvb = 0; dvb < 8; ++dvb)
#pragma unroll
        for (int i = 0; i < 16; ++i) o[dvb][i] = 0.f;
      float m = -1e30f, l = 0.f;
#define ISSUE_TILE(T, BUF) do { int _t2 = tid; asm volatile("" : "+v"(_t2)); \
      const char* _kg = (const char*)PROJ + ((size_t)(T) * 64 * 4096 + 3072 + head * 256) * 2; \
      const char* _vg = (const char*)VT + ((size_t)(1024 + head * 256) * SEQ + (size_t)(T) * 64) * 2; \
      LAS unsigned char* _b = L + (BUF) * 65536 + wave * 1024; \
      _Pragma("unroll") for (int _i = 0; _i < 4; ++_i) { const int _slot = _t2 + NT * _i, _cmp = _slot >> 10, _sl = _slot & 1023, _row = _sl >> 4, _c = (_sl & 15) ^ (_row & 15); \
        __builtin_amdgcn_global_load_lds((const unsigned*)(_kg + (unsigned)((_row * 4096 + _cmp * 128 + _c * 8) * 2)), (LAS unsigned*)(_b + _i * 8192), 16, 0, 0); } \
      _Pragma("unroll") for (int _i = 0; _i < 4; ++_i) { const int _slot = _t2 + NT * _i, _row = _slot >> 3, _c = (_slot & 7) ^ ((_row >> 1) & 7); \
        __builtin_amdgcn_global_load_lds((const unsigned*)(_vg + (unsigned)((_row * SEQ + _c * 8) * 2)), (LAS unsigned*)(_b + 32768 + _i * 8192), 16, 0, 0); } } while (0)
#define ISSUE_PIECE(T, BUF, I) do { int _t2 = tid; asm volatile("" : "+v"(_t2)); LAS unsigned char* _b = L + (BUF) * 65536 + wave * 1024; \
      if ((I) < 4) { const int _slot = _t2 + NT * (I), _cmp = _slot >> 10, _sl = _slot & 1023, _row = _sl >> 4, _c = (_sl & 15) ^ (_row & 15); \
        const char* _kg = (const char*)PROJ + ((size_t)(T) * 64 * 4096 + 3072 + head * 256) * 2; \
        __builtin_amdgcn_global_load_lds((const unsigned*)(_kg + (unsigned)((_row * 4096 + _cmp * 128 + _c * 8) * 2)), (LAS unsigned*)(_b + (I) * 8192), 16, 0, 0); } \
      else { const int _slot = _t2 + NT * ((I) - 4), _row = _slot >> 3, _c = (_slot & 7) ^ ((_row >> 1) & 7); \
        const char* _vg = (const char*)VT + ((size_t)(1024 + head * 256) * SEQ + (size_t)(T) * 64) * 2; \
        __builtin_amdgcn_global_load_lds((const unsigned*)(_vg + (unsigned)((_row * SEQ + _c * 8) * 2)), (LAS unsigned*)(_b + 32768 + ((I) - 4) * 8192), 16, 0, 0); } } while (0)
      __syncthreads();
      ISSUE_TILE(ntiles - 1 - t_lo, 0);
      asm volatile("s_waitcnt vmcnt(0)" ::: "memory");
      __syncthreads();
      for (int t = t_lo; t < t_hi; ++t) {
        const int buf = (t - t_lo) & 1, tt = ntiles - 1 - t;
        const bool do_issue = (t + 1 < t_hi);
        const int k0 = tt * 64;
        const bool act = (k0 <= q0 + pr * 32 + 31);
        if (do_issue && !act) ISSUE_TILE(tt - 1, buf ^ 1);
        if (act) {
          LAS unsigned char* kb = L + (buf * 65536 + comp * 16384);
          LAS unsigned char* vb = L + (buf * 65536 + 32768);
#define KADDR(f) (kb + ((f) & 1) * 8192 + (kbase + ((unsigned)(((f) >> 1) * 32) ^ khs)))
#define VADDR(f) (vb + ((f) & 7) * 4096 + (vbase + ((unsigned)(((f) >> 3) * 32) ^ vhs)))
          unsigned khs = khs_c, vhs = vhs_c; asm volatile("" : "+v"(khs), "+v"(vhs));
          bf16x8 kf[KR];
#pragma unroll
          for (int f = 0; f < KR; ++f) lds_rd128(kf[f], LDSADDR(KADDR(f)));
          float sl2 = slope2; asm volatile("" : "+v"(sl2));
          const float mref = (m > -1e29f) ? m : 0.f;
          const float tb = sl2 * (float)(k0 + 8 * h - q0) - mref;
          f32x16 sa0, sa1;
          {
            const float s4x = sl2 * 4.0f, s16x = s4x * 4.0f, s32x = s16x + s16x;
            sa0[0] = tb; sa0[1] = tb + sl2; sa0[2] = sa0[1] + sl2; sa0[3] = sa0[2] + sl2;
#pragma unroll
            for (int gi = 0; gi < 4; ++gi) sa0[4 + gi] = sa0[gi] + s4x;
#pragma unroll
            for (int gi = 0; gi < 8; ++gi) sa0[8 + gi] = sa0[gi] + s16x;
#pragma unroll
            for (int gi = 0; gi < 16; ++gi) sa1[gi] = sa0[gi] + s32x;
          }
#pragma unroll
          for (int f = 0; f < 16; ++f) {
            lgkm_wait((15 - f) < (KR - 1) ? (15 - f) : (KR - 1), kf[f % KR]);
            if (f & 1) sa1 = mfma32(kf[f % KR], qf[f >> 1], sa1); else sa0 = mfma32(kf[f % KR], qf[f >> 1], sa0);
            if (f + KR < 16) lds_rd128(kf[f % KR], LDSADDR(KADDR(f + KR)));
            __builtin_amdgcn_sched_barrier(0);
          }
          bf16x8 vf[VR];
#pragma unroll
          for (int f = 0; f < VR; ++f) lds_rd128(vf[f], LDSADDR(VADDR(f)));
          __builtin_amdgcn_sched_barrier(0);
          if (do_issue) { ISSUE_PIECE(tt - 1, buf ^ 1, 0); ISSUE_PIECE(tt - 1, buf ^ 1, 1); ISSUE_PIECE(tt - 1, buf ^ 1, 2); ISSUE_PIECE(tt - 1, buf ^ 1, 3); }
          __builtin_amdgcn_sched_barrier(0);
          if (k0 + 63 > q0 + pr * 32) {
#pragma unroll
            for (int gi = 0; gi < 16; ++gi) {
              const int koff = (gi & 3) + 4 * ((gi >> 2) & 1) + 16 * ((gi >> 3) & 1);
              if (k0 + koff + 8 * h > qrow) sa0[gi] = -1e30f;
              if (k0 + koff + 32 + 8 * h > qrow) sa1[gi] = -1e30f;
            }
          }
          float mloc = fmaxf(sa0[0], sa1[0]);
#pragma unroll
          for (int gi = 1; gi < 16; ++gi) mloc = fmaxf(mloc, fmaxf(sa0[gi], sa1[gi]));
          mloc = fmaxf(mloc, shx(mloc, 32, lane));
          const float mrel = m - mref;
          const float delta = fmaxf(mrel, mloc);
          if (__ballot(delta > mrel) != 0ull) {
            const float alpha = __builtin_amdgcn_exp2f(mrel - delta);
            l *= alpha;
#pragma unroll
            for (int dvb = 0; dvb < 8; ++dvb) o[dvb] = o[dvb] * alpha;
#pragma unroll
            for (int gi = 0; gi < 16; ++gi) { sa0[gi] -= delta; sa1[gi] -= delta; }
          }
          m = mref + delta;
          float ps = 0.f;
#pragma unroll
          for (int gi = 0; gi < 16; ++gi) {
            const float p0 = __builtin_amdgcn_exp2f(sa0[gi]), p1 = __builtin_amdgcn_exp2f(sa1[gi]);
            sa0[gi] = p0; sa1[gi] = p1; ps += p0 + p1;
          }
          l += ps;
          __builtin_amdgcn_sched_barrier(0);
          if (do_issue) { ISSUE_PIECE(tt - 1, buf ^ 1, 4); ISSUE_PIECE(tt - 1, buf ^ 1, 5); ISSUE_PIECE(tt - 1, buf ^ 1, 6); ISSUE_PIECE(tt - 1, buf ^ 1, 7); }
          __builtin_amdgcn_sched_barrier(0);
          bf16x8 pf[4];
          pf[0] = pack8(sa0[0], sa0[1], sa0[2], sa0[3], sa0[4], sa0[5], sa0[6], sa0[7]);
          pf[1] = pack8(sa0[8], sa0[9], sa0[10], sa0[11], sa0[12], sa0[13], sa0[14], sa0[15]);
          pf[2] = pack8(sa1[0], sa1[1], sa1[2], sa1[3], sa1[4], sa1[5], sa1[6], sa1[7]);
          pf[3] = pack8(sa1[8], sa1[9], sa1[10], sa1[11], sa1[12], sa1[13], sa1[14], sa1[15]);
          __builtin_amdgcn_sched_barrier(0);
#pragma unroll
          for (int f = 0; f < 32; ++f) {
            lgkm_wait((31 - f) < (VR - 1) ? (31 - f) : (VR - 1), vf[f % VR]);
            o[f & 7] = mfma32(vf[f % VR], pf[f >> 3], o[f & 7]);
            if (f + VR < 32) lds_rd128(vf[f % VR], LDSADDR(VADDR(f + VR)));
            __builtin_amdgcn_sched_barrier(0);
          }
#undef KADDR
#undef VADDR
        }
        asm volatile("s_waitcnt vmcnt(0)" ::: "memory");
        __syncthreads();
      }
#undef ISSUE_TILE
#undef ISSUE_PIECE
      if (t_lo == 0 && t_hi == nst) {
        attn_finish(o, l, p, lds, tid, pr, comp, q0, head);
      } else {
        int t5 = tid; asm volatile("" : "+v"(t5));
        float* ps = part_slot(p, slot) + wave * 8192 + (t5 & 63);
#pragma unroll
        for (int dvb = 0; dvb < 8; ++dvb)
#pragma unroll
          for (int gi = 0; gi < 16; ++gi) ps[(dvb * 16 + gi) * 64] = o[dvb][gi];
        float* ml = (float*)(p.ws + WS_ML) + ((size_t)slot * 8 + wave) * 128 + (t5 & 63);
        ml[0] = m; ml[64] = l;
      }
    }
  }
  __syncthreads();
}

__device__ __forceinline__ void attn_combine(const Params& p, const int g_wave64) {
  extern __shared__ __attribute__((aligned(16))) unsigned char lds[];
  OPAQUE_TID(tid); const int lane = tid & 63, wave = __builtin_amdgcn_readfirstlane(tid >> 6);
  const int comp = wave & 1, pr = wave >> 1;
  attn_build_plan(p, lds, tid);
  const int xg = (int)blockIdx.x & 7, jq = (int)blockIdx.x >> 3;
#pragma unroll 1
  for (int rr = 0; rr < 16; ++rr) {
    const int* e = (const int*)(lds + ATT_TAB) + rr * 8;
    const int cflag = __builtin_amdgcn_readfirstlane(e[4]), xend = __builtin_amdgcn_readfirstlane(e[5]), slot0 = __builtin_amdgcn_readfirstlane(e[3]);
    if (!cflag) continue;
    const int head = rr >> 2, qb = __builtin_amdgcn_readfirstlane(e[6]);
    f32x16 o[8]; float m, l;
    {
      const int slot = slot0;
      const float* ps = part_slot(p, slot) + wave * 8192 + lane;
#pragma unroll
      for (int dvb = 0; dvb < 8; ++dvb)
#pragma unroll
        for (int gi = 0; gi < 16; ++gi) o[dvb][gi] = ps[(dvb * 16 + gi) * 64];
      const float* ml = (const float*)(p.ws + WS_ML) + ((size_t)slot * 8 + wave) * 128 + lane;
      m = ml[0]; l = ml[64];
    }
    for (int xx = xg + 1; xx <= xend; ++xx) {
      const int slot = 2 * (jq * 8 + xx);
      const float* ml = (const float*)(p.ws + WS_ML) + ((size_t)slot * 8 + wave) * 128 + lane;
      const float ms = ml[0], ls = ml[64];
      const float mn = fmaxf(m, ms);
      const float a0 = __builtin_amdgcn_exp2f(m - mn), a1 = __builtin_amdgcn_exp2f(ms - mn);
      const float* ps = part_slot(p, slot) + wave * 8192 + lane;
#pragma unroll
      for (int dvb = 0; dvb < 8; ++dvb) {
#pragma unroll
        for (int gi = 0; gi < 16; ++gi) o[dvb][gi] = o[dvb][gi] * a0 + ps[(dvb * 16 + gi) * 64] * a1;
        asm volatile("" : "+v"(o[dvb]) :: "memory");
      }
      l = l * a0 + ls * a1; m = mn;
    }
    attn_finish(o, l, p, lds, tid, pr, comp, qb * 128, head);
  }
  __syncthreads();
}

__device__ __forceinline__ void p6_post_attn(const Params& p, const int g_wave64) {
  const float* x = p.in[0]; const float* gp = p.in[12]; const float* gf = p.in[13];
  const bf16_t* Mb = (const bf16_t*)(p.ws + WS_M); bf16_t* H = (bf16_t*)(p.ws + WS_H);
  OPAQUE_TID(tid); const int lane = tid & 63, wave = tid >> 6;
  for (int row = blockIdx.x * 8 + wave; row < SEQ; row += gridDim.x * 8) {
    f32x4 mv[8];
    float s = 0.f;
#pragma unroll
    for (int ii = 0; ii < 8; ++ii) { const u32x2 rw = *(const u32x2*)(Mb + (size_t)row * DM + ii * 256 + lane * 4); mv[ii] = (f32x4){bflo(rw[0]), bfhi(rw[0]), bflo(rw[1]), bfhi(rw[1])}; s += mv[ii][0] * mv[ii][0] + mv[ii][1] * mv[ii][1] + mv[ii][2] * mv[ii][2] + mv[ii][3] * mv[ii][3]; }
    s = wave_sum_l(s, lane);
    const float rs = rsqrtf(s * (1.0f / DM) + EPS);
    float s2 = 0.f;
#pragma unroll
    for (int ii = 0; ii < 8; ++ii) {
      const f32x4 xv = __builtin_nontemporal_load((const f32x4*)(x + (size_t)row * DM + ii * 256 + lane * 4));
      const f32x4 g = *(const f32x4*)(gp + ii * 256 + lane * 4);
      mv[ii] = xv + mv[ii] * rs * g;
      s2 += mv[ii][0] * mv[ii][0] + mv[ii][1] * mv[ii][1] + mv[ii][2] * mv[ii][2] + mv[ii][3] * mv[ii][3];
    }
    s2 = wave_sum_l(s2, lane);
    const float rs2 = rsqrtf(s2 * (1.0f / DM) + EPS);
#pragma unroll
    for (int ii = 0; ii < 8; ++ii) {
      const f32x4 g = *(const f32x4*)(gf + ii * 256 + lane * 4);
      const f32x4 hv = mv[ii] * rs2 * g;
      u32x2 w = {pk_bf16(hv[0], hv[1]), pk_bf16(hv[2], hv[3])};
      *(u32x2*)(H + (size_t)row * DM + ii * 256 + lane * 4) = w;
    }
  }
}

__device__ __forceinline__ void p10_final(const Params& p, const int g_wave64) {
  const float* x = p.in[0]; const float* gm = p.in[12]; const float* gp = p.in[18];
  const bf16_t* Mb = (const bf16_t*)(p.ws + WS_M); const bf16_t* F = (const bf16_t*)(p.ws + WS_F); float* out = p.out;
  OPAQUE_TID(tid); const int lane = tid & 63, wave = tid >> 6;
  for (int row = blockIdx.x * 8 + wave; row < SEQ; row += gridDim.x * 8) {
    f32x4 mv[8], fv[8];
    float s = 0.f, sm = 0.f;
#pragma unroll
    for (int ii = 0; ii < 8; ++ii) {
      const u32x2 rw = __builtin_nontemporal_load((const u32x2*)(F + (size_t)row * DM + ii * 256 + lane * 4)); fv[ii] = (f32x4){bflo(rw[0]), bfhi(rw[0]), bflo(rw[1]), bfhi(rw[1])};
      const u32x2 rm = *(const u32x2*)(Mb + (size_t)row * DM + ii * 256 + lane * 4); mv[ii] = (f32x4){bflo(rm[0]), bfhi(rm[0]), bflo(rm[1]), bfhi(rm[1])};
      s += fv[ii][0] * fv[ii][0] + fv[ii][1] * fv[ii][1] + fv[ii][2] * fv[ii][2] + fv[ii][3] * fv[ii][3];
      sm += mv[ii][0] * mv[ii][0] + mv[ii][1] * mv[ii][1] + mv[ii][2] * mv[ii][2] + mv[ii][3] * mv[ii][3];
    }
    s = wave_sum_l(s, lane); sm = wave_sum_l(sm, lane);
    const float rs = rsqrtf(s * (1.0f / DM) + EPS), rsm = rsqrtf(sm * (1.0f / DM) + EPS);
#pragma unroll
    for (int ii = 0; ii < 8; ++ii) {
      const f32x4 xv = __builtin_nontemporal_load((const f32x4*)(x + (size_t)row * DM + ii * 256 + lane * 4));
      const f32x4 g1 = *(const f32x4*)(gm + ii * 256 + lane * 4);
      const f32x4 g = *(const f32x4*)(gp + ii * 256 + lane * 4);
      __builtin_nontemporal_store((xv + mv[ii] * rsm * g1) + fv[ii] * rs * g, (f32x4*)(out + (size_t)row * DM + ii * 256 + lane * 4));
    }
  }
}
__device__ __forceinline__ void p8_fixup(const Params& p, const int g_wave64) {
  const float* SA0 = (const float*)(p.ws + WS_SA0); const float* SB0 = (const float*)(p.ws + WS_SB0); const float* SAL = (const float*)(p.ws + WS_SAL);
  bf16_t* G = (bf16_t*)(p.ws + WS_BUP); const float* cw = p.in[15]; const float* cb = p.in[16];
  OPAQUE_TID(tid);
  constexpr int nM = SEQ / 256, nN = DM / 256, nwg = nM * nN;
  int pmprev = -1;
  for (int L = (int)blockIdx.x; L < nwg; L += (int)gridDim.x) {
    int w = L; { const int q = nwg / NXCD, r = nwg % NXCD, x = w % NXCD, o = w / NXCD; w = (x < r ? x * (q + 1) : r * (q + 1) + (x - r) * q) + o; }
    const int nig = WGM * nN, gid = w / nig, fm = gid * WGM, gsz = min(nM - fm, WGM);
    const int pm = fm + ((w % nig) % gsz);
    if (pm == pmprev) continue;
    pmprev = pm;
    for (int el = tid; el < 2 * DFF; el += NT) {
      const int c = el % DFF, r = el / DFF, pr2 = pm * 2 + r;
      const float at = SA0[(size_t)pr2 * DFF + c];
      const float l0 = pm > 0 ? SAL[((size_t)(pm - 1) * 2 + 0) * DFF + c] : 0.f, l1 = pm > 0 ? SAL[((size_t)(pm - 1) * 2 + 1) * DFF + c] : 0.f;
      const float a1 = r ? SA0[(size_t)(pr2 - 1) * DFF + c] : l1, a2 = r ? l1 : l0;
      const float y = cw[c] * a2 + cw[DFF + c] * a1 + cw[2 * DFF + c] * at + cb[c];
      const float e = __builtin_amdgcn_exp2f(-2.302208198f * (y + 0.044715f * y * y * y));
      const float g = y * __builtin_amdgcn_rcpf(1.0f + e) * SB0[(size_t)pr2 * DFF + c];
      G[(size_t)(pm * 256 + r) * DFF + c] = (bf16_t)(pk_bf16(g, 0.f) & 0xffffu);
    }
  }
  asm volatile("s_waitcnt vmcnt(0)" ::: "memory");
  __syncthreads();
}

__device__ __forceinline__ void p8_conv_glu(const Params& p, const int g_wave64) {
  const bf16_t* Aup = (const bf16_t*)(p.ws + WS_AUP); bf16_t* Bup = (bf16_t*)(p.ws + WS_BUP);
  const float* cw = p.in[15]; const float* cb = p.in[16];
  constexpr int NCG = DFF / 8, RUN = 32, NRUN = SEQ / RUN;
  OPAQUE_TID(tid);
  for (int item = blockIdx.x * NT + tid; item < NCG * NRUN; item += gridDim.x * NT) {
    const int cgi = item % NCG, run = item / NCG, c0 = cgi * 8, t0 = run * RUN;
    float w0[8], w1[8], w2[8], bb[8], am2[8], am1[8];
#pragma unroll
    for (int j = 0; j < 8; ++j) { w0[j] = cw[c0 + j]; w1[j] = cw[DFF + c0 + j]; w2[j] = cw[2 * DFF + c0 + j]; bb[j] = cb[c0 + j]; am2[j] = 0.f; am1[j] = 0.f; }
    if (t0 >= 2) {
      const u32x4 v2 = *(const u32x4*)(Aup + (size_t)(t0 - 2) * DFF + c0), v1 = *(const u32x4*)(Aup + (size_t)(t0 - 1) * DFF + c0);
#pragma unroll
      for (int j = 0; j < 4; ++j) { am2[2 * j] = bflo(v2[j]); am2[2 * j + 1] = bfhi(v2[j]); am1[2 * j] = bflo(v1[j]); am1[2 * j + 1] = bfhi(v1[j]); }
    }
    for (int t = t0; t < t0 + RUN; ++t) {
      const u32x4 va = *(const u32x4*)(Aup + (size_t)t * DFF + c0);
      const u32x4 vb = *(const u32x4*)(Bup + (size_t)t * DFF + c0);
      float ac[8], bv[8], y[8];
#pragma unroll
      for (int j = 0; j < 4; ++j) { ac[2 * j] = bflo(va[j]); ac[2 * j + 1] = bfhi(va[j]); bv[2 * j] = bflo(vb[j]); bv[2 * j + 1] = bfhi(vb[j]); }
#pragma unroll
      for (int j = 0; j < 8; ++j) {
        const float a = w0[j] * am2[j] + w1[j] * am1[j] + w2[j] * ac[j] + bb[j];
        const float uu = 0.7978845608028654f * (a + 0.044715f * a * a * a);
        const float th = 1.0f - 2.0f / (1.0f + __expf(2.0f * uu));
        y[j] = 0.5f * a * (1.0f + th) * bv[j];
        am2[j] = am1[j]; am1[j] = ac[j];
      }
      u32x4 w = {pk_bf16(y[0], y[1]), pk_bf16(y[2], y[3]), pk_bf16(y[4], y[5]), pk_bf16(y[6], y[7])};
      *(u32x4*)(Bup + (size_t)t * DFF + c0) = w;
    }
  }
}


#define XB_TMO      128
#define XB_XCNT(j)  (256  + 64 * (j))
#define XB_XSUB(j)  (1280 + 64 * (j))
#define XB_XGEN(j)  (2304 + 64 * (j))
#define XB_TOP      3328
#define XB_TOPGEN   3392
#define XCD_BAR_WORDS 3456
#define XB_SPIN_CAP (1u << 18)
DI unsigned xb_ld(unsigned* p) { return __hip_atomic_load(p, __ATOMIC_RELAXED, __HIP_MEMORY_SCOPE_AGENT); }
DI unsigned xb_add(unsigned* p, unsigned v) { return __hip_atomic_fetch_add(p, v, __ATOMIC_RELAXED, __HIP_MEMORY_SCOPE_AGENT); }
DI unsigned xb_xcc_id() { return (unsigned)__builtin_amdgcn_s_getreg((3 << 11) | 20) & 0xFu; }
#define XB_SPIN(cond, bar) do { unsigned _sp = 0; while (cond) { __builtin_amdgcn_s_sleep(1); \
    if ((++_sp & 255u) == 0u) { if (xb_ld(&(bar)[XB_TMO])) break; if (_sp > XB_SPIN_CAP) { atomicAdd(&(bar)[XB_TMO], 1u); break; } } } } while (0)
DI void xcd_barrier_complete(unsigned* bar, unsigned x, unsigned& nloc, unsigned& nx) {
  const unsigned G = gridDim.x;
  unsigned sum, cnt, mine, sp = 0u;
  for (;;) {
    sum = 0u; cnt = 0u; mine = 0u;
#pragma unroll
    for (unsigned j = 0; j < 16; ++j) { const unsigned c = xb_ld(&bar[XB_XCNT(j)]); sum += c; cnt += (c > 0u) ? 1u : 0u; mine = (j == x) ? c : mine; }
    if (sum == G) break;
    __builtin_amdgcn_s_sleep(1);
    if ((++sp & 255u) == 0u) { if (xb_ld(&bar[XB_TMO])) break; if (sp > XB_SPIN_CAP) { atomicAdd(&bar[XB_TMO], 1u); break; } }
  }
  nloc = mine > 0u ? mine : 1u; nx = cnt > 0u ? cnt : 1u;
}
__device__ __forceinline__ void xcd_barrier(unsigned* bar, volatile LAS unsigned* st) {
  asm volatile("s_waitcnt vmcnt(0)" ::: "memory");
  __syncthreads();
  if (threadIdx.x == 0) {
    const unsigned x = xb_xcc_id();
    __builtin_amdgcn_s_waitcnt(0);
    unsigned nloc = st[0], nx = st[1];
    if (nloc == 0u) { xcd_barrier_complete(bar, x, nloc, nx); st[0] = nloc; st[1] = nx; }
    const unsigned old = xb_add(&bar[XB_XSUB(x)], 1u);
    const unsigned gen = old / nloc;
    if (old + 1u == (gen + 1u) * nloc) {
      __builtin_amdgcn_fence(__ATOMIC_RELEASE, "agent");
      asm volatile("s_waitcnt vmcnt(0)" ::: "memory");
      const unsigned og = xb_add(&bar[XB_TOP], 1u);
      const unsigned tg = og / nx;
      if (og + 1u == (tg + 1u) * nx) xb_add(&bar[XB_TOPGEN], 1u);
      else XB_SPIN(xb_ld(&bar[XB_TOPGEN]) == tg, bar);
      __builtin_amdgcn_fence(__ATOMIC_ACQUIRE, "agent");
      xb_add(&bar[XB_XGEN(x)], 1u);
      asm volatile("s_waitcnt vmcnt(0)" ::: "memory");
    } else {
      XB_SPIN(xb_ld(&bar[XB_XGEN(x)]) == gen, bar);
      __builtin_amdgcn_fence(__ATOMIC_ACQUIRE, "agent");
      asm volatile("s_waitcnt vmcnt(0)" ::: "memory");
    }
  }
  __syncthreads();
}
__global__ void __launch_bounds__(NT, 2) mega(Params p) {
  cg::grid_group grid = cg::this_grid();
  extern __shared__ __attribute__((aligned(16))) unsigned char lds_all[];
  volatile LAS unsigned* xb_st = (volatile LAS unsigned*)((LAS unsigned char*)lds_all + (LDS_BYTES - 16));
  unsigned* xb_bar = (unsigned*)(p.ws + WS_BAR);
  if (threadIdx.x == 0) { xb_st[0] = 0u; xb_st[1] = 0u; (void)xb_add(&xb_bar[XB_XCNT(xb_xcc_id())], 1u); }
  __syncthreads();
  const int g_wave64 = __builtin_amdgcn_readfirstlane((int)threadIdx.x & ~63);
  unsigned char* ws = p.ws;
  bf16_t* H = (bf16_t*)(ws + WS_H);
#ifndef PH
#define PH -1
#endif
#define ON(k) (PH < 0 || PH == (k))
  if (ON(0)) { p0_norm_ga(p, g_wave64); }
  if (ON(1)) { p0_transposes(p, g_wave64); }
  if (p.ws == nullptr) grid.sync();
  xcd_barrier(xb_bar, xb_st);
  if (ON(2)) {
  gemm_phase<false, SEQ, 4096, DM, 4096, 1 << 20>(H, (const bf16_t*)(ws + WS_WIN), ws + WS_PROJ, ws + WS_PROJ, g_wave64);
  gemm_phase<false, 2048, SEQ, DM, SEQ, 1 << 20>((const bf16_t*)(ws + WS_WV), H, ws + WS_VT, ws + WS_VT, g_wave64);
  }
  xcd_barrier(xb_bar, xb_st);
  if (ON(3)) { attn_norms(p, g_wave64); gla_g1(p, g_wave64); }
  xcd_barrier(xb_bar, xb_st);
  if (ON(4)) gla_g2(p, g_wave64);
  xcd_barrier(xb_bar, xb_st);
  if (ON(5)) gla_g3(p, g_wave64);
  if (ON(6)) { attn_phase(p, g_wave64); xcd_barrier(xb_bar, xb_st); attn_combine(p, g_wave64); }
  xcd_barrier(xb_bar, xb_st);
  if (ON(7)) gemm_phase<false, SEQ, DM, DM, DM, 1 << 20>((const bf16_t*)(ws + WS_O), (const bf16_t*)(ws + WS_WO), ws + WS_M, ws + WS_M, g_wave64);
  xcd_barrier(xb_bar, xb_st);
  if (ON(8)) p6_post_attn(p, g_wave64);
  xcd_barrier(xb_bar, xb_st);
  if (ON(2)) gemm_phase<false, SEQ, 2 * DFF, DM, DFF, 1 << 20, 2>(H, (const bf16_t*)(ws + WS_WFI), ws + WS_BUP, ws + WS_BUP, g_wave64,
                                                                ConvEpi{p.in[15], p.in[16], (float*)(ws + WS_SA0), (float*)(ws + WS_SB0), (float*)(ws + WS_SAL)});
  xcd_barrier(xb_bar, xb_st);
  if (ON(9)) p8_fixup(p, g_wave64);
  if (ON(7)) gemm_phase<false, SEQ, DM, DFF, DM, 1 << 20>((const bf16_t*)(ws + WS_BUP), (const bf16_t*)(ws + WS_WFO), ws + WS_F, ws + WS_F, g_wave64);
  xcd_barrier(xb_bar, xb_st);
  if (ON(10)) p10_final(p, g_wave64);
}

extern "C" void kernel_launch(void* const* d_in, const int* in_sizes, int n_in, void* d_out, int out_size, void* d_ws, size_t ws_size,
                              hipStream_t stream) {
  static int grid_blocks = 0;
  if (!grid_blocks) {
    int dev = 0, cus = 0, per_cu = 0;
    hipGetDevice(&dev);
    hipDeviceGetAttribute(&cus, hipDeviceAttributeMultiprocessorCount, dev);
    hipFuncSetAttribute((const void*)mega, hipFuncAttributeMaxDynamicSharedMemorySize, LDS_BYTES);
    hipOccupancyMaxActiveBlocksPerMultiprocessor(&per_cu, (const void*)mega, NT, LDS_BYTES);
    (void)hipGetLastError();
    if (per_cu < 1) per_cu = 1;
    grid_blocks = 256;
    if (cus != 256) fprintf(stderr, "kernel_launch: built for 256 CUs, device reports %d\n", cus);
    if (ws_size < WS_END2) fprintf(stderr, "kernel_launch: workspace too small: %zu < %zu\n", ws_size, (size_t)WS_END);
  }
  Params p{};
  for (int i = 0; i < 19; ++i) p.in[i] = (const float*)d_in[i];
  p.out = (float*)d_out; p.ws = (unsigned char*)d_ws;
  (void)hipMemsetAsync((unsigned char*)d_ws + WS_BAR, 0, 16384 + 128, stream);
  void* args[] = {&p};
  hipError_t e = hipLaunchCooperativeKernel((const void*)mega, dim3(grid_blocks), dim3(NT), args, LDS_BYTES, stream);
  if (e != hipSuccess) fprintf(stderr, "cooperative launch failed: %s (grid %d)\n", hipGetErrorString(e), grid_blocks);
}
```

```cpp
#include <hip/hip_runtime.h>
#include <hip/hip_cooperative_groups.h>
#include <cstdio>
#include <cstdint>
namespace cg = cooperative_groups;

typedef unsigned short bf16_t;
typedef short bf16x8 __attribute__((ext_vector_type(8)));
typedef float f32x2 __attribute__((ext_vector_type(2)));
typedef float f32x4 __attribute__((ext_vector_type(4)));
typedef float f32x16 __attribute__((ext_vector_type(16)));
typedef unsigned u32x2 __attribute__((ext_vector_type(2)));
typedef unsigned u32x4 __attribute__((ext_vector_type(4)));
typedef __bf16 bf2_t __attribute__((ext_vector_type(2)));

#define DI __device__ __forceinline__
#define OPAQUE_TID(t) int t; asm volatile("v_mbcnt_lo_u32_b32 %0, -1, 0\n\tv_mbcnt_hi_u32_b32 %0, -1, %0\n\tv_add_u32 %0, %1, %0" : "=&v"(t) : "s"(g_wave64))
#define LAS __attribute__((address_space(3)))
#define LDSP(p) ((LAS unsigned*)(p))

constexpr int SEQ = 16384, DM = 2048, DFF = 5632, INC = 6160;
#ifndef OVH
#define OVH 6
#endif
#ifndef KR
#define KR 6
#endif
#ifndef VR
#define VR 8
#endif
constexpr int NT = 512;
constexpr int LDS_BYTES = 147456;
constexpr float EPS = 1e-6f;
constexpr float LOG2E = 1.4426950408889634f;

constexpr size_t MB = 1048576;
constexpr size_t WS_BAR = 1 * MB + 768 * 1024, WS_NRM = WS_BAR + 16384, WS_ML = 484 * MB, WS_SA0 = 486 * MB, WS_SB0 = 489 * MB, WS_SAL = 492 * MB, WS_END2 = 495 * MB;
constexpr size_t WS_GA = 0, WS_GDEC = 1 * MB, WS_WFI = 2 * MB, WS_WFO = 46 * MB, WS_H = 68 * MB, WS_R = 132 * MB;
constexpr size_t WS_WIN = WS_R, WS_WV = WS_R + 16 * MB, WS_WO = WS_R + 24 * MB, WS_PROJ = WS_R + 32 * MB, WS_VT = WS_R + 160 * MB,
                 WS_O = WS_R + 224 * MB, WS_PART2 = WS_R + 288 * MB, WS_M = WS_PROJ, WS_AUP = WS_R, WS_BUP = WS_R + 176 * MB, WS_F = WS_R + 96 * MB, WS_END = WS_R + 352 * MB;

struct Params { const float* in[19]; float* out; unsigned char* ws; };

DI unsigned pk_bf16(float lo, float hi) { f32x2 v = {lo, hi}; bf2_t r = __builtin_convertvector(v, bf2_t); return __builtin_bit_cast(unsigned, r); }
DI float bf2f(bf16_t u) { return __uint_as_float(((unsigned)u) << 16); }
DI float bflo(unsigned u) { return __uint_as_float(u << 16); }
DI float bfhi(unsigned u) { return __uint_as_float(u & 0xffff0000u); }
DI f32x16 mfma32(bf16x8 a, bf16x8 b, f32x16 c) { return __builtin_amdgcn_mfma_f32_32x32x16_bf16(a, b, c, 0, 0, 0); }
DI float shx(float v, const int mask, const int lane) { return __builtin_bit_cast(float, __builtin_amdgcn_ds_bpermute((lane ^ mask) << 2, __builtin_bit_cast(int, v))); }
DI float wave_sum_l(float v, const int lane) { for (int o = 32; o > 0; o >>= 1) v += __builtin_bit_cast(float, __builtin_amdgcn_ds_bpermute((lane ^ o) << 2, __builtin_bit_cast(int, v))); return v; }
DI float wave_sum(float v) { for (int o = 32; o > 0; o >>= 1) v += __shfl_xor(v, o); return v; }
DI bf16x8 pack8(float a0, float a1, float a2, float a3, float a4, float a5, float a6, float a7) {
  u32x4 p = {pk_bf16(a0, a1), pk_bf16(a2, a3), pk_bf16(a4, a5), pk_bf16(a6, a7)}; return __builtin_bit_cast(bf16x8, p);
}
DI int perm32(int rho) { const int n = rho >> 4, i = rho & 15; return 8 * (i >> 2) + 4 * n + (i & 3); }
DI float* part_slot(const Params& p, const int slot) { return slot < 256 ? p.out + (size_t)slot * 65536 : (float*)(p.ws + WS_PART2) + (size_t)(slot - 256) * 65536; }
DI int perm23(int r) { return (r & ~12) | ((r & 4) << 1) | ((r & 8) >> 1); }

constexpr int BM = 256, BK = 64, HALF = 128, HT = HALF * BK, NXCD = 8, WGM = 8;
DI int lds_byte(int r, int c) { int st = (r >> 4) * 2 + (c >> 5), rr = r & 15, cc = c & 31, ob = rr * 64 + cc * 2; return st * 1024 + (ob ^ (((ob >> 9) & 1) << 5)); }
DI void stage_rc(int b, int& R, int& C) { int st = b / 1024, sb = b % 1024, swz = sb ^ (((sb >> 9) & 1) << 5); R = (st >> 1) * 16 + swz / 64; C = (st & 1) * 32 + (swz % 64) / 2; }

struct ConvEpi { const float* cw; const float* cb; float* sa0; float* sb0; float* sal; };
template <bool OUT_F32, int M, int N, int K, int ldc, int split_pn, int EPI = 0>
__device__ __forceinline__ void gemm_phase(const bf16_t* __restrict__ A, const bf16_t* __restrict__ Bt, void* out0, void* out1, const int g_wave64, const ConvEpi ce = ConvEpi{}) {
  OPAQUE_TID(tidx);
  extern __shared__ __attribute__((aligned(16))) unsigned char shm_raw[];
  LAS unsigned char* ldsb = (LAS unsigned char*)shm_raw;
#define SA(b, h) (((b) * 2 + (h)) * (HT * 2))
#define SB(b, h) ((4 + (b) * 2 + (h)) * (HT * 2))
#define STAGE(P, BASE, br, kt) do { const char* _gb = (const char*)(BASE) + ((size_t)(br) * K + (size_t)(kt) * BK) * 2; \
      __builtin_amdgcn_global_load_lds((const unsigned*)(_gb + so0), (LAS unsigned*)(ldsb + (P) + ldsw), 16, 0, 0); \
      __builtin_amdgcn_global_load_lds((const unsigned*)(_gb + so1), (LAS unsigned*)(ldsb + (P) + ldsw + 8192), 16, 0, 0); } while (0)
#define STAGEB(P, BASE, br, kt) do { const char* _gb = (const char*)(BASE) + ((size_t)(br) * K + (size_t)(kt) * BK) * 2; \
      __builtin_amdgcn_global_load_lds((const unsigned*)(_gb + sb0), (LAS unsigned*)(ldsb + (P) + ldsw), 16, 0, 0); \
      __builtin_amdgcn_global_load_lds((const unsigned*)(_gb + sb1), (LAS unsigned*)(ldsb + (P) + ldsw + 8192), 16, 0, 0); } while (0)
#define LDA(dst, b, h) _Pragma("unroll") for (int m = 0; m < 4; ++m) _Pragma("unroll") for (int k = 0; k < 2; ++k) \
    dst[m][k] = *(const LAS bf16x8*)(ldsb + SA(b, h) + aoff + m * 2048 + k * 1024)
#define LDB(dst, b, h) _Pragma("unroll") for (int n = 0; n < 2; ++n) _Pragma("unroll") for (int k = 0; k < 2; ++k) \
    dst[n][k] = *(const LAS bf16x8*)(ldsb + SB(b, h) + boff + n * 2048 + k * 1024)
#define MMA(ai, bj, At, Bq) do { __builtin_amdgcn_s_setprio(1); \
    _Pragma("unroll") for (int m = 0; m < 4; ++m) _Pragma("unroll") for (int n = 0; n < 2; ++n) _Pragma("unroll") for (int k = 0; k < 2; ++k) \
      acc[ai][bj][m][n] = __builtin_amdgcn_mfma_f32_16x16x32_bf16(Bq[n][k], At[m][k], acc[ai][bj][m][n], 0, 0, 0); \
    __builtin_amdgcn_s_setprio(0); } while (0)
#define WAIT_V(n) asm volatile("s_waitcnt vmcnt(" #n ")" ::: "memory")
#define WAIT_L(n) asm volatile("s_waitcnt lgkmcnt(" #n ")" ::: "memory")
#define BAR __builtin_amdgcn_s_barrier()
#define SCHED __builtin_amdgcn_sched_barrier(0)
  const int nM = M / BM, nN = N / BM, nwg = nM * nN;
  const int wid = __builtin_amdgcn_readfirstlane(tidx >> 6), lane = tidx & 63, wr = wid >> 2, wc = wid & 3, fr = lane & 15, fq = lane >> 4;
  constexpr int nt = K / BK;
  unsigned so0, so1, sb0, sb1;
  { int _r, _c; stage_rc(tidx * 16, _r, _c); so0 = (unsigned)(_r * K + _c) * 2u; sb0 = (unsigned)(((_r & ~31) + perm32(_r & 31)) * K + _c) * 2u;
    stage_rc(tidx * 16 + 8192, _r, _c); so1 = (unsigned)(_r * K + _c) * 2u; sb1 = (unsigned)(((_r & ~31) + perm32(_r & 31)) * K + _c) * 2u; }
  const unsigned ldsw = (unsigned)wid * 1024u;
  const int aoff = lds_byte(wr * 64 + fr, fq * 8), boff = lds_byte(wc * 32 + fr, fq * 8);
#define UNIT_OF(L, PM, PN) do { int _w = (L); { const int _q = nwg / NXCD, _r = nwg % NXCD, _x = _w % NXCD, _o = _w / NXCD; _w = (_x < _r ? _x * (_q + 1) : _r * (_q + 1) + (_x - _r) * _q) + _o; } \
    const int _nig = WGM * nN, _gid = _w / _nig, _fm = _gid * WGM, _gsz = min(nM - _fm, WGM); PM = _fm + ((_w % _nig) % _gsz); PN = (_w % _nig) / _gsz; } while (0)
  if ((int)blockIdx.x < nwg) {
    int pm, pn; UNIT_OF((int)blockIdx.x, pm, pn);
    int brow = pm * BM, bcol = pn * BM;
    __syncthreads();
    f32x4 acc[2][2][4][2] = {};
    bf16x8 At[4][2], B0[2][2], B1[2][2];
    STAGEB(SB(0, 0), Bt, bcol, 0); STAGEB(SB(0, 1), Bt, bcol + HALF, 0); STAGE(SA(0, 0), A, brow, 0); STAGE(SA(0, 1), A, brow + HALF, 0);
    if (wr == 1) BAR;
    WAIT_V(2); BAR;
    STAGEB(SB(1, 0), Bt, bcol, 1); STAGE(SA(1, 0), A, brow, 1); STAGEB(SB(1, 1), Bt, bcol + HALF, 1);
    WAIT_V(6); BAR;
    for (int it = 0;; ++it) {
      const int Ln = (it + 1) * (int)gridDim.x + (int)blockIdx.x;
      const bool has_next = Ln < nwg;
      int npm = pm, npn = pn; if (has_next) UNIT_OF(Ln, npm, npn);
      const int nbrow = npm * BM, nbcol = npn * BM;
      for (int t = 0; t < nt; t += 2) {
        const bool last = (t == nt - 2);
        const int r2 = last ? nbrow : brow, c2 = last ? nbcol : bcol, k2 = last ? 0 : t + 2, k3 = k2 + 1;
        LDB(B0, 0, 0); LDB(B1, 0, 1); SCHED; LDA(At, 0, 0); STAGE(SA(1, 1), A, brow + HALF, t + 1);
        WAIT_V(8); WAIT_L(0); BAR; MMA(0, 0, At, B0); MMA(0, 1, At, B1); BAR; SCHED;
        LDA(At, 0, 1); STAGEB(SB(0, 0), Bt, c2, k2); STAGEB(SB(0, 1), Bt, c2 + HALF, k2); STAGE(SA(0, 0), A, r2, k2);
        WAIT_V(8); WAIT_L(0); BAR; MMA(1, 0, At, B0); MMA(1, 1, At, B1); BAR; SCHED;
        LDB(B0, 1, 0); LDB(B1, 1, 1); SCHED; LDA(At, 1, 0); STAGE(SA(0, 1), A, r2 + HALF, k2);
        WAIT_V(8); WAIT_L(0); BAR; MMA(0, 0, At, B0); MMA(0, 1, At, B1); BAR; SCHED;
        LDA(At, 1, 1); STAGEB(SB(1, 0), Bt, c2, k3); STAGEB(SB(1, 1), Bt, c2 + HALF, k3); STAGE(SA(1, 0), A, r2, k3);
        WAIT_V(8); WAIT_L(0); BAR; MMA(1, 0, At, B0); MMA(1, 1, At, B1); BAR; SCHED;
      }
      if (wr == 0) BAR;
      if constexpr (EPI == 2) {
        LAS float* halo = (LAS float*)(ldsb + 133120);
        const int cl = wc * 32 + fq * 8;
        float w0[8], w1[8], w2[8], cbv[8];
        {
          const float* wp = ce.cw + 128 * pn + cl; const float* bp = ce.cb + 128 * pn + cl;
#pragma unroll
          for (int x4 = 0; x4 < 2; ++x4) { const f32x4 a0 = *(const f32x4*)(wp + 4 * x4), a1 = *(const f32x4*)(wp + DFF + 4 * x4), a2 = *(const f32x4*)(wp + 2 * DFF + 4 * x4), a3 = *(const f32x4*)(bp + 4 * x4);
#pragma unroll
            for (int j = 0; j < 4; ++j) { w0[x4 * 4 + j] = a0[j]; w1[x4 * 4 + j] = a1[j]; w2[x4 * 4 + j] = a2[j]; cbv[x4 * 4 + j] = a3[j]; } }
        }
        if (fr >= 14) {
#pragma unroll
          for (int ai = 0; ai < 2; ++ai) { LAS float* hp = halo + ((ai * 2 + wr) * 2 + (fr - 14)) * 128 + cl; *(LAS f32x4*)hp = acc[ai][0][3][0]; *(LAS f32x4*)(hp + 4) = acc[ai][0][3][1]; }
          if (wr == 1) { float* sp = ce.sal + ((size_t)pm * 2 + (fr - 14)) * DFF + 128 * pn + cl; *(f32x4*)sp = acc[1][0][3][0]; *(f32x4*)(sp + 4) = acc[1][0][3][1]; }
        }
        if (wr == 0 && fr < 2) {
          float* sp = ce.sa0 + ((size_t)pm * 2 + fr) * DFF + 128 * pn + cl; *(f32x4*)sp = acc[0][0][0][0]; *(f32x4*)(sp + 4) = acc[0][0][0][1];
          float* sq = ce.sb0 + ((size_t)pm * 2 + fr) * DFF + 128 * pn + cl; *(f32x4*)sq = acc[0][1][0][0]; *(f32x4*)(sq + 4) = acc[0][1][0][1];
        }
        WAIT_L(0); BAR;
        bf16_t* gp = (bf16_t*)out0 + (size_t)(brow + wr * 64 + fr) * DFF + 128 * pn + cl;
#pragma unroll
        for (int ai = 0; ai < 2; ++ai) {
          const int blk = ai * 2 + wr;
          float h62[8], h63[8];
          if (blk > 0) {
            const LAS float* hq = halo + ((blk - 1) * 2) * 128 + cl;
            const f32x4 q0 = *(const LAS f32x4*)hq, q1 = *(const LAS f32x4*)(hq + 4), q2 = *(const LAS f32x4*)(hq + 128), q3 = *(const LAS f32x4*)(hq + 132);
#pragma unroll
            for (int j = 0; j < 4; ++j) { h62[j] = q0[j]; h62[4 + j] = q1[j]; h63[j] = q2[j]; h63[4 + j] = q3[j]; }
          } else {
#pragma unroll
            for (int j = 0; j < 8; ++j) { h62[j] = 0.f; h63[j] = 0.f; }
          }
#pragma unroll
          for (int m = 0; m < 4; ++m) {
            float gv[8];
#pragma unroll
            for (int x = 0; x < 8; ++x) {
              const float cur = acc[ai][0][m][x >> 2][x & 3], bb = acc[ai][1][m][x >> 2][x & 3];
              int o1, o2;
              if (m == 0) { o1 = __float_as_int(h63[x]); o2 = __float_as_int(fr == 0 ? h62[x] : h63[x]); }
              else { const int pv = __float_as_int(acc[ai][0][m - 1][x >> 2][x & 3]);
                     o1 = __builtin_amdgcn_update_dpp(pv, pv, 0x121, 0xf, 0xf, false); o2 = __builtin_amdgcn_update_dpp(pv, pv, 0x122, 0xf, 0xf, false); }
              const float a1 = __int_as_float(__builtin_amdgcn_update_dpp(o1, __float_as_int(cur), 0x111, 0xf, 0xf, false));
              const float a2 = __int_as_float(__builtin_amdgcn_update_dpp(o2, __float_as_int(cur), 0x112, 0xf, 0xf, false));
              const float y = w0[x] * a2 + w1[x] * a1 + w2[x] * cur + cbv[x];
              const float e = __builtin_amdgcn_exp2f(-2.302208198f * (y + 0.044715f * y * y * y));
              gv[x] = y * __builtin_amdgcn_rcpf(1.0f + e) * bb;
            }
            if (!(blk == 0 && m == 0 && fr < 2)) {
              u32x4 w = {pk_bf16(gv[0], gv[1]), pk_bf16(gv[2], gv[3]), pk_bf16(gv[4], gv[5]), pk_bf16(gv[6], gv[7])};
              *(u32x4*)(gp + (size_t)(ai * HALF + m * 16) * DFF) = w;
            }
          }
        }
#pragma unroll
        for (int ai = 0; ai < 2; ++ai)
#pragma unroll
          for (int bj = 0; bj < 2; ++bj)
#pragma unroll
            for (int m = 0; m < 4; ++m) { acc[ai][bj][m][0] = (f32x4){0.f, 0.f, 0.f, 0.f}; acc[ai][bj][m][1] = (f32x4){0.f, 0.f, 0.f, 0.f}; }
      } else {
      constexpr int ES = OUT_F32 ? 4 : 2;
      char* rp = (char*)((pn < split_pn) ? out0 : out1) +
                 ((size_t)(brow + wr * 64 + fr) * ldc + (size_t)(((pn < split_pn) ? bcol : bcol - split_pn * BM) + wc * 32 + fq * 8)) * ES;
#pragma unroll
      for (int ai = 0; ai < 2; ++ai) {
#pragma unroll
        for (int m = 0; m < 4; ++m) {
#pragma unroll
          for (int bj = 0; bj < 2; ++bj) {
            const f32x4 v0 = acc[ai][bj][m][0], v1 = acc[ai][bj][m][1];
            if (OUT_F32) { *(f32x4*)(rp + (bj * HALF) * ES) = v0; *(f32x4*)(rp + (bj * HALF + 4) * ES) = v1; }
            else { u32x4 w = {pk_bf16(v0[0], v0[1]), pk_bf16(v0[2], v0[3]), pk_bf16(v1[0], v1[1]), pk_bf16(v1[2], v1[3])}; *(u32x4*)(rp + (bj * HALF) * ES) = w; }
            acc[ai][bj][m][0] = (f32x4){0.f, 0.f, 0.f, 0.f}; acc[ai][bj][m][1] = (f32x4){0.f, 0.f, 0.f, 0.f};
          }
          rp += (size_t)16 * ldc * ES;
          asm volatile("" : "+v"(rp));
        }
        rp += (size_t)(HALF - 64) * ldc * ES;
      }
      }
      if (!has_next) break;
      pm = npm; pn = npn; brow = nbrow; bcol = nbcol;
      if (wr == 1) BAR;
    }
    WAIT_V(0);
    BAR;
  }
#undef UNIT_OF
  __syncthreads();
#undef SA
#undef SB
#undef STAGE
#undef STAGEB
#undef LDA
#undef LDB
#undef MMA
}

__device__ __forceinline__ void p0_norm_ga(const Params& p, const int g_wave64) {
  extern __shared__ __attribute__((aligned(16))) float ldsf[];
  const float* x = p.in[0]; const float* g = p.in[1]; const float* w_in = p.in[2];
  bf16_t* H = (bf16_t*)(p.ws + WS_H); float* GA = (float*)(p.ws + WS_GA);
  OPAQUE_TID(tid); const int lane = tid & 63, wave = tid >> 6;
  for (int idx = tid; idx < 32768; idx += NT) { const int k = idx >> 4, j = idx & 15; ldsf[j * 2052 + k] = w_in[(size_t)k * INC + 3072 + j]; }
  __syncthreads();
  for (int rb = blockIdx.x; rb < SEQ / 64; rb += gridDim.x) {
    for (int rp = 0; rp < 4; ++rp) {
      const int row0 = rb * 64 + wave * 8 + rp * 2;
      f32x4 xv[2][8];
#pragma unroll
      for (int q = 0; q < 2; ++q)
#pragma unroll
        for (int ii = 0; ii < 8; ++ii) xv[q][ii] = *(const f32x4*)(x + (size_t)(row0 + q) * DM + ii * 256 + lane * 4);
      float rs[2];
#pragma unroll
      for (int q = 0; q < 2; ++q) {
        float s = 0.f;
#pragma unroll
        for (int ii = 0; ii < 8; ++ii) s += xv[q][ii][0] * xv[q][ii][0] + xv[q][ii][1] * xv[q][ii][1] + xv[q][ii][2] * xv[q][ii][2] + xv[q][ii][3] * xv[q][ii][3];
        s = wave_sum_l(s, lane); rs[q] = rsqrtf(s * (1.0f / DM) + EPS);
      }
#pragma unroll
      for (int ii = 0; ii < 8; ++ii) {
        const f32x4 gv = *(const f32x4*)(g + ii * 256 + lane * 4);
#pragma unroll
        for (int q = 0; q < 2; ++q) {
          xv[q][ii] = xv[q][ii] * rs[q] * gv;
          u32x2 w = {pk_bf16(xv[q][ii][0], xv[q][ii][1]), pk_bf16(xv[q][ii][2], xv[q][ii][3])};
          *(u32x2*)(H + (size_t)(row0 + q) * DM + ii * 256 + lane * 4) = w;
        }
      }
      float a0[16], a1[16];
#pragma unroll
      for (int j = 0; j < 16; ++j) {
        float s0 = 0.f, s1 = 0.f;
#pragma unroll
        for (int ii = 0; ii < 8; ++ii) {
          const f32x4 wv = *(const f32x4*)(ldsf + j * 2052 + ii * 256 + lane * 4);
          s0 += xv[0][ii][0] * wv[0] + xv[0][ii][1] * wv[1] + xv[0][ii][2] * wv[2] + xv[0][ii][3] * wv[3];
          s1 += xv[1][ii][0] * wv[0] + xv[1][ii][1] * wv[1] + xv[1][ii][2] * wv[2] + xv[1][ii][3] * wv[3];
        }
        a0[j] = s0; a1[j] = s1;
        asm volatile("" : "+v"(a0[j]), "+v"(a1[j]) :: "memory");
      }
#define BFLY(N, MASK) _Pragma("unroll") for (int i = 0; i < (N) / 2; ++i) { const bool up = (lane & (MASK)) != 0; \
        const float sd0 = up ? a0[i] : a0[i + (N) / 2], kp0 = up ? a0[i + (N) / 2] : a0[i]; a0[i] = kp0 + shx(sd0, (MASK), lane); \
        const float sd1 = up ? a1[i] : a1[i + (N) / 2], kp1 = up ? a1[i + (N) / 2] : a1[i]; a1[i] = kp1 + shx(sd1, (MASK), lane); }
      BFLY(16, 32) BFLY(8, 16) BFLY(4, 8) BFLY(2, 4)
#undef BFLY
      float g0 = a0[0], g1 = a1[0];
      g0 += shx(g0, 2, lane); g1 += shx(g1, 2, lane);
      g0 += shx(g0, 1, lane); g1 += shx(g1, 1, lane);
      if ((lane & 3) == 0) { const int j = ((lane >> 5) & 1) * 8 + ((lane >> 4) & 1) * 4 + ((lane >> 3) & 1) * 2 + ((lane >> 2) & 1); GA[(size_t)row0 * 16 + j] = g0; GA[(size_t)(row0 + 1) * 16 + j] = g1; }
    }
  }
  __syncthreads();
}

struct TSeg { const float* src; int ld, col0, ncols, K; bf16_t* dst; };
__device__ __forceinline__ void p0_transposes(const Params& p, const int g_wave64) {
  extern __shared__ __attribute__((aligned(16))) float ldsf[];
  OPAQUE_TID(tid);
  const int ntile[8] = {32 * 16, 32 * 16, 32 * 32, 32 * 16, 32 * 16, 32 * 32, 32 * 176, 88 * 32};
  int total = 0;
  for (int i = 0; i < 8; ++i) total += ntile[i];
  const int lane = tid & 63, wave = __builtin_amdgcn_readfirstlane(tid >> 6);
  for (int tix = blockIdx.x * 8 + wave; tix < total; tix += gridDim.x * 8) {
    int s = 0, rem = tix;
    while (rem >= ntile[s]) { rem -= ntile[s]; ++s; }
    const float* src; int ld, col0, nct, K; bf16_t* dst;
    bf16_t* WinT = (bf16_t*)(p.ws + WS_WIN); bf16_t* WvT = (bf16_t*)(p.ws + WS_WV);
    switch (s) {
      case 0: src = p.in[2]; ld = INC; col0 = 0; nct = 16; K = 2048; dst = WinT; break;
      case 1: src = p.in[2]; ld = INC; col0 = 2048; nct = 16; K = 2048; dst = WinT + (size_t)1024 * 2048; break;
      case 2: src = p.in[2]; ld = INC; col0 = 3088; nct = 32; K = 2048; dst = WinT + (size_t)2048 * 2048; break;
      case 3: src = p.in[2]; ld = INC; col0 = 1024; nct = 16; K = 2048; dst = WvT; break;
      case 4: src = p.in[2]; ld = INC; col0 = 5136; nct = 16; K = 2048; dst = WvT + (size_t)1024 * 2048; break;
      case 5: src = p.in[11]; ld = 2048; col0 = 0; nct = 32; K = 2048; dst = (bf16_t*)(p.ws + WS_WO); break;
      case 6: src = p.in[14]; ld = 2 * DFF; col0 = 0; nct = 176; K = 2048; dst = (bf16_t*)(p.ws + WS_WFI); break;
      default: src = p.in[17]; ld = 2048; col0 = 0; nct = 32; K = DFF; dst = (bf16_t*)(p.ws + WS_WFO); break;
    }
    const int kt = rem / nct, ct = rem % nct;
    float* t = ldsf + wave * (64 * 65);
    f32x4 v[16];
#pragma unroll
    for (int i = 0; i < 16; ++i) v[i] = *(const f32x4*)(src + (size_t)(kt * 64 + i * 4 + (lane >> 4)) * ld + col0 + ct * 64 + (lane & 15) * 4);
#pragma unroll
    for (int i = 0; i < 16; ++i) { float* tp = t + (i * 4 + (lane >> 4)) * 65 + (lane & 15) * 4; tp[0] = v[i][0]; tp[1] = v[i][1]; tp[2] = v[i][2]; tp[3] = v[i][3]; }
    asm volatile("s_waitcnt lgkmcnt(0)" ::: "memory");
#pragma unroll
    for (int i = 0; i < 8; ++i) {
      const int nl = (lane >> 3) + 8 * i, kl = (lane & 7) * 8;
      const float* tp = t + kl * 65 + nl;
      u32x4 w = {pk_bf16(tp[0], tp[65]), pk_bf16(tp[130], tp[195]), pk_bf16(tp[260], tp[325]), pk_bf16(tp[390], tp[455])};
      int drow0 = ct * 64;
      if (s == 6) drow0 = (ct < 88) ? 256 * (ct >> 1) + 64 * (ct & 1) : 256 * ((ct - 88) >> 1) + 128 + 64 * ((ct - 88) & 1);
      *(u32x4*)(dst + (size_t)(drow0 + nl) * K + kt * 64 + kl) = w;
    }
    asm volatile("s_waitcnt lgkmcnt(0)" ::: "memory");
  }
  __syncthreads();
}

DI void gla_cumsum(const Params& p, float* Bs, float* tot, float* gas, int head, int chunk, int tid_in) {
  const float* GA = (const float*)(p.ws + WS_GA); const float* wup = p.in[3]; const float* ba = p.in[4];
  const int tid = tid_in, d = tid & 127, tg = tid >> 7;
  float w[16];
#pragma unroll
  for (int r = 0; r < 16; ++r) w[r] = wup[r * 512 + head * 128 + d];
  const float bias = ba[head * 128 + d];
  if (tid < 256) { const f32x4 gv = *(const f32x4*)(GA + (size_t)(chunk * 64 + (tid >> 2)) * 16 + (tid & 3) * 4); *(f32x4*)(gas + (tid >> 2) * 16 + (tid & 3) * 4) = gv; }
  __syncthreads();
  float run = 0.f;
#pragma unroll 4
  for (int tt = 0; tt < 16; ++tt) {
    const f32x4* gp = (const f32x4*)(gas + (tg * 16 + tt) * 16);
    const f32x4 g0 = gp[0], g1 = gp[1], g2 = gp[2], g3 = gp[3];
    float xx = bias;
    xx += g0[0] * w[0] + g0[1] * w[1] + g0[2] * w[2] + g0[3] * w[3];
    xx += g1[0] * w[4] + g1[1] * w[5] + g1[2] * w[6] + g1[3] * w[7];
    xx += g2[0] * w[8] + g2[1] * w[9] + g2[2] * w[10] + g2[3] * w[11];
    xx += g3[0] * w[12] + g3[1] * w[13] + g3[2] * w[14] + g3[3] * w[15];
    const float ls = -(fmaxf(-xx, 0.f) + __logf(1.0f + __expf(-fabsf(xx))));
    run += ls * (1.0f / 16.0f);
    Bs[(tg * 16 + tt) * 129 + d] = run;
  }
  tot[tg * 128 + d] = run;
  __syncthreads();
  float pre = 0.f;
  for (int gq = 0; gq < tg; ++gq) pre += tot[gq * 128 + d];
  for (int tt = 0; tt < 16; ++tt) Bs[(tg * 16 + tt) * 129 + d] += pre;
  __syncthreads();
}

constexpr int GL_QB = 0, GL_KB = 17408, GL_VT = 34816, GL_B = 71680, GL_TOT = GL_B + 33024, GL_ST = 71680, GL_RED = 141312, GL_GA = 142336;

DI void gla_load_vt(const Params& p, unsigned char* lds, int head, int chunk, int tid) {
  const bf16_t* VT = (const bf16_t*)(p.ws + WS_VT);
#pragma unroll
  for (int i = 0; i < 4; ++i) {
    const int id = tid + NT * i, row = id >> 3, c = id & 7;
    const u32x4 v = *(const u32x4*)(VT + (size_t)(head * 256 + row) * SEQ + chunk * 64 + c * 8);
    *(u32x4*)(lds + GL_VT + row * 144 + c * 16) = v;
  }
}

__device__ __forceinline__ void gla_g1(const Params& p, const int g_wave64) {
  extern __shared__ __attribute__((aligned(16))) unsigned char lds[];
  const bf16_t* PROJ = (const bf16_t*)(p.ws + WS_PROJ);
  float* UT = p.out; float* GDEC = (float*)(p.ws + WS_GDEC);
  OPAQUE_TID(tid); const int lane = tid & 63, wave = tid >> 6, r = lane & 31, h = lane >> 5;
  float* Bs = (float*)(lds + GL_B); float* tot = (float*)(lds + GL_TOT);
  for (int u = blockIdx.x; u < 1024; u += gridDim.x) {
    const int head = u >> 8, chunk = u & 255;
    __syncthreads();
    bf16_t kraw[16];
    {
      const int d = tid & 127, tg = tid >> 7;
#pragma unroll
      for (int tt = 0; tt < 16; ++tt) kraw[tt] = PROJ[(size_t)(chunk * 64 + tg * 16 + tt) * 4096 + 512 + head * 128 + d];
    }
    gla_load_vt(p, lds, head, chunk, tid);
    gla_cumsum(p, Bs, tot, (float*)(lds + GL_GA), head, chunk, tid);
    {
      const int d = tid & 127, tg = tid >> 7;
      const float bl = Bs[63 * 129 + d];
      float kv[16];
#pragma unroll
      for (int tt = 0; tt < 16; ++tt) {
        const int tl = tg * 16 + tt;
        const float kk = bf2f(kraw[tt]);
        kv[tt] = kk * __expf(bl - Bs[tl * 129 + d]);
      }
      u32x4 w0 = {pk_bf16(kv[0], kv[1]), pk_bf16(kv[2], kv[3]), pk_bf16(kv[4], kv[5]), pk_bf16(kv[6], kv[7])};
      u32x4 w1 = {pk_bf16(kv[8], kv[9]), pk_bf16(kv[10], kv[11]), pk_bf16(kv[12], kv[13]), pk_bf16(kv[14], kv[15])};
      *(u32x4*)(lds + GL_QB + d * 144 + tg * 32) = w0;
      *(u32x4*)(lds + GL_QB + d * 144 + tg * 32 + 16) = w1;
      if (tid < 128) GDEC[(size_t)u * 128 + d] = __expf(bl);
    }
    __syncthreads();
    f32x16 acc[4];
#pragma unroll
    for (int nb = 0; nb < 4; ++nb)
#pragma unroll
      for (int i = 0; i < 16; ++i) acc[nb][i] = 0.f;
#pragma unroll
    for (int s = 0; s < 4; ++s) {
      const bf16x8 a = *(const bf16x8*)(lds + GL_VT + (wave * 32 + r) * 144 + (16 * s + 8 * h) * 2);
#pragma unroll
      for (int nb = 0; nb < 4; ++nb) {
        const bf16x8 b = *(const bf16x8*)(lds + GL_QB + (nb * 32 + r) * 144 + (16 * s + 8 * h) * 2);
        acc[nb] = mfma32(a, b, acc[nb]);
      }
    }
    bf16_t* up = (bf16_t*)UT + (size_t)u * 32768;
#pragma unroll
    for (int nb = 0; nb < 4; ++nb)
#pragma unroll
      for (int gi = 0; gi < 16; ++gi) {
        const int e = wave * 32 + (gi & 3) + 8 * (gi >> 2) + 4 * h;
        up[e * 128 + nb * 32 + r] = (bf16_t)(pk_bf16(acc[nb][gi], 0.f) & 0xffffu);
      }
  }
  __syncthreads();
}

__device__ __forceinline__ void gla_g2(const Params& p, const int g_wave64) {
  const bf16_t* UB = (const bf16_t*)p.out; bf16_t* SB = (bf16_t*)p.out + (size_t)1024 * 32768; const float* GDEC = (const float*)(p.ws + WS_GDEC);
  OPAQUE_TID(tid);
  for (int el = blockIdx.x * NT + tid; el < 4 * 32768; el += gridDim.x * NT) {
    const int head = el >> 15, ed = el & 32767, d = ed & 127;
    const bf16_t* up = UB + (size_t)head * 256 * 32768 + ed;
    bf16_t* sp = SB + (size_t)head * 256 * 32768 + ed;
    const float* gp = GDEC + (size_t)head * 256 * 128 + d;
    float st = 0.f;
    for (int c0 = 0; c0 < 256; c0 += 32) {
      float uu[32], gg[32];
#pragma unroll
      for (int i = 0; i < 32; ++i) { uu[i] = bf2f(up[(size_t)(c0 + i) * 32768]); gg[i] = gp[(c0 + i) * 128]; }
#pragma unroll
      for (int i = 0; i < 32; ++i) { sp[(size_t)(c0 + i) * 32768] = (bf16_t)(pk_bf16(st, 0.f) & 0xffffu); st = gg[i] * st + uu[i]; }
    }
  }
}

__device__ __forceinline__ void gla_g3(const Params& p, const int g_wave64) {
  extern __shared__ __attribute__((aligned(16))) unsigned char lds[];
  const bf16_t* PROJ = (const bf16_t*)(p.ws + WS_PROJ);
  const float* ST = p.out; bf16_t* O = (bf16_t*)(p.ws + WS_O); const float* gnorm = p.in[5];
  OPAQUE_TID(tid); const int lane = tid & 63, wave = tid >> 6, r = lane & 31, h = lane >> 5;
  const int ib = wave & 1, eq = wave >> 1;
  float* Bs = (float*)(lds + GL_B); float* tot = (float*)(lds + GL_TOT); float* red = (float*)(lds + GL_RED);
  for (int u = blockIdx.x; u < 1024; u += gridDim.x) {
    const int head = u >> 8, chunk = u & 255;
    __syncthreads();
    u32x4 stv[8];
    {
      const bf16_t* sp = (const bf16_t*)ST + (size_t)1024 * 32768 + (size_t)u * 32768;
#pragma unroll
      for (int i = 0; i < 8; ++i) { const int id = tid + NT * i, e = id >> 4, c8 = id & 15; stv[i] = *(const u32x4*)(sp + e * 128 + c8 * 8); }
    }
    bf16_t qraw[16], kraw[16];
    {
      const int d = tid & 127, tg = tid >> 7;
#pragma unroll
      for (int tt = 0; tt < 16; ++tt) { const size_t ro = (size_t)(chunk * 64 + tg * 16 + tt) * 4096 + head * 128 + d; qraw[tt] = PROJ[ro]; kraw[tt] = PROJ[ro + 512]; }
    }
    gla_load_vt(p, lds, head, chunk, tid);
    gla_cumsum(p, Bs, tot, (float*)(lds + GL_GA), head, chunk, tid);
    {
      const int d = tid & 127, tg = tid >> 7;
#pragma unroll
      for (int tt = 0; tt < 16; ++tt) {
        const int tl = tg * 16 + tt;
        const float bb = Bs[tl * 129 + d];
        const float qq = bf2f(qraw[tt]) * 0.08838834764831845f * __expf(bb);
        const float kk = bf2f(kraw[tt]) * __expf(-bb);
        *(bf16_t*)(lds + GL_QB + tl * 272 + d * 2) = (bf16_t)(pk_bf16(qq, 0.f) & 0xffff);
        *(bf16_t*)(lds + GL_KB + tl * 272 + d * 2) = (bf16_t)(pk_bf16(kk, 0.f) & 0xffff);
      }
    }
    __syncthreads();
    {
#pragma unroll
      for (int i = 0; i < 8; ++i) { const int id = tid + NT * i, e = id >> 4, c8 = id & 15; *(u32x4*)(lds + GL_ST + e * 272 + c8 * 16) = stv[i]; }
    }
    __syncthreads();
    bf16x8 qf[8];
#pragma unroll
    for (int s = 0; s < 8; ++s) qf[s] = *(const bf16x8*)(lds + GL_QB + (ib * 32 + r) * 272 + (16 * s + 8 * h) * 2);
    f32x16 X[2];
#pragma unroll
    for (int jb = 0; jb < 2; ++jb) {
#pragma unroll
      for (int i = 0; i < 16; ++i) X[jb][i] = 0.f;
      if (jb <= ib) {
        const int jrow = jb * 32 + perm23(r);
#pragma unroll
        for (int s = 0; s < 8; ++s) {
          const bf16x8 a = *(const bf16x8*)(lds + GL_KB + jrow * 272 + (16 * s + 8 * h) * 2);
          X[jb] = mfma32(a, qf[s], X[jb]);
        }
        if (jb == ib) {
#pragma unroll
          for (int gi = 0; gi < 16; ++gi) {
            const int jj = (gi & 3) + 4 * ((gi >> 2) & 1) + 8 * h + 16 * ((gi >> 3) & 1);
            if (jj > r) X[jb][gi] = 0.f;
          }
        }
      }
    }
    f32x16 acc[2];
#pragma unroll
    for (int eb = 0; eb < 2; ++eb)
#pragma unroll
      for (int i = 0; i < 16; ++i) acc[eb][i] = 0.f;
    const int e0 = eq * 64;
#pragma unroll
    for (int jb = 0; jb < 2; ++jb) {
      if (jb <= ib) {
#pragma unroll
        for (int s2 = 0; s2 < 2; ++s2) {
          const bf16x8 pf = pack8(X[jb][8 * s2 + 0], X[jb][8 * s2 + 1], X[jb][8 * s2 + 2], X[jb][8 * s2 + 3],
                                  X[jb][8 * s2 + 4], X[jb][8 * s2 + 5], X[jb][8 * s2 + 6], X[jb][8 * s2 + 7]);
#pragma unroll
          for (int eb = 0; eb < 2; ++eb) {
            const bf16x8 a = *(const bf16x8*)(lds + GL_VT + (e0 + eb * 32 + r) * 144 + (jb * 32 + 16 * s2 + 8 * h) * 2);
            acc[eb] = mfma32(a, pf, acc[eb]);
          }
        }
      }
    }
#pragma unroll
    for (int s = 0; s < 8; ++s)
#pragma unroll
      for (int eb = 0; eb < 2; ++eb) {
        const bf16x8 a = *(const bf16x8*)(lds + GL_ST + (e0 + eb * 32 + r) * 272 + (16 * s + 8 * h) * 2);
        acc[eb] = mfma32(a, qf[s], acc[eb]);
      }
    float ss = 0.f;
#pragma unroll
    for (int eb = 0; eb < 2; ++eb)
#pragma unroll
      for (int i = 0; i < 16; ++i) ss += acc[eb][i] * acc[eb][i];
    ss += shx(ss, 32, lane);
    if (h == 0) red[eq * 64 + ib * 32 + r] = ss;
    __syncthreads();
    const int il = ib * 32 + r;
    const float tsum = red[il] + red[64 + il] + red[128 + il] + red[192 + il];
    const float rstd = rsqrtf(tsum * (1.0f / 256.0f) + EPS);
    const int token = chunk * 64 + il;
#pragma unroll
    for (int eb = 0; eb < 2; ++eb)
#pragma unroll
      for (int g4 = 0; g4 < 4; ++g4) {
        const int eb0 = e0 + eb * 32 + 8 * g4 + 4 * h;
        const u32x2 gt = *(const u32x2*)(PROJ + (size_t)token * 4096 + 1024 + head * 256 + eb0);
        const f32x4 gn = *(const f32x4*)(gnorm + eb0);
        float gv[4] = {bflo(gt[0]), bfhi(gt[0]), bflo(gt[1]), bfhi(gt[1])};
        float y[4];
#pragma unroll
        for (int j = 0; j < 4; ++j) { const float sg = gv[j] * __builtin_amdgcn_rcpf(1.0f + __expf(-gv[j])); y[j] = acc[eb][g4 * 4 + j] * rstd * gn[j] * sg; }
        u32x2 w = {pk_bf16(y[0], y[1]), pk_bf16(y[2], y[3])};
        *(u32x2*)(O + (size_t)token * DM + head * 256 + eb0) = w;
      }
  }
  __syncthreads();
}

#define LDSADDR(p) ((unsigned)(unsigned long)(p))
DI void lds_rd128(bf16x8& dst, const unsigned addr) { asm volatile("ds_read_b128 %0, %1" : "=v"(dst) : "v"(addr)); }
DI void lgkm_wait(const int n, bf16x8& reg) {
  switch (n) {
    case 0: asm volatile("s_waitcnt lgkmcnt(0)" : "+v"(reg)); break;
    case 1: asm volatile("s_waitcnt lgkmcnt(1)" : "+v"(reg)); break;
    case 2: asm volatile("s_waitcnt lgkmcnt(2)" : "+v"(reg)); break;
    case 3: asm volatile("s_waitcnt lgkmcnt(3)" : "+v"(reg)); break;
    case 4: asm volatile("s_waitcnt lgkmcnt(4)" : "+v"(reg)); break;
    case 5: asm volatile("s_waitcnt lgkmcnt(5)" : "+v"(reg)); break;
    case 6: asm volatile("s_waitcnt lgkmcnt(6)" : "+v"(reg)); break;
    default: asm volatile("s_waitcnt lgkmcnt(7)" : "+v"(reg)); break;
  }
}
__device__ __forceinline__ void attn_finish(f32x16 (&o)[8], const float l, const Params& p, unsigned char* lds, const int tid, const int pr, const int comp, const int q0, const int head) {
  bf16_t* O = (bf16_t*)(p.ws + WS_O); const float* dnorm = p.in[10];
  {
      int t3 = tid; asm volatile("" : "+v"(t3));
      const float lt = l + __builtin_bit_cast(float, __builtin_amdgcn_ds_bpermute(((t3 & 63) ^ 32) << 2, __builtin_bit_cast(int, l)));
      float* ex = (float*)lds + (size_t)pr * 8192;
      const int lane_e = t3 & 63, h_e = lane_e >> 5, qrow_e = q0 + pr * 32 + (lane_e & 31);
      if (comp == 1) {
        float lam;
        {
          const float* q1 = p.in[6]; const float* k1 = p.in[7]; const float* q2 = p.in[8]; const float* k2 = p.in[9];
          float s1 = q1[lane_e] * k1[lane_e] + q1[lane_e + 64] * k1[lane_e + 64];
          float s2 = q2[lane_e] * k2[lane_e] + q2[lane_e + 64] * k2[lane_e + 64];
          s1 = wave_sum_l(s1, lane_e); s2 = wave_sum_l(s2, lane_e);
          lam = expf(s1) - expf(s2) + 0.2f;
        }
        const float sc = lam / lt;
#pragma unroll
        for (int dvb = 0; dvb < 8; ++dvb)
#pragma unroll
          for (int gi = 0; gi < 16; ++gi) ex[(dvb * 16 + gi) * 64 + lane_e] = o[dvb][gi] * sc;
      }
      __syncthreads();
      if (comp == 0) {
        const float sc = 1.0f / lt;
        float ss = 0.f;
#pragma unroll
        for (int dvb = 0; dvb < 8; ++dvb) {
#pragma unroll
          for (int gi = 0; gi < 16; ++gi) { const float dv = o[dvb][gi] * sc - ex[(dvb * 16 + gi) * 64 + lane_e]; o[dvb][gi] = dv; ss += dv * dv; }
          asm volatile("" : "+v"(o[dvb]), "+v"(ss) :: "memory");
        }
        ss += __builtin_bit_cast(float, __builtin_amdgcn_ds_bpermute((lane_e ^ 32) << 2, __builtin_bit_cast(int, ss)));
        const float rstd = rsqrtf(ss * (1.0f / 256.0f) + EPS) * 0.8f;
#pragma unroll
        for (int dvb = 0; dvb < 8; ++dvb)
#pragma unroll
          for (int g4 = 0; g4 < 4; ++g4) {
            const int dv0 = dvb * 32 + 8 * g4 + 4 * h_e;
            const f32x4 gn = *(const f32x4*)(dnorm + dv0);
            u32x2 w = {pk_bf16(o[dvb][g4 * 4 + 0] * rstd * gn[0], o[dvb][g4 * 4 + 1] * rstd * gn[1]),
                       pk_bf16(o[dvb][g4 * 4 + 2] * rstd * gn[2], o[dvb][g4 * 4 + 3] * rstd * gn[3])};
            *(u32x2*)(O + (size_t)qrow_e * DM + 1024 + head * 256 + dv0) = w;
          }
      }
      __syncthreads();
  }
}

__device__ __forceinline__ void attn_norms(const Params& p, const int g_wave64) {
  extern __shared__ __attribute__((aligned(16))) unsigned char lds[];
  const bf16_t* PROJ = (const bf16_t*)(p.ws + WS_PROJ); unsigned* NRM = (unsigned*)(p.ws + WS_NRM);
  OPAQUE_TID(tid); const int lane = tid & 63, wave = tid >> 6;
  float* red = (float*)lds;
  float mx0 = 0.f, mx1 = 0.f, mx2 = 0.f;
  for (int rb = blockIdx.x; rb < SEQ / 64; rb += gridDim.x) {
    const int row = rb * 64 + (tid >> 3), j = tid & 7;
    const bf16_t* qp = PROJ + (size_t)row * 4096 + 2048 + j * 128;
    const bf16_t* kp = qp + 1024;
    float qq = 0.f, kk = 0.f, qk = 0.f;
#pragma unroll
    for (int c = 0; c < 16; ++c) { const u32x4 v = *(const u32x4*)(qp + c * 8), w = *(const u32x4*)(kp + c * 8);
#pragma unroll
      for (int e = 0; e < 4; ++e) { const float a = bflo(v[e]), bb = bfhi(v[e]), c2 = bflo(w[e]), d2 = bfhi(w[e]); qq += a * a + bb * bb; kk += c2 * c2 + d2 * d2; qk += a * c2 + bb * d2; } }
    mx0 = fmaxf(mx0, qq); mx1 = fmaxf(mx1, kk); mx2 = fmaxf(mx2, -qk);
  }
  for (int o = 8; o < 64; o <<= 1) { mx0 = fmaxf(mx0, shx(mx0, o, lane)); mx1 = fmaxf(mx1, shx(mx1, o, lane)); mx2 = fmaxf(mx2, shx(mx2, o, lane)); }
  __syncthreads();
  if (lane < 8) { red[wave * 24 + lane] = mx0; red[wave * 24 + 8 + lane] = mx1; red[wave * 24 + 16 + lane] = mx2; }
  __syncthreads();
  if (tid < 24) { float mm = 0.f; for (int w = 0; w < 8; ++w) mm = fmaxf(mm, red[w * 24 + tid]); atomicMax(NRM + tid, __float_as_uint(mm)); }
  __syncthreads();
}
__device__ __forceinline__ void attn_plan(const Params& p, int (&dh)[4]) {
  unsigned* NRM = (unsigned*)(p.ws + WS_NRM);
#pragma unroll
  for (int hh = 0; hh < 4; ++hh) {
    float bound = 0.f;
#pragma unroll
    for (int c = 0; c < 2; ++c) {
      const float qn = __uint_as_float(__hip_atomic_load(NRM + hh * 2 + c, __ATOMIC_RELAXED, __HIP_MEMORY_SCOPE_AGENT));
      const float kn = __uint_as_float(__hip_atomic_load(NRM + 8 + hh * 2 + c, __ATOMIC_RELAXED, __HIP_MEMORY_SCOPE_AGENT));
      const float dg = __uint_as_float(__hip_atomic_load(NRM + 16 + hh * 2 + c, __ATOMIC_RELAXED, __HIP_MEMORY_SCOPE_AGENT));
      bound = fmaxf(bound, (sqrtf(qn * kn) + dg) * (0.08838834764831845f * LOG2E * 1.02f));
    }
    const float slope2 = exp2f(-2.0f * (float)(hh + 1)) * LOG2E;
    const float D = (bound + 152.0f) / slope2;
    dh[hh] = __builtin_amdgcn_readfirstlane((D < 1.0e9f) ? (int)D : 1000000000);
  }
}
__device__ __forceinline__ int attn_nsteps(const int head, const int qb, const int (&dh)[4]) {
  const int d = dh[0] * (head == 0) + dh[1] * (head == 1) + dh[2] * (head == 2) + dh[3] * (head == 3);
  int ttmin = (128 * qb - d) / 64 - 1; ttmin = ttmin < 0 ? 0 : ttmin;
  return 2 * qb + 2 - ttmin;
}
constexpr int ATT_TAB = 132096;
__device__ __forceinline__ void attn_build_plan(const Params& p, unsigned char* lds, const int tid) {
  int* tab = (int*)(lds + ATT_TAB);
  __syncthreads();
  int dh[4]; attn_plan(p, dh);
  if (tid < 256) {
    const int r = tid >> 5, j = tid & 31;
    int v = attn_nsteps(r >> 1, 127 - (r & 1) * 32 - j, dh) + attn_nsteps(r >> 1, (r & 1) * 32 + j, dh) + 2 * OVH;
    for (int o = 1; o < 32; o <<= 1) { const int w = __builtin_amdgcn_ds_bpermute(((tid & 63) ^ o) << 2, v); v = w > v ? w : v; }
    if (j == 0) tab[128 + r] = v;
  }
  __syncthreads();
  if (tid == 0) {
    const int xg = (int)blockIdx.x & 7, jq = (int)blockIdx.x >> 3;
    int R = 0;
#pragma unroll 1
    for (int r = 0; r < 8; ++r) R += tab[128 + r];
    const int Xa = (xg * R) / 8, Xb = ((xg + 1) * R) / 8;
    int P = 0; int first = 1;
#pragma unroll 1
    for (int r = 0; r < 8; ++r) {
      const int head = r >> 1, pg = r & 1, rlen = tab[128 + r];
      const int ra = (Xa > P ? Xa : P) - P, rb = (Xb < P + rlen ? Xb : P + rlen) - P;
      int off = 0;
#pragma unroll 1
      for (int part = 0; part < 2; ++part) {
        const int qb = part == 0 ? pg * 32 + jq : 127 - pg * 32 - jq;
        const int nst = attn_nsteps(head, qb, dh);
        int t_lo = ra - off, t_hi = rb - off;
        t_lo = t_lo < 0 ? 0 : t_lo; t_hi = t_hi > nst ? nst : t_hi;
        int* e = tab + (r * 2 + part) * 8;
        e[2] = nst; e[6] = qb;
        if (ra >= rb || t_lo >= t_hi) { e[0] = 0; e[1] = 0; e[3] = 0; e[4] = 0; e[5] = 0; }
        else {
          e[0] = t_lo; e[1] = t_hi; e[3] = 2 * (int)blockIdx.x + (first ? 0 : 1); first = 0;
          int cflag = 0, xend = xg;
          if (t_lo == 0 && t_hi < nst) {
            cflag = 1;
            for (int xx = xg + 1; xx < 8; ++xx) { if ((xx * R) / 8 - (P + off) >= nst) break; xend = xx; }
          }
          e[4] = cflag; e[5] = xend;
        }
        off += nst + OVH;
      }
      P += rlen;
    }
  }
  __syncthreads();
}
__device__ __forceinline__ void attn_phase(const Params& p, const int g_wave64) {
  extern __shared__ __attribute__((aligned(16))) unsigned char lds[];
  const bf16_t* PROJ = (const bf16_t*)(p.ws + WS_PROJ); const bf16_t* VT = (const bf16_t*)(p.ws + WS_VT);
  OPAQUE_TID(tid); const int lane = tid & 63, wave = __builtin_amdgcn_readfirstlane(tid >> 6), r = lane & 31, h = lane >> 5;
  const int comp = wave & 1, pr = wave >> 1;
  LAS unsigned char* L = (LAS unsigned char*)lds;
  const int pr_r = perm23(r);
  const unsigned kbase = (unsigned)pr_r * 256u, khs_c = (unsigned)((h ^ (pr_r & 15)) << 4);
  const unsigned vbase = (unsigned)r * 128u, vhs_c = (unsigned)((h ^ ((r >> 1) & 7)) << 4);
  const float C1 = 0.08838834764831845f * LOG2E;
  attn_build_plan(p, lds, tid);
  const int jq = (int)blockIdx.x >> 3;
#pragma unroll 1
  for (int rr = 0; rr < 16; ++rr) {
    const int* e = (const int*)(lds + ATT_TAB) + rr * 8;
    const int t_lo = __builtin_amdgcn_readfirstlane(e[0]), t_hi = __builtin_amdgcn_readfirstlane(e[1]), nst = __builtin_amdgcn_readfirstlane(e[2]), slot = __builtin_amdgcn_readfirstlane(e[3]);
    if (t_lo >= t_hi) continue;
    const int head = rr >> 2, qb = __builtin_amdgcn_readfirstlane(e[6]);
    const float slope2 = exp2f(-2.0f * (float)(head + 1)) * LOG2E;
    {
      const int q0 = qb * 128, ntiles = 2 * qb + 2;
      const int qrow = q0 + pr * 32 + r;
      bf16x8 qf[8];
      {
        int t4 = tid; asm volatile("" : "+v"(t4));
        const bf16_t* qp = PROJ + (size_t)(q0 + pr * 32 + (t4 & 31)) * 4096 + 2048 + head * 256 + comp * 128 + 8 * ((t4 >> 5) & 1);
#pragma unroll
        for (int s = 0; s < 8; ++s) {
          const u32x4 raw = *(const u32x4*)(qp + 16 * s);
          u32x4 sc;
#pragma unroll
          for (int j = 0; j < 4; ++j) sc[j] = pk_bf16(bflo(raw[j]) * C1, bfhi(raw[j]) * C1);
          qf[s] = __builtin_bit_cast(bf16x8, sc);
        }
      }
      f32x16 o[8];
#pragma unroll
      for (int dvb = 0; dvb < 8; ++dvb)
#pragma unroll
        for (int i = 0; i < 16; ++i) o[dvb][i] = 0.f;
      float m = -1e30f, l = 0.f;
#define ISSUE_TILE(T, BUF) do { int _t2 = tid; asm volatile("" : "+v"(_t2)); \
      const char* _kg = (const char*)PROJ + ((size_t)(T) * 64 * 4096 + 3072 + head * 256) * 2; \
      const char* _vg = (const char*)VT + ((size_t)(1024 + head * 256) * SEQ + (size_t)(T) * 64) * 2; \
      LAS unsigned char* _b = L + (BUF) * 65536 + wave * 1024; \
      _Pragma("unroll") for (int _i = 0; _i < 4; ++_i) { const int _slot = _t2 + NT * _i, _cmp = _slot >> 10, _sl = _slot & 1023, _row = _sl >> 4, _c = (_sl & 15) ^ (_row & 15); \
        __builtin_amdgcn_global_load_lds((const unsigned*)(_kg + (unsigned)((_row * 4096 + _cmp * 128 + _c * 8) * 2)), (LAS unsigned*)(_b + _i * 8192), 16, 0, 0); } \
      _Pragma("unroll") for (int _i = 0; _i < 4; ++_i) { const int _slot = _t2 + NT * _i, _row = _slot >> 3, _c = (_slot & 7) ^ ((_row >> 1) & 7); \
        __builtin_amdgcn_global_load_lds((const unsigned*)(_vg + (unsigned)((_row * SEQ + _c * 8) * 2)), (LAS unsigned*)(_b + 32768 + _i * 8192), 16, 0, 0); } } while (0)
#define ISSUE_PIECE(T, BUF, I) do { int _t2 = tid; asm volatile("" : "+v"(_t2)); LAS unsigned char* _b = L + (BUF) * 65536 + wave * 1024; \
      if ((I) < 4) { const int _slot = _t2 + NT * (I), _cmp = _slot >> 10, _sl = _slot & 1023, _row = _sl >> 4, _c = (_sl & 15) ^ (_row & 15); \
        const char* _kg = (const char*)PROJ + ((size_t)(T) * 64 * 4096 + 3072 + head * 256) * 2; \
        __builtin_amdgcn_global_load_lds((const unsigned*)(_kg + (unsigned)((_row * 4096 + _cmp * 128 + _c * 8) * 2)), (LAS unsigned*)(_b + (I) * 8192), 16, 0, 0); } \
      else { const int _slot = _t2 + NT * ((I) - 4), _row = _slot >> 3, _c = (_slot & 7) ^ ((_row >> 1) & 7); \
        const char* _vg = (const char*)VT + ((size_t)(1024 + head * 256) * SEQ + (size_t)(T) * 64) * 2; \
        __builtin_amdgcn_global_load_lds((const unsigned*)(_vg + (unsigned)((_row * SEQ + _c * 8) * 2)), (LAS unsigned*)(_b + 32768 + ((I) - 4) * 8192), 16, 0, 0); } } while (0)
      __syncthreads();
      ISSUE_TILE(ntiles - 1 - t_lo, 0);
      asm volatile("s_waitcnt vmcnt(0)" ::: "memory");
      __syncthreads();
      for (int t = t_lo; t < t_hi; ++t) {
        const int buf = (t - t_lo) & 1, tt = ntiles - 1 - t;
        const bool do_issue = (t + 1 < t_hi);
        const int k0 = tt * 64;
        const bool act = (k0 <= q0 + pr * 32 + 31);
        if (do_issue && !act) ISSUE_TILE(tt - 1, buf ^ 1);
        if (act) {
          LAS unsigned char* kb = L + (buf * 65536 + comp * 16384);
          LAS unsigned char* vb = L + (buf * 65536 + 32768);
#define KADDR(f) (kb + ((f) & 1) * 8192 + (kbase + ((unsigned)(((f) >> 1) * 32) ^ khs)))
#define VADDR(f) (vb + ((f) & 7) * 4096 + (vbase + ((unsigned)(((f) >> 3) * 32) ^ vhs)))
          unsigned khs = khs_c, vhs = vhs_c; asm volatile("" : "+v"(khs), "+v"(vhs));
          bf16x8 kf[KR];
#pragma unroll
          for (int f = 0; f < KR; ++f) lds_rd128(kf[f], LDSADDR(KADDR(f)));
          float sl2 = slope2; asm volatile("" : "+v"(sl2));
          const float mref = (m > -1e29f) ? m : 0.f;
          const float tb = sl2 * (float)(k0 + 8 * h - q0) - mref;
          f32x16 sa0, sa1;
          {
            const float s4x = sl2 * 4.0f, s16x = s4x * 4.0f, s32x = s16x + s16x;
            sa0[0] = tb; sa0[1] = tb + sl2; sa0[2] = sa0[1] + sl2; sa0[3] = sa0[2] + sl2;
#pragma unroll
            for (int gi = 0; gi < 4; ++gi) sa0[4 + gi] = sa0[gi] + s4x;
#pragma unroll
            for (int gi = 0; gi < 8; ++gi) sa0[8 + gi] = sa0[gi] + s16x;
#pragma unroll
            for (int gi = 0; gi < 16; ++gi) sa1[gi] = sa0[gi] + s32x;
          }
#pragma unroll
          for (int f = 0; f < 16; ++f) {
            lgkm_wait((15 - f) < (KR - 1) ? (15 - f) : (KR - 1), kf[f % KR]);
            if (f & 1) sa1 = mfma32(kf[f % KR], qf[f >> 1], sa1); else sa0 = mfma32(kf[f % KR], qf[f >> 1], sa0);
            if (f + KR < 16) lds_rd128(kf[f % KR], LDSADDR(KADDR(f + KR)));
            __builtin_amdgcn_sched_barrier(0);
          }
          bf16x8 vf[VR];
#pragma unroll
          for (int f = 0; f < VR; ++f) lds_rd128(vf[f], LDSADDR(VADDR(f)));
          __builtin_amdgcn_sched_barrier(0);
          if (do_issue) { ISSUE_PIECE(tt - 1, buf ^ 1, 0); ISSUE_PIECE(tt - 1, buf ^ 1, 1); ISSUE_PIECE(tt - 1, buf ^ 1, 2); ISSUE_PIECE(tt - 1, buf ^ 1, 3); }
          __builtin_amdgcn_sched_barrier(0);
          if (k0 + 63 > q0 + pr * 32) {
#pragma unroll
            for (int gi = 0; gi < 16; ++gi) {
              const int koff = (gi & 3) + 4 * ((gi >> 2) & 1) + 16 * ((gi >> 3) & 1);
              if (k0 + koff + 8 * h > qrow) sa0[gi] = -1e30f;
              if (k0 + koff + 32 + 8 * h > qrow) sa1[gi] = -1e30f;
            }
          }
          float mloc = fmaxf(sa0[0], sa1[0]);
#pragma unroll
          for (int gi = 1; gi < 16; ++gi) mloc = fmaxf(mloc, fmaxf(sa0[gi], sa1[gi]));
          mloc = fmaxf(mloc, shx(mloc, 32, lane));
          const float mrel = m - mref;
          const float delta = fmaxf(mrel, mloc);
          if (__ballot(delta > mrel) != 0ull) {
            const float alpha = __builtin_amdgcn_exp2f(mrel - delta);
            l *= alpha;
#pragma unroll
            for (int dvb = 0; dvb < 8; ++dvb) o[dvb] = o[dvb] * alpha;
#pragma unroll
            for (int gi = 0; gi < 16; ++gi) { sa0[gi] -= delta; sa1[gi] -= delta; }
          }
          m = mref + delta;
          float ps = 0.f;
#pragma unroll
          for (int gi = 0; gi < 16; ++gi) {
            const float p0 = __builtin_amdgcn_exp2f(sa0[gi]), p1 = __builtin_amdgcn_exp2f(sa1[gi]);
            sa0[gi] = p0; sa1[gi] = p1; ps += p0 + p1;
          }
          l += ps;
          __builtin_amdgcn_sched_barrier(0);
          if (do_issue) { ISSUE_PIECE(tt - 1, buf ^ 1, 4); ISSUE_PIECE(tt - 1, buf ^ 1, 5); ISSUE_PIECE(tt - 1, buf ^ 1, 6); ISSUE_PIECE(tt - 1, buf ^ 1, 7); }
          __builtin_amdgcn_sched_barrier(0);
          bf16x8 pf[4];
          pf[0] = pack8(sa0[0], sa0[1], sa0[2], sa0[3], sa0[4], sa0[5], sa0[6], sa0[7]);
          pf[1] = pack8(sa0[8], sa0[9], sa0[10], sa0[11], sa0[12], sa0[13], sa0[14], sa0[15]);
          pf[2] = pack8(sa1[0], sa1[1], sa1[2], sa1[3], sa1[4], sa1[5], sa1[6], sa1[7]);
          pf[3] = pack8(sa1[8], sa1[9], sa1[10], sa1[11], sa1[12], sa1[13], sa1[14], sa1[15]);
          __builtin_amdgcn_sched_barrier(0);
#pragma unroll
          for (int f = 0; f < 32; ++f) {
            lgkm_wait((31 - f) < (VR - 1) ? (31 - f) : (VR - 1), vf[f % VR]);
            o[f & 7] = mfma32(vf[f % VR], pf[f >> 3], o[f & 7]);
            if (f + VR < 32) lds_rd128(vf[f % VR], LDSADDR(VADDR(f + VR)));
            __builtin_amdgcn_sched_barrier(0);
          }
#undef KADDR
#undef VADDR
        }
        asm volatile("s_waitcnt vmcnt(0)" ::: "memory");
        __syncthreads();
      }
#undef ISSUE_TILE
#undef ISSUE_PIECE
      if (t_lo == 0 && t_hi == nst) {
        attn_finish(o, l, p, lds, tid, pr, comp, q0, head);
      } else {
        int t5 = tid; asm volatile("" : "+v"(t5));
        float* ps = part_slot(p, slot) + wave * 8192 + (t5 & 63);
#pragma unroll
        for (int dvb = 0; dvb < 8; ++dvb)
#pragma unroll
          for (int gi = 0; gi < 16; ++gi) ps[(dvb * 16 + gi) * 64] = o[dvb][gi];
        float* ml = (float*)(p.ws + WS_ML) + ((size_t)slot * 8 + wave) * 128 + (t5 & 63);
        ml[0] = m; ml[64] = l;
      }
    }
  }
  __syncthreads();
}

__device__ __forceinline__ void attn_combine(const Params& p, const int g_wave64) {
  extern __shared__ __attribute__((aligned(16))) unsigned char lds[];
  OPAQUE_TID(tid); const int lane = tid & 63, wave = __builtin_amdgcn_readfirstlane(tid >> 6);
  const int comp = wave & 1, pr = wave >> 1;
  attn_build_plan(p, lds, tid);
  const int xg = (int)blockIdx.x & 7, jq = (int)blockIdx.x >> 3;
#pragma unroll 1
  for (int rr = 0; rr < 16; ++rr) {
    const int* e = (const int*)(lds + ATT_TAB) + rr * 8;
    const int cflag = __builtin_amdgcn_readfirstlane(e[4]), xend = __builtin_amdgcn_readfirstlane(e[5]), slot0 = __builtin_amdgcn_readfirstlane(e[3]);
    if (!cflag) continue;
    const int head = rr >> 2, qb = __builtin_amdgcn_readfirstlane(e[6]);
    f32x16 o[8]; float m, l;
    {
      const int slot = slot0;
      const float* ps = part_slot(p, slot) + wave * 8192 + lane;
#pragma unroll
      for (int dvb = 0; dvb < 8; ++dvb)
#pragma unroll
        for (int gi = 0; gi < 16; ++gi) o[dvb][gi] = ps[(dvb * 16 + gi) * 64];
      const float* ml = (const float*)(p.ws + WS_ML) + ((size_t)slot * 8 + wave) * 128 + lane;
      m = ml[0]; l = ml[64];
    }
    for (int xx = xg + 1; xx <= xend; ++xx) {
      const int slot = 2 * (jq * 8 + xx);
      const float* ml = (const float*)(p.ws + WS_ML) + ((size_t)slot * 8 + wave) * 128 + lane;
      const float ms = ml[0], ls = ml[64];
      const float mn = fmaxf(m, ms);
      const float a0 = __builtin_amdgcn_exp2f(m - mn), a1 = __builtin_amdgcn_exp2f(ms - mn);
      const float* ps = part_slot(p, slot) + wave * 8192 + lane;
#pragma unroll
      for (int dvb = 0; dvb < 8; ++dvb) {
#pragma unroll
        for (int gi = 0; gi < 16; ++gi) o[dvb][gi] = o[dvb][gi] * a0 + ps[(dvb * 16 + gi) * 64] * a1;
        asm volatile("" : "+v"(o[dvb]) :: "memory");
      }
      l = l * a0 + ls * a1; m = mn;
    }
    attn_finish(o, l, p, lds, tid, pr, comp, qb * 128, head);
  }
  __syncthreads();
}

__device__ __forceinline__ void p6_post_attn(const Params& p, const int g_wave64) {
  const float* x = p.in[0]; const float* gp = p.in[12]; const float* gf = p.in[13];
  const bf16_t* Mb = (const bf16_t*)(p.ws + WS_M); bf16_t* H = (bf16_t*)(p.ws + WS_H);
  OPAQUE_TID(tid); const int lane = tid & 63, wave = tid >> 6;
  for (int row = blockIdx.x * 8 + wave; row < SEQ; row += gridDim.x * 8) {
    f32x4 mv[8];
    float s = 0.f;
#pragma unroll
    for (int ii = 0; ii < 8; ++ii) { const u32x2 rw = *(const u32x2*)(Mb + (size_t)row * DM + ii * 256 + lane * 4); mv[ii] = (f32x4){bflo(rw[0]), bfhi(rw[0]), bflo(rw[1]), bfhi(rw[1])}; s += mv[ii][0] * mv[ii][0] + mv[ii][1] * mv[ii][1] + mv[ii][2] * mv[ii][2] + mv[ii][3] * mv[ii][3]; }
    s = wave_sum_l(s, lane);
    const float rs = rsqrtf(s * (1.0f / DM) + EPS);
    float s2 = 0.f;
#pragma unroll
    for (int ii = 0; ii < 8; ++ii) {
      const f32x4 xv = *(const f32x4*)(x + (size_t)row * DM + ii * 256 + lane * 4);
      const f32x4 g = *(const f32x4*)(gp + ii * 256 + lane * 4);
      mv[ii] = xv + mv[ii] * rs * g;
      s2 += mv[ii][0] * mv[ii][0] + mv[ii][1] * mv[ii][1] + mv[ii][2] * mv[ii][2] + mv[ii][3] * mv[ii][3];
    }
    s2 = wave_sum_l(s2, lane);
    const float rs2 = rsqrtf(s2 * (1.0f / DM) + EPS);
#pragma unroll
    for (int ii = 0; ii < 8; ++ii) {
      const f32x4 g = *(const f32x4*)(gf + ii * 256 + lane * 4);
      const f32x4 hv = mv[ii] * rs2 * g;
      u32x2 w = {pk_bf16(hv[0], hv[1]), pk_bf16(hv[2], hv[3])};
      *(u32x2*)(H + (size_t)row * DM + ii * 256 + lane * 4) = w;
    }
  }
}

__device__ __forceinline__ void p10_final(const Params& p, const int g_wave64) {
  const float* x = p.in[0]; const float* gm = p.in[12]; const float* gp = p.in[18];
  const bf16_t* Mb = (const bf16_t*)(p.ws + WS_M); const bf16_t* F = (const bf16_t*)(p.ws + WS_F); float* out = p.out;
  OPAQUE_TID(tid); const int lane = tid & 63, wave = tid >> 6;
  for (int row = blockIdx.x * 8 + wave; row < SEQ; row += gridDim.x * 8) {
    f32x4 mv[8], fv[8];
    float s = 0.f, sm = 0.f;
#pragma unroll
    for (int ii = 0; ii < 8; ++ii) {
      const u32x2 rw = *(const u32x2*)(F + (size_t)row * DM + ii * 256 + lane * 4); fv[ii] = (f32x4){bflo(rw[0]), bfhi(rw[0]), bflo(rw[1]), bfhi(rw[1])};
      const u32x2 rm = *(const u32x2*)(Mb + (size_t)row * DM + ii * 256 + lane * 4); mv[ii] = (f32x4){bflo(rm[0]), bfhi(rm[0]), bflo(rm[1]), bfhi(rm[1])};
      s += fv[ii][0] * fv[ii][0] + fv[ii][1] * fv[ii][1] + fv[ii][2] * fv[ii][2] + fv[ii][3] * fv[ii][3];
      sm += mv[ii][0] * mv[ii][0] + mv[ii][1] * mv[ii][1] + mv[ii][2] * mv[ii][2] + mv[ii][3] * mv[ii][3];
    }
    s = wave_sum_l(s, lane); sm = wave_sum_l(sm, lane);
    const float rs = rsqrtf(s * (1.0f / DM) + EPS), rsm = rsqrtf(sm * (1.0f / DM) + EPS);
#pragma unroll
    for (int ii = 0; ii < 8; ++ii) {
      const f32x4 xv = *(const f32x4*)(x + (size_t)row * DM + ii * 256 + lane * 4);
      const f32x4 g1 = *(const f32x4*)(gm + ii * 256 + lane * 4);
      const f32x4 g = *(const f32x4*)(gp + ii * 256 + lane * 4);
      *(f32x4*)(out + (size_t)row * DM + ii * 256 + lane * 4) = (xv + mv[ii] * rsm * g1) + fv[ii] * rs * g;
    }
  }
}
__device__ __forceinline__ void p8_fixup(const Params& p, const int g_wave64) {
  const float* SA0 = (const float*)(p.ws + WS_SA0); const float* SB0 = (const float*)(p.ws + WS_SB0); const float* SAL = (const float*)(p.ws + WS_SAL);
  bf16_t* G = (bf16_t*)(p.ws + WS_BUP); const float* cw = p.in[15]; const float* cb = p.in[16];
  OPAQUE_TID(tid);
  constexpr int nM = SEQ / 256, nN = DM / 256, nwg = nM * nN;
  int pmprev = -1;
  for (int L = (int)blockIdx.x; L < nwg; L += (int)gridDim.x) {
    int w = L; { const int q = nwg / NXCD, r = nwg % NXCD, x = w % NXCD, o = w / NXCD; w = (x < r ? x * (q + 1) : r * (q + 1) + (x - r) * q) + o; }
    const int nig = WGM * nN, gid = w / nig, fm = gid * WGM, gsz = min(nM - fm, WGM);
    const int pm = fm + ((w % nig) % gsz);
    if (pm == pmprev) continue;
    pmprev = pm;
    for (int el = tid; el < 2 * DFF; el += NT) {
      const int c = el % DFF, r = el / DFF, pr2 = pm * 2 + r;
      const float at = SA0[(size_t)pr2 * DFF + c];
      const float l0 = pm > 0 ? SAL[((size_t)(pm - 1) * 2 + 0) * DFF + c] : 0.f, l1 = pm > 0 ? SAL[((size_t)(pm - 1) * 2 + 1) * DFF + c] : 0.f;
      const float a1 = r ? SA0[(size_t)(pr2 - 1) * DFF + c] : l1, a2 = r ? l1 : l0;
      const float y = cw[c] * a2 + cw[DFF + c] * a1 + cw[2 * DFF + c] * at + cb[c];
      const float e = __builtin_amdgcn_exp2f(-2.302208198f * (y + 0.044715f * y * y * y));
      const float g = y * __builtin_amdgcn_rcpf(1.0f + e) * SB0[(size_t)pr2 * DFF + c];
      G[(size_t)(pm * 256 + r) * DFF + c] = (bf16_t)(pk_bf16(g, 0.f) & 0xffffu);
    }
  }
  asm volatile("s_waitcnt vmcnt(0)" ::: "memory");
  __syncthreads();
}

__device__ __forceinline__ void p8_conv_glu(const Params& p, const int g_wave64) {
  const bf16_t* Aup = (const bf16_t*)(p.ws + WS_AUP); bf16_t* Bup = (bf16_t*)(p.ws + WS_BUP);
  const float* cw = p.in[15]; const float* cb = p.in[16];
  constexpr int NCG = DFF / 8, RUN = 32, NRUN = SEQ / RUN;
  OPAQUE_TID(tid);
  for (int item = blockIdx.x * NT + tid; item < NCG * NRUN; item += gridDim.x * NT) {
    const int cgi = item % NCG, run = item / NCG, c0 = cgi * 8, t0 = run * RUN;
    float w0[8], w1[8], w2[8], bb[8], am2[8], am1[8];
#pragma unroll
    for (int j = 0; j < 8; ++j) { w0[j] = cw[c0 + j]; w1[j] = cw[DFF + c0 + j]; w2[j] = cw[2 * DFF + c0 + j]; bb[j] = cb[c0 + j]; am2[j] = 0.f; am1[j] = 0.f; }
    if (t0 >= 2) {
      const u32x4 v2 = *(const u32x4*)(Aup + (size_t)(t0 - 2) * DFF + c0), v1 = *(const u32x4*)(Aup + (size_t)(t0 - 1) * DFF + c0);
#pragma unroll
      for (int j = 0; j < 4; ++j) { am2[2 * j] = bflo(v2[j]); am2[2 * j + 1] = bfhi(v2[j]); am1[2 * j] = bflo(v1[j]); am1[2 * j + 1] = bfhi(v1[j]); }
    }
    for (int t = t0; t < t0 + RUN; ++t) {
      const u32x4 va = *(const u32x4*)(Aup + (size_t)t * DFF + c0);
      const u32x4 vb = *(const u32x4*)(Bup + (size_t)t * DFF + c0);
      float ac[8], bv[8], y[8];
#pragma unroll
      for (int j = 0; j < 4; ++j) { ac[2 * j] = bflo(va[j]); ac[2 * j + 1] = bfhi(va[j]); bv[2 * j] = bflo(vb[j]); bv[2 * j + 1] = bfhi(vb[j]); }
#pragma unroll
      for (int j = 0; j < 8; ++j) {
        const float a = w0[j] * am2[j] + w1[j] * am1[j] + w2[j] * ac[j] + bb[j];
        const float uu = 0.7978845608028654f * (a + 0.044715f * a * a * a);
        const float th = 1.0f - 2.0f / (1.0f + __expf(2.0f * uu));
        y[j] = 0.5f * a * (1.0f + th) * bv[j];
        am2[j] = am1[j]; am1[j] = ac[j];
      }
      u32x4 w = {pk_bf16(y[0], y[1]), pk_bf16(y[2], y[3]), pk_bf16(y[4], y[5]), pk_bf16(y[6], y[7])};
      *(u32x4*)(Bup + (size_t)t * DFF + c0) = w;
    }
  }
}


#define XB_TMO      128
#define XB_XCNT(j)  (256  + 64 * (j))
#define XB_XSUB(j)  (1280 + 64 * (j))
#define XB_XGEN(j)  (2304 + 64 * (j))
#define XB_TOP      3328
#define XB_TOPGEN   3392
#define XCD_BAR_WORDS 3456
#define XB_SPIN_CAP (1u << 18)
DI unsigned xb_ld(unsigned* p) { return __hip_atomic_load(p, __ATOMIC_RELAXED, __HIP_MEMORY_SCOPE_AGENT); }
DI unsigned xb_add(unsigned* p, unsigned v) { return __hip_atomic_fetch_add(p, v, __ATOMIC_RELAXED, __HIP_MEMORY_SCOPE_AGENT); }
DI unsigned xb_xcc_id() { return (unsigned)__builtin_amdgcn_s_getreg((3 << 11) | 20) & 0xFu; }
#define XB_SPIN(cond, bar) do { unsigned _sp = 0; while (cond) { __builtin_amdgcn_s_sleep(1); \
    if ((++_sp & 255u) == 0u) { if (xb_ld(&(bar)[XB_TMO])) break; if (_sp > XB_SPIN_CAP) { atomicAdd(&(bar)[XB_TMO], 1u); break; } } } } while (0)
DI void xcd_barrier_complete(unsigned* bar, unsigned x, unsigned& nloc, unsigned& nx) {
  const unsigned G = gridDim.x;
  unsigned sum, cnt, mine, sp = 0u;
  for (;;) {
    sum = 0u; cnt = 0u; mine = 0u;
#pragma unroll
    for (unsigned j = 0; j < 16; ++j) { const unsigned c = xb_ld(&bar[XB_XCNT(j)]); sum += c; cnt += (c > 0u) ? 1u : 0u; mine = (j == x) ? c : mine; }
    if (sum == G) break;
    __builtin_amdgcn_s_sleep(1);
    if ((++sp & 255u) == 0u) { if (xb_ld(&bar[XB_TMO])) break; if (sp > XB_SPIN_CAP) { atomicAdd(&bar[XB_TMO], 1u); break; } }
  }
  nloc = mine > 0u ? mine : 1u; nx = cnt > 0u ? cnt : 1u;
}
__device__ __forceinline__ void xcd_barrier(unsigned* bar, volatile LAS unsigned* st) {
  asm volatile("s_waitcnt vmcnt(0)" ::: "memory");
  __syncthreads();
  if (threadIdx.x == 0) {
    const unsigned x = xb_xcc_id();
    __builtin_amdgcn_s_waitcnt(0);
    unsigned nloc = st[0], nx = st[1];
    if (nloc == 0u) { xcd_barrier_complete(bar, x, nloc, nx); st[0] = nloc; st[1] = nx; }
    const unsigned old = xb_add(&bar[XB_XSUB(x)], 1u);
    const unsigned gen = old / nloc;
    if (old + 1u == (gen + 1u) * nloc) {
      __builtin_amdgcn_fence(__ATOMIC_RELEASE, "agent");
      asm volatile("s_waitcnt vmcnt(0)" ::: "memory");
      const unsigned og = xb_add(&bar[XB_TOP], 1u);
      const unsigned tg = og / nx;
      if (og + 1u == (tg + 1u) * nx) xb_add(&bar[XB_TOPGEN], 1u);
      else XB_SPIN(xb_ld(&bar[XB_TOPGEN]) == tg, bar);
      __builtin_amdgcn_fence(__ATOMIC_ACQUIRE, "agent");
      xb_add(&bar[XB_XGEN(x)], 1u);
      asm volatile("s_waitcnt vmcnt(0)" ::: "memory");
    } else {
      XB_SPIN(xb_ld(&bar[XB_XGEN(x)]) == gen, bar);
      __builtin_amdgcn_fence(__ATOMIC_ACQUIRE, "agent");
      asm volatile("s_waitcnt vmcnt(0)" ::: "memory");
    }
  }
  __syncthreads();
}
__global__ void __launch_bounds__(NT, 2) mega(Params p) {
  cg::grid_group grid = cg::this_grid();
  extern __shared__ __attribute__((aligned(16))) unsigned char lds_all[];
  volatile LAS unsigned* xb_st = (volatile LAS unsigned*)((LAS unsigned char*)lds_all + (LDS_BYTES - 16));
  unsigned* xb_bar = (unsigned*)(p.ws + WS_BAR);
  if (threadIdx.x == 0) { xb_st[0] = 0u; xb_st[1] = 0u; (void)xb_add(&xb_bar[XB_XCNT(xb_xcc_id())], 1u); }
  __syncthreads();
  const int g_wave64 = __builtin_amdgcn_readfirstlane((int)threadIdx.x & ~63);
  unsigned char* ws = p.ws;
  bf16_t* H = (bf16_t*)(ws + WS_H);
#ifndef PH
#define PH -1
#endif
#define ON(k) (PH < 0 || PH == (k))
  if (ON(0)) { p0_norm_ga(p, g_wave64); }
  if (ON(1)) { p0_transposes(p, g_wave64); }
  if (p.ws == nullptr) grid.sync();
  xcd_barrier(xb_bar, xb_st);
  if (ON(2)) {
  gemm_phase<false, SEQ, 4096, DM, 4096, 1 << 20>(H, (const bf16_t*)(ws + WS_WIN), ws + WS_PROJ, ws + WS_PROJ, g_wave64);
  gemm_phase<false, 2048, SEQ, DM, SEQ, 1 << 20>((const bf16_t*)(ws + WS_WV), H, ws + WS_VT, ws + WS_VT, g_wave64);
  }
  xcd_barrier(xb_bar, xb_st);
  if (ON(3)) { attn_norms(p, g_wave64); gla_g1(p, g_wave64); }
  xcd_barrier(xb_bar, xb_st);
  if (ON(4)) gla_g2(p, g_wave64);
  xcd_barrier(xb_bar, xb_st);
  if (ON(5)) gla_g3(p, g_wave64);
  if (ON(6)) { attn_phase(p, g_wave64); xcd_barrier(xb_bar, xb_st); attn_combine(p, g_wave64); }
  xcd_barrier(xb_bar, xb_st);
  if (ON(7)) gemm_phase<false, SEQ, DM, DM, DM, 1 << 20>((const bf16_t*)(ws + WS_O), (const bf16_t*)(ws + WS_WO), ws + WS_M, ws + WS_M, g_wave64);
  xcd_barrier(xb_bar, xb_st);
  if (ON(8)) p6_post_attn(p, g_wave64);
  xcd_barrier(xb_bar, xb_st);
  if (ON(2)) gemm_phase<false, SEQ, 2 * DFF, DM, DFF, 1 << 20, 2>(H, (const bf16_t*)(ws + WS_WFI), ws + WS_BUP, ws + WS_BUP, g_wave64,
                                                                ConvEpi{p.in[15], p.in[16], (float*)(ws + WS_SA0), (float*)(ws + WS_SB0), (float*)(ws + WS_SAL)});
  xcd_barrier(xb_bar, xb_st);
  if (ON(9)) p8_fixup(p, g_wave64);
  if (ON(7)) gemm_phase<false, SEQ, DM, DFF, DM, 1 << 20>((const bf16_t*)(ws + WS_BUP), (const bf16_t*)(ws + WS_WFO), ws + WS_F, ws + WS_F, g_wave64);
  xcd_barrier(xb_bar, xb_st);
  if (ON(10)) p10_final(p, g_wave64);
}

extern "C" void kernel_launch(void* const* d_in, const int* in_sizes, int n_in, void* d_out, int out_size, void* d_ws, size_t ws_size,
                              hipStream_t stream) {
  static int grid_blocks = 0;
  if (!grid_blocks) {
    int dev = 0, cus = 0, per_cu = 0;
    hipGetDevice(&dev);
    hipDeviceGetAttribute(&cus, hipDeviceAttributeMultiprocessorCount, dev);
    hipFuncSetAttribute((const void*)mega, hipFuncAttributeMaxDynamicSharedMemorySize, LDS_BYTES);
    hipOccupancyMaxActiveBlocksPerMultiprocessor(&per_cu, (const void*)mega, NT, LDS_BYTES);
    (void)hipGetLastError();
    if (per_cu < 1) per_cu = 1;
    grid_blocks = 256;
    if (cus != 256) fprintf(stderr, "kernel_launch: built for 256 CUs, device reports %d\n", cus);
    if (ws_size < WS_END2) fprintf(stderr, "kernel_launch: workspace too small: %zu < %zu\n", ws_size, (size_t)WS_END);
  }
  Params p{};
  for (int i = 0; i < 19; ++i) p.in[i] = (const float*)d_in[i];
  p.out = (float*)d_out; p.ws = (unsigned char*)d_ws;
  (void)hipMemsetAsync((unsigned char*)d_ws + WS_BAR, 0, 16384 + 128, stream);
  void* args[] = {&p};
  hipError_t e = hipLaunchCooperativeKernel((const void*)mega, dim3(grid_blocks), dim3(NT), args, LDS_BYTES, stream);
  if (e != hipSuccess) fprintf(stderr, "cooperative launch failed: %s (grid %d)\n", hipGetErrorString(e), grid_blocks);
}
```

```cpp
#include <hip/hip_runtime.h>
#include <hip/hip_cooperative_groups.h>
#include <cstdio>
#include <cstdint>
namespace cg = cooperative_groups;

typedef unsigned short bf16_t;
typedef short bf16x8 __attribute__((ext_vector_type(8)));
typedef float f32x2 __attribute__((ext_vector_type(2)));
typedef float f32x4 __attribute__((ext_vector_type(4)));
typedef float f32x16 __attribute__((ext_vector_type(16)));
typedef unsigned u32x2 __attribute__((ext_vector_type(2)));
typedef unsigned u32x4 __attribute__((ext_vector_type(4)));
typedef __bf16 bf2_t __attribute__((ext_vector_type(2)));

#define DI __device__ __forceinline__
#define OPAQUE_TID(t) int t; asm volatile("v_mbcnt_lo_u32_b32 %0, -1, 0\n\tv_mbcnt_hi_u32_b32 %0, -1, %0\n\tv_add_u32 %0, %1, %0" : "=&v"(t) : "s"(g_wave64))
#define LAS __attribute__((address_space(3)))
#define LDSP(p) ((LAS unsigned*)(p))

constexpr int SEQ = 16384, DM = 2048, DFF = 5632, INC = 6160;
#ifndef OVH
#define OVH 6
#endif
#ifndef KR
#define KR 6
#endif
#ifndef VR
#define VR 8
#endif
constexpr int NT = 512;
constexpr int LDS_BYTES = 147456;
constexpr float EPS = 1e-6f;
constexpr float LOG2E = 1.4426950408889634f;

constexpr size_t MB = 1048576;
constexpr size_t WS_BAR = 1 * MB + 768 * 1024, WS_NRM = WS_BAR + 16384, WS_ML = 484 * MB, WS_SA0 = 486 * MB, WS_SB0 = 489 * MB, WS_SAL = 492 * MB, WS_END2 = 495 * MB;
constexpr size_t WS_GA = 0, WS_GDEC = 1 * MB, WS_WFI = 2 * MB, WS_WFO = 46 * MB, WS_H = 68 * MB, WS_R = 132 * MB;
constexpr size_t WS_WIN = WS_R, WS_WV = WS_R + 16 * MB, WS_WO = WS_R + 24 * MB, WS_PROJ = WS_R + 32 * MB, WS_VT = WS_R + 160 * MB,
                 WS_O = WS_R + 224 * MB, WS_PART2 = WS_R + 288 * MB, WS_M = WS_PROJ, WS_AUP = WS_R, WS_BUP = WS_R + 176 * MB, WS_F = WS_R + 96 * MB, WS_END = WS_R + 352 * MB;

struct Params { const float* in[19]; float* out; unsigned char* ws; };

DI unsigned pk_bf16(float lo, float hi) { f32x2 v = {lo, hi}; bf2_t r = __builtin_convertvector(v, bf2_t); return __builtin_bit_cast(unsigned, r); }
DI float bf2f(bf16_t u) { return __uint_as_float(((unsigned)u) << 16); }
DI float bflo(unsigned u) { return __uint_as_float(u << 16); }
DI float bfhi(unsigned u) { return __uint_as_float(u & 0xffff0000u); }
DI f32x16 mfma32(bf16x8 a, bf16x8 b, f32x16 c) { return __builtin_amdgcn_mfma_f32_32x32x16_bf16(a, b, c, 0, 0, 0); }
DI float shx(float v, const int mask, const int lane) { return __builtin_bit_cast(float, __builtin_amdgcn_ds_bpermute((lane ^ mask) << 2, __builtin_bit_cast(int, v))); }
DI float wave_sum_l(float v, const int lane) { for (int o = 32; o > 0; o >>= 1) v += __builtin_bit_cast(float, __builtin_amdgcn_ds_bpermute((lane ^ o) << 2, __builtin_bit_cast(int, v))); return v; }
DI float wave_sum(float v) { for (int o = 32; o > 0; o >>= 1) v += __shfl_xor(v, o); return v; }
DI bf16x8 pack8(float a0, float a1, float a2, float a3, float a4, float a5, float a6, float a7) {
  u32x4 p = {pk_bf16(a0, a1), pk_bf16(a2, a3), pk_bf16(a4, a5), pk_bf16(a6, a7)}; return __builtin_bit_cast(bf16x8, p);
}
DI int perm32(int rho) { const int n = rho >> 4, i = rho & 15; return 8 * (i >> 2) + 4 * n + (i & 3); }
DI float* part_slot(const Params& p, const int slot) { return slot < 256 ? p.out + (size_t)slot * 65536 : (float*)(p.ws + WS_PART2) + (size_t)(slot - 256) * 65536; }
DI int perm23(int r) { return (r & ~12) | ((r & 4) << 1) | ((r & 8) >> 1); }

constexpr int BM = 256, BK = 64, HALF = 128, HT = HALF * BK, NXCD = 8, WGM = 8;
DI int lds_byte(int r, int c) { int st = (r >> 4) * 2 + (c >> 5), rr = r & 15, cc = c & 31, ob = rr * 64 + cc * 2; return st * 1024 + (ob ^ (((ob >> 9) & 1) << 5)); }
DI void stage_rc(int b, int& R, int& C) { int st = b / 1024, sb = b % 1024, swz = sb ^ (((sb >> 9) & 1) << 5); R = (st >> 1) * 16 + swz / 64; C = (st & 1) * 32 + (swz % 64) / 2; }

struct ConvEpi { const float* cw; const float* cb; float* sa0; float* sb0; float* sal; };
template <bool OUT_F32, int M, int N, int K, int ldc, int split_pn, int EPI = 0>
__device__ __forceinline__ void gemm_phase(const bf16_t* __restrict__ A, const bf16_t* __restrict__ Bt, void* out0, void* out1, const int g_wave64, const ConvEpi ce = ConvEpi{}) {
  OPAQUE_TID(tidx);
  extern __shared__ __attribute__((aligned(16))) unsigned char shm_raw[];
  LAS unsigned char* ldsb = (LAS unsigned char*)shm_raw;
#define SA(b, h) (((b) * 2 + (h)) * (HT * 2))
#define SB(b, h) ((4 + (b) * 2 + (h)) * (HT * 2))
#define STAGE(P, BASE, br, kt) do { const char* _gb = (const char*)(BASE) + ((size_t)(br) * K + (size_t)(kt) * BK) * 2; \
      __builtin_amdgcn_global_load_lds((const unsigned*)(_gb + so0), (LAS unsigned*)(ldsb + (P) + ldsw), 16, 0, 0); \
      __builtin_amdgcn_global_load_lds((const unsigned*)(_gb + so1), (LAS unsigned*)(ldsb + (P) + ldsw + 8192), 16, 0, 0); } while (0)
#define STAGEB(P, BASE, br, kt) do { const char* _gb = (const char*)(BASE) + ((size_t)(br) * K + (size_t)(kt) * BK) * 2; \
      __builtin_amdgcn_global_load_lds((const unsigned*)(_gb + sb0), (LAS unsigned*)(ldsb + (P) + ldsw), 16, 0, 0); \
      __builtin_amdgcn_global_load_lds((const unsigned*)(_gb + sb1), (LAS unsigned*)(ldsb + (P) + ldsw + 8192), 16, 0, 0); } while (0)
#define LDA(dst, b, h) _Pragma("unroll") for (int m = 0; m < 4; ++m) _Pragma("unroll") for (int k = 0; k < 2; ++k) \
    dst[m][k] = *(const LAS bf16x8*)(ldsb + SA(b, h) + aoff + m * 2048 + k * 1024)
#define LDB(dst, b, h) _Pragma("unroll") for (int n = 0; n < 2; ++n) _Pragma("unroll") for (int k = 0; k < 2; ++k) \
    dst[n][k] = *(const LAS bf16x8*)(ldsb + SB(b, h) + boff + n * 2048 + k * 1024)
#define MMA(ai, bj, At, Bq) do { __builtin_amdgcn_s_setprio(1); \
    _Pragma("unroll") for (int m = 0; m < 4; ++m) _Pragma("unroll") for (int n = 0; n < 2; ++n) _Pragma("unroll") for (int k = 0; k < 2; ++k) \
      acc[ai][bj][m][n] = __builtin_amdgcn_mfma_f32_16x16x32_bf16(Bq[n][k], At[m][k], acc[ai][bj][m][n], 0, 0, 0); \
    __builtin_amdgcn_s_setprio(0); } while (0)
#define WAIT_V(n) asm volatile("s_waitcnt vmcnt(" #n ")" ::: "memory")
#define WAIT_L(n) asm volatile("s_waitcnt lgkmcnt(" #n ")" ::: "memory")
#define BAR __builtin_amdgcn_s_barrier()
#define SCHED __builtin_amdgcn_sched_barrier(0)
  const int nM = M / BM, nN = N / BM, nwg = nM * nN;
  const int wid = __builtin_amdgcn_readfirstlane(tidx >> 6), lane = tidx & 63, wr = wid >> 2, wc = wid & 3, fr = lane & 15, fq = lane >> 4;
  constexpr int nt = K / BK;
  unsigned so0, so1, sb0, sb1;
  { int _r, _c; stage_rc(tidx * 16, _r, _c); so0 = (unsigned)(_r * K + _c) * 2u; sb0 = (unsigned)(((_r & ~31) + perm32(_r & 31)) * K + _c) * 2u;
    stage_rc(tidx * 16 + 8192, _r, _c); so1 = (unsigned)(_r * K + _c) * 2u; sb1 = (unsigned)(((_r & ~31) + perm32(_r & 31)) * K + _c) * 2u; }
  const unsigned ldsw = (unsigned)wid * 1024u;
  const int aoff = lds_byte(wr * 64 + fr, fq * 8), boff = lds_byte(wc * 32 + fr, fq * 8);
#define UNIT_OF(L, PM, PN) do { int _w = (L); { const int _q = nwg / NXCD, _r = nwg % NXCD, _x = _w % NXCD, _o = _w / NXCD; _w = (_x < _r ? _x * (_q + 1) : _r * (_q + 1) + (_x - _r) * _q) + _o; } \
    const int _nig = WGM * nN, _gid = _w / _nig, _fm = _gid * WGM, _gsz = min(nM - _fm, WGM); PM = _fm + ((_w % _nig) % _gsz); PN = (_w % _nig) / _gsz; } while (0)
  if ((int)blockIdx.x < nwg) {
    int pm, pn; UNIT_OF((int)blockIdx.x, pm, pn);
    int brow = pm * BM, bcol = pn * BM;
    __syncthreads();
    f32x4 acc[2][2][4][2] = {};
    bf16x8 At[4][2], B0[2][2], B1[2][2];
    STAGEB(SB(0, 0), Bt, bcol, 0); STAGEB(SB(0, 1), Bt, bcol + HALF, 0); STAGE(SA(0, 0), A, brow, 0); STAGE(SA(0, 1), A, brow + HALF, 0);
    if (wr == 1) BAR;
    WAIT_V(2); BAR;
    STAGEB(SB(1, 0), Bt, bcol, 1); STAGE(SA(1, 0), A, brow, 1); STAGEB(SB(1, 1), Bt, bcol + HALF, 1);
    WAIT_V(6); BAR;
    for (int it = 0;; ++it) {
      const int Ln = (it + 1) * (int)gridDim.x + (int)blockIdx.x;
      const bool has_next = Ln < nwg;
      int npm = pm, npn = pn; if (has_next) UNIT_OF(Ln, npm, npn);
      const int nbrow = npm * BM, nbcol = npn * BM;
      for (int t = 0; t < nt; t += 2) {
        const bool last = (t == nt - 2);
        const int r2 = last ? nbrow : brow, c2 = last ? nbcol : bcol, k2 = last ? 0 : t + 2, k3 = k2 + 1;
        LDB(B0, 0, 0); LDB(B1, 0, 1); SCHED; LDA(At, 0, 0); STAGE(SA(1, 1), A, brow + HALF, t + 1);
        WAIT_V(8); WAIT_L(0); BAR; MMA(0, 0, At, B0); MMA(0, 1, At, B1); BAR; SCHED;
        LDA(At, 0, 1); STAGEB(SB(0, 0), Bt, c2, k2); STAGEB(SB(0, 1), Bt, c2 + HALF, k2); STAGE(SA(0, 0), A, r2, k2);
        WAIT_V(8); WAIT_L(0); BAR; MMA(1, 0, At, B0); MMA(1, 1, At, B1); BAR; SCHED;
        LDB(B0, 1, 0); LDB(B1, 1, 1); SCHED; LDA(At, 1, 0); STAGE(SA(0, 1), A, r2 + HALF, k2);
        WAIT_V(8); WAIT_L(0); BAR; MMA(0, 0, At, B0); MMA(0, 1, At, B1); BAR; SCHED;
        LDA(At, 1, 1); STAGEB(SB(1, 0), Bt, c2, k3); STAGEB(SB(1, 1), Bt, c2 + HALF, k3); STAGE(SA(1, 0), A, r2, k3);
        WAIT_V(8); WAIT_L(0); BAR; MMA(1, 0, At, B0); MMA(1, 1, At, B1); BAR; SCHED;
      }
      if (wr == 0) BAR;
      if constexpr (EPI == 2) {
        LAS float* halo = (LAS float*)(ldsb + 133120);
        const int cl = wc * 32 + fq * 8;
        float w0[8], w1[8], w2[8], cbv[8];
        {
          const float* wp = ce.cw + 128 * pn + cl; const float* bp = ce.cb + 128 * pn + cl;
#pragma unroll
          for (int x4 = 0; x4 < 2; ++x4) { const f32x4 a0 = *(const f32x4*)(wp + 4 * x4), a1 = *(const f32x4*)(wp + DFF + 4 * x4), a2 = *(const f32x4*)(wp + 2 * DFF + 4 * x4), a3 = *(const f32x4*)(bp + 4 * x4);
#pragma unroll
            for (int j = 0; j < 4; ++j) { w0[x4 * 4 + j] = a0[j]; w1[x4 * 4 + j] = a1[j]; w2[x4 * 4 + j] = a2[j]; cbv[x4 * 4 + j] = a3[j]; } }
        }
        if (fr >= 14) {
#pragma unroll
          for (int ai = 0; ai < 2; ++ai) { LAS float* hp = halo + ((ai * 2 + wr) * 2 + (fr - 14)) * 128 + cl; *(LAS f32x4*)hp = acc[ai][0][3][0]; *(LAS f32x4*)(hp + 4) = acc[ai][0][3][1]; }
          if (wr == 1) { float* sp = ce.sal + ((size_t)pm * 2 + (fr - 14)) * DFF + 128 * pn + cl; *(f32x4*)sp = acc[1][0][3][0]; *(f32x4*)(sp + 4) = acc[1][0][3][1]; }
        }
        if (wr == 0 && fr < 2) {
          float* sp = ce.sa0 + ((size_t)pm * 2 + fr) * DFF + 128 * pn + cl; *(f32x4*)sp = acc[0][0][0][0]; *(f32x4*)(sp + 4) = acc[0][0][0][1];
          float* sq = ce.sb0 + ((size_t)pm * 2 + fr) * DFF + 128 * pn + cl; *(f32x4*)sq = acc[0][1][0][0]; *(f32x4*)(sq + 4) = acc[0][1][0][1];
        }
        WAIT_L(0); BAR;
        bf16_t* gp = (bf16_t*)out0 + (size_t)(brow + wr * 64 + fr) * DFF + 128 * pn + cl;
#pragma unroll
        for (int ai = 0; ai < 2; ++ai) {
          const int blk = ai * 2 + wr;
          float h62[8], h63[8];
          if (blk > 0) {
            const LAS float* hq = halo + ((blk - 1) * 2) * 128 + cl;
            const f32x4 q0 = *(const LAS f32x4*)hq, q1 = *(const LAS f32x4*)(hq + 4), q2 = *(const LAS f32x4*)(hq + 128), q3 = *(const LAS f32x4*)(hq + 132);
#pragma unroll
            for (int j = 0; j < 4; ++j) { h62[j] = q0[j]; h62[4 + j] = q1[j]; h63[j] = q2[j]; h63[4 + j] = q3[j]; }
          } else {
#pragma unroll
            for (int j = 0; j < 8; ++j) { h62[j] = 0.f; h63[j] = 0.f; }
          }
#pragma unroll
          for (int m = 0; m < 4; ++m) {
            float gv[8];
#pragma unroll
            for (int x = 0; x < 8; ++x) {
              const float cur = acc[ai][0][m][x >> 2][x & 3], bb = acc[ai][1][m][x >> 2][x & 3];
              int o1, o2;
              if (m == 0) { o1 = __float_as_int(h63[x]); o2 = __float_as_int(fr == 0 ? h62[x] : h63[x]); }
              else { const int pv = __float_as_int(acc[ai][0][m - 1][x >> 2][x & 3]);
                     o1 = __builtin_amdgcn_update_dpp(pv, pv, 0x121, 0xf, 0xf, false); o2 = __builtin_amdgcn_update_dpp(pv, pv, 0x122, 0xf, 0xf, false); }
              const float a1 = __int_as_float(__builtin_amdgcn_update_dpp(o1, __float_as_int(cur), 0x111, 0xf, 0xf, false));
              const float a2 = __int_as_float(__builtin_amdgcn_update_dpp(o2, __float_as_int(cur), 0x112, 0xf, 0xf, false));
              const float y = w0[x] * a2 + w1[x] * a1 + w2[x] * cur + cbv[x];
              const float e = __builtin_amdgcn_exp2f(-2.302208198f * (y + 0.044715f * y * y * y));
              gv[x] = y * __builtin_amdgcn_rcpf(1.0f + e) * bb;
            }
            if (!(blk == 0 && m == 0 && fr < 2)) {
              u32x4 w = {pk_bf16(gv[0], gv[1]), pk_bf16(gv[2], gv[3]), pk_bf16(gv[4], gv[5]), pk_bf16(gv[6], gv[7])};
              *(u32x4*)(gp + (size_t)(ai * HALF + m * 16) * DFF) = w;
            }
          }
        }
#pragma unroll
        for (int ai = 0; ai < 2; ++ai)
#pragma unroll
          for (int bj = 0; bj < 2; ++bj)
#pragma unroll
            for (int m = 0; m < 4; ++m) { acc[ai][bj][m][0] = (f32x4){0.f, 0.f, 0.f, 0.f}; acc[ai][bj][m][1] = (f32x4){0.f, 0.f, 0.f, 0.f}; }
      } else {
      constexpr int ES = OUT_F32 ? 4 : 2;
      char* rp = (char*)((pn < split_pn) ? out0 : out1) +
                 ((size_t)(brow + wr * 64 + fr) * ldc + (size_t)(((pn < split_pn) ? bcol : bcol - split_pn * BM) + wc * 32 + fq * 8)) * ES;
#pragma unroll
      for (int ai = 0; ai < 2; ++ai) {
#pragma unroll
        for (int m = 0; m < 4; ++m) {
#pragma unroll
          for (int bj = 0; bj < 2; ++bj) {
            const f32x4 v0 = acc[ai][bj][m][0], v1 = acc[ai][bj][m][1];
            if (OUT_F32) { *(f32x4*)(rp + (bj * HALF) * ES) = v0; *(f32x4*)(rp + (bj * HALF + 4) * ES) = v1; }
            else { u32x4 w = {pk_bf16(v0[0], v0[1]), pk_bf16(v0[2], v0[3]), pk_bf16(v1[0], v1[1]), pk_bf16(v1[2], v1[3])}; *(u32x4*)(rp + (bj * HALF) * ES) = w; }
            acc[ai][bj][m][0] = (f32x4){0.f, 0.f, 0.f, 0.f}; acc[ai][bj][m][1] = (f32x4){0.f, 0.f, 0.f, 0.f};
          }
          rp += (size_t)16 * ldc * ES;
          asm volatile("" : "+v"(rp));
        }
        rp += (size_t)(HALF - 64) * ldc * ES;
      }
      }
      if (!has_next) break;
      pm = npm; pn = npn; brow = nbrow; bcol = nbcol;
      if (wr == 1) BAR;
    }
    WAIT_V(0);
    BAR;
  }
#undef UNIT_OF
  __syncthreads();
#undef SA
#undef SB
#undef STAGE
#undef STAGEB
#undef LDA
#undef LDB
#undef MMA
}

__device__ __forceinline__ void p0_norm_ga(const Params& p, const int g_wave64) {
  extern __shared__ __attribute__((aligned(16))) float ldsf[];
  const float* x = p.in[0]; const float* g = p.in[1]; const float* w_in = p.in[2];
  bf16_t* H = (bf16_t*)(p.ws + WS_H); float* GA = (float*)(p.ws + WS_GA);
  OPAQUE_TID(tid); const int lane = tid & 63, wave = tid >> 6;
  {
    float wtmp[64];
#pragma unroll
    for (int i = 0; i < 64; ++i) { const int idx = tid + NT * i; wtmp[i] = w_in[(size_t)(idx >> 4) * INC + 3072 + (idx & 15)]; }
#pragma unroll
    for (int i = 0; i < 64; ++i) { const int idx = tid + NT * i; ldsf[(idx & 15) * 2052 + (idx >> 4)] = wtmp[i]; }
  }
  __syncthreads();
  for (int rb = blockIdx.x; rb < SEQ / 64; rb += gridDim.x) {
    for (int rp = 0; rp < 4; ++rp) {
      const int row0 = rb * 64 + wave * 8 + rp * 2;
      f32x4 xv[2][8];
#pragma unroll
      for (int q = 0; q < 2; ++q)
#pragma unroll
        for (int ii = 0; ii < 8; ++ii) xv[q][ii] = *(const f32x4*)(x + (size_t)(row0 + q) * DM + ii * 256 + lane * 4);
      float rs[2];
#pragma unroll
      for (int q = 0; q < 2; ++q) {
        float s = 0.f;
#pragma unroll
        for (int ii = 0; ii < 8; ++ii) s += xv[q][ii][0] * xv[q][ii][0] + xv[q][ii][1] * xv[q][ii][1] + xv[q][ii][2] * xv[q][ii][2] + xv[q][ii][3] * xv[q][ii][3];
        s = wave_sum_l(s, lane); rs[q] = rsqrtf(s * (1.0f / DM) + EPS);
      }
#pragma unroll
      for (int ii = 0; ii < 8; ++ii) {
        const f32x4 gv = *(const f32x4*)(g + ii * 256 + lane * 4);
#pragma unroll
        for (int q = 0; q < 2; ++q) {
          xv[q][ii] = xv[q][ii] * rs[q] * gv;
          u32x2 w = {pk_bf16(xv[q][ii][0], xv[q][ii][1]), pk_bf16(xv[q][ii][2], xv[q][ii][3])};
          *(u32x2*)(H + (size_t)(row0 + q) * DM + ii * 256 + lane * 4) = w;
        }
      }
      float a0[16], a1[16];
#pragma unroll
      for (int j = 0; j < 16; ++j) {
        float s0 = 0.f, s1 = 0.f;
#pragma unroll
        for (int ii = 0; ii < 8; ++ii) {
          const f32x4 wv = *(const f32x4*)(ldsf + j * 2052 + ii * 256 + lane * 4);
          s0 += xv[0][ii][0] * wv[0] + xv[0][ii][1] * wv[1] + xv[0][ii][2] * wv[2] + xv[0][ii][3] * wv[3];
          s1 += xv[1][ii][0] * wv[0] + xv[1][ii][1] * wv[1] + xv[1][ii][2] * wv[2] + xv[1][ii][3] * wv[3];
        }
        a0[j] = s0; a1[j] = s1;
        asm volatile("" : "+v"(a0[j]), "+v"(a1[j]) :: "memory");
      }
#define BFLY(N, MASK) _Pragma("unroll") for (int i = 0; i < (N) / 2; ++i) { const bool up = (lane & (MASK)) != 0; \
        const float sd0 = up ? a0[i] : a0[i + (N) / 2], kp0 = up ? a0[i + (N) / 2] : a0[i]; a0[i] = kp0 + shx(sd0, (MASK), lane); \
        const float sd1 = up ? a1[i] : a1[i + (N) / 2], kp1 = up ? a1[i + (N) / 2] : a1[i]; a1[i] = kp1 + shx(sd1, (MASK), lane); }
      BFLY(16, 32) BFLY(8, 16) BFLY(4, 8) BFLY(2, 4)
#undef BFLY
      float g0 = a0[0], g1 = a1[0];
      g0 += shx(g0, 2, lane); g1 += shx(g1, 2, lane);
      g0 += shx(g0, 1, lane); g1 += shx(g1, 1, lane);
      if ((lane & 3) == 0) { const int j = ((lane >> 5) & 1) * 8 + ((lane >> 4) & 1) * 4 + ((lane >> 3) & 1) * 2 + ((lane >> 2) & 1); GA[(size_t)row0 * 16 + j] = g0; GA[(size_t)(row0 + 1) * 16 + j] = g1; }
    }
  }
  __syncthreads();
}

struct TSeg { const float* src; int ld, col0, ncols, K; bf16_t* dst; };
__device__ __forceinline__ void p0_transposes(const Params& p, const int g_wave64) {
  extern __shared__ __attribute__((aligned(16))) float ldsf[];
  OPAQUE_TID(tid);
  const int ntile[8] = {32 * 16, 32 * 16, 32 * 32, 32 * 16, 32 * 16, 32 * 32, 32 * 176, 88 * 32};
  int total = 0;
  for (int i = 0; i < 8; ++i) total += ntile[i];
  const int lane = tid & 63, wave = __builtin_amdgcn_readfirstlane(tid >> 6);
  for (int tix = blockIdx.x * 8 + wave; tix < total; tix += gridDim.x * 8) {
    int s = 0, rem = tix;
    while (rem >= ntile[s]) { rem -= ntile[s]; ++s; }
    const float* src; int ld, col0, nct, K; bf16_t* dst;
    bf16_t* WinT = (bf16_t*)(p.ws + WS_WIN); bf16_t* WvT = (bf16_t*)(p.ws + WS_WV);
    switch (s) {
      case 0: src = p.in[2]; ld = INC; col0 = 0; nct = 16; K = 2048; dst = WinT; break;
      case 1: src = p.in[2]; ld = INC; col0 = 2048; nct = 16; K = 2048; dst = WinT + (size_t)1024 * 2048; break;
      case 2: src = p.in[2]; ld = INC; col0 = 3088; nct = 32; K = 2048; dst = WinT + (size_t)2048 * 2048; break;
      case 3: src = p.in[2]; ld = INC; col0 = 1024; nct = 16; K = 2048; dst = WvT; break;
      case 4: src = p.in[2]; ld = INC; col0 = 5136; nct = 16; K = 2048; dst = WvT + (size_t)1024 * 2048; break;
      case 5: src = p.in[11]; ld = 2048; col0 = 0; nct = 32; K = 2048; dst = (bf16_t*)(p.ws + WS_WO); break;
      case 6: src = p.in[14]; ld = 2 * DFF; col0 = 0; nct = 176; K = 2048; dst = (bf16_t*)(p.ws + WS_WFI); break;
      default: src = p.in[17]; ld = 2048; col0 = 0; nct = 32; K = DFF; dst = (bf16_t*)(p.ws + WS_WFO); break;
    }
    const int kt = rem / nct, ct = rem % nct;
    float* t = ldsf + wave * (64 * 65);
    f32x4 v[16];
#pragma unroll
    for (int i = 0; i < 16; ++i) v[i] = *(const f32x4*)(src + (size_t)(kt * 64 + i * 4 + (lane >> 4)) * ld + col0 + ct * 64 + (lane & 15) * 4);
#pragma unroll
    for (int i = 0; i < 16; ++i) { float* tp = t + (i * 4 + (lane >> 4)) * 65 + (lane & 15) * 4; tp[0] = v[i][0]; tp[1] = v[i][1]; tp[2] = v[i][2]; tp[3] = v[i][3]; }
    asm volatile("s_waitcnt lgkmcnt(0)" ::: "memory");
#pragma unroll
    for (int i = 0; i < 8; ++i) {
      const int nl = (lane >> 3) + 8 * i, kl = (lane & 7) * 8;
      const float* tp = t + kl * 65 + nl;
      u32x4 w = {pk_bf16(tp[0], tp[65]), pk_bf16(tp[130], tp[195]), pk_bf16(tp[260], tp[325]), pk_bf16(tp[390], tp[455])};
      int drow0 = ct * 64;
      if (s == 6) drow0 = (ct < 88) ? 256 * (ct >> 1) + 64 * (ct & 1) : 256 * ((ct - 88) >> 1) + 128 + 64 * ((ct - 88) & 1);
      *(u32x4*)(dst + (size_t)(drow0 + nl) * K + kt * 64 + kl) = w;
    }
    asm volatile("s_waitcnt lgkmcnt(0)" ::: "memory");
  }
  __syncthreads();
}

DI void gla_cumsum(const Params& p, float* Bs, float* tot, float* gas, int head, int chunk, int tid_in) {
  const float* GA = (const float*)(p.ws + WS_GA); const float* wup = p.in[3]; const float* ba = p.in[4];
  const int tid = tid_in, d = tid & 127, tg = tid >> 7;
  float w[16];
#pragma unroll
  for (int r = 0; r < 16; ++r) w[r] = wup[r * 512 + head * 128 + d];
  const float bias = ba[head * 128 + d];
  if (tid < 256) { const f32x4 gv = *(const f32x4*)(GA + (size_t)(chunk * 64 + (tid >> 2)) * 16 + (tid & 3) * 4); *(f32x4*)(gas + (tid >> 2) * 16 + (tid & 3) * 4) = gv; }
  __syncthreads();
  float run = 0.f;
#pragma unroll 4
  for (int tt = 0; tt < 16; ++tt) {
    const f32x4* gp = (const f32x4*)(gas + (tg * 16 + tt) * 16);
    const f32x4 g0 = gp[0], g1 = gp[1], g2 = gp[2], g3 = gp[3];
    float xx = bias;
    xx += g0[0] * w[0] + g0[1] * w[1] + g0[2] * w[2] + g0[3] * w[3];
    xx += g1[0] * w[4] + g1[1] * w[5] + g1[2] * w[6] + g1[3] * w[7];
    xx += g2[0] * w[8] + g2[1] * w[9] + g2[2] * w[10] + g2[3] * w[11];
    xx += g3[0] * w[12] + g3[1] * w[13] + g3[2] * w[14] + g3[3] * w[15];
    const float ls = -(fmaxf(-xx, 0.f) + __logf(1.0f + __expf(-fabsf(xx))));
    run += ls * (1.0f / 16.0f);
    Bs[(tg * 16 + tt) * 129 + d] = run;
  }
  tot[tg * 128 + d] = run;
  __syncthreads();
  float pre = 0.f;
  for (int gq = 0; gq < tg; ++gq) pre += tot[gq * 128 + d];
  for (int tt = 0; tt < 16; ++tt) Bs[(tg * 16 + tt) * 129 + d] += pre;
  __syncthreads();
}

constexpr int GL_QB = 0, GL_KB = 17408, GL_VT = 34816, GL_B = 71680, GL_TOT = GL_B + 33024, GL_ST = 71680, GL_RED = 141312, GL_GA = 142336;

DI void gla_load_vt(const Params& p, unsigned char* lds, int head, int chunk, int tid) {
  const bf16_t* VT = (const bf16_t*)(p.ws + WS_VT);
#pragma unroll
  for (int i = 0; i < 4; ++i) {
    const int id = tid + NT * i, row = id >> 3, c = id & 7;
    const u32x4 v = *(const u32x4*)(VT + (size_t)(head * 256 + row) * SEQ + chunk * 64 + c * 8);
    *(u32x4*)(lds + GL_VT + row * 144 + c * 16) = v;
  }
}

__device__ __forceinline__ void gla_g1(const Params& p, const int g_wave64) {
  extern __shared__ __attribute__((aligned(16))) unsigned char lds[];
  const bf16_t* PROJ = (const bf16_t*)(p.ws + WS_PROJ);
  float* UT = p.out; float* GDEC = (float*)(p.ws + WS_GDEC);
  OPAQUE_TID(tid); const int lane = tid & 63, wave = tid >> 6, r = lane & 31, h = lane >> 5;
  float* Bs = (float*)(lds + GL_B); float* tot = (float*)(lds + GL_TOT);
  for (int u = blockIdx.x; u < 1024; u += gridDim.x) {
    const int head = u >> 8, chunk = u & 255;
    __syncthreads();
    bf16_t kraw[16];
    {
      const int d = tid & 127, tg = tid >> 7;
#pragma unroll
      for (int tt = 0; tt < 16; ++tt) kraw[tt] = PROJ[(size_t)(chunk * 64 + tg * 16 + tt) * 4096 + 512 + head * 128 + d];
    }
    gla_load_vt(p, lds, head, chunk, tid);
    gla_cumsum(p, Bs, tot, (float*)(lds + GL_GA), head, chunk, tid);
    {
      const int d = tid & 127, tg = tid >> 7;
      const float bl = Bs[63 * 129 + d];
      float kv[16];
#pragma unroll
      for (int tt = 0; tt < 16; ++tt) {
        const int tl = tg * 16 + tt;
        const float kk = bf2f(kraw[tt]);
        kv[tt] = kk * __expf(bl - Bs[tl * 129 + d]);
      }
      u32x4 w0 = {pk_bf16(kv[0], kv[1]), pk_bf16(kv[2], kv[3]), pk_bf16(kv[4], kv[5]), pk_bf16(kv[6], kv[7])};
      u32x4 w1 = {pk_bf16(kv[8], kv[9]), pk_bf16(kv[10], kv[11]), pk_bf16(kv[12], kv[13]), pk_bf16(kv[14], kv[15])};
      *(u32x4*)(lds + GL_QB + d * 144 + tg * 32) = w0;
      *(u32x4*)(lds + GL_QB + d * 144 + tg * 32 + 16) = w1;
      if (tid < 128) GDEC[(size_t)u * 128 + d] = __expf(bl);
    }
    __syncthreads();
    f32x16 acc[4];
#pragma unroll
    for (int nb = 0; nb < 4; ++nb)
#pragma unroll
      for (int i = 0; i < 16; ++i) acc[nb][i] = 0.f;
#pragma unroll
    for (int s = 0; s < 4; ++s) {
      const bf16x8 a = *(const bf16x8*)(lds + GL_VT + (wave * 32 + r) * 144 + (16 * s + 8 * h) * 2);
#pragma unroll
      for (int nb = 0; nb < 4; ++nb) {
        const bf16x8 b = *(const bf16x8*)(lds + GL_QB + (nb * 32 + r) * 144 + (16 * s + 8 * h) * 2);
        acc[nb] = mfma32(a, b, acc[nb]);
      }
    }
    bf16_t* up = (bf16_t*)UT + (size_t)u * 32768;
#pragma unroll
    for (int nb = 0; nb < 4; ++nb)
#pragma unroll
      for (int gi = 0; gi < 16; ++gi) {
        const int e = wave * 32 + (gi & 3) + 8 * (gi >> 2) + 4 * h;
        up[e * 128 + nb * 32 + r] = (bf16_t)(pk_bf16(acc[nb][gi], 0.f) & 0xffffu);
      }
  }
  __syncthreads();
}

__device__ __forceinline__ void gla_g2(const Params& p, const int g_wave64) {
  const bf16_t* UB = (const bf16_t*)p.out; bf16_t* SB = (bf16_t*)p.out + (size_t)1024 * 32768; const float* GDEC = (const float*)(p.ws + WS_GDEC);
  OPAQUE_TID(tid);
  for (int el = blockIdx.x * NT + tid; el < 4 * 32768; el += gridDim.x * NT) {
    const int head = el >> 15, ed = el & 32767, d = ed & 127;
    const bf16_t* up = UB + (size_t)head * 256 * 32768 + ed;
    bf16_t* sp = SB + (size_t)head * 256 * 32768 + ed;
    const float* gp = GDEC + (size_t)head * 256 * 128 + d;
    float st = 0.f;
    for (int c0 = 0; c0 < 256; c0 += 32) {
      float uu[32], gg[32];
#pragma unroll
      for (int i = 0; i < 32; ++i) { uu[i] = bf2f(up[(size_t)(c0 + i) * 32768]); gg[i] = gp[(c0 + i) * 128]; }
#pragma unroll
      for (int i = 0; i < 32; ++i) { sp[(size_t)(c0 + i) * 32768] = (bf16_t)(pk_bf16(st, 0.f) & 0xffffu); st = gg[i] * st + uu[i]; }
    }
  }
}

__device__ __forceinline__ void gla_g3(const Params& p, const int g_wave64) {
  extern __shared__ __attribute__((aligned(16))) unsigned char lds[];
  const bf16_t* PROJ = (const bf16_t*)(p.ws + WS_PROJ);
  const float* ST = p.out; bf16_t* O = (bf16_t*)(p.ws + WS_O); const float* gnorm = p.in[5];
  OPAQUE_TID(tid); const int lane = tid & 63, wave = tid >> 6, r = lane & 31, h = lane >> 5;
  const int ib = wave & 1, eq = wave >> 1;
  float* Bs = (float*)(lds + GL_B); float* tot = (float*)(lds + GL_TOT); float* red = (float*)(lds + GL_RED);
  for (int u = blockIdx.x; u < 1024; u += gridDim.x) {
    const int head = u >> 8, chunk = u & 255;
    __syncthreads();
    u32x4 stv[8];
    {
      const bf16_t* sp = (const bf16_t*)ST + (size_t)1024 * 32768 + (size_t)u * 32768;
#pragma unroll
      for (int i = 0; i < 8; ++i) { const int id = tid + NT * i, e = id >> 4, c8 = id & 15; stv[i] = *(const u32x4*)(sp + e * 128 + c8 * 8); }
    }
    bf16_t qraw[16], kraw[16];
    {
      const int d = tid & 127, tg = tid >> 7;
#pragma unroll
      for (int tt = 0; tt < 16; ++tt) { const size_t ro = (size_t)(chunk * 64 + tg * 16 + tt) * 4096 + head * 128 + d; qraw[tt] = PROJ[ro]; kraw[tt] = PROJ[ro + 512]; }
    }
    gla_load_vt(p, lds, head, chunk, tid);
    gla_cumsum(p, Bs, tot, (float*)(lds + GL_GA), head, chunk, tid);
    {
      const int d = tid & 127, tg = tid >> 7;
#pragma unroll
      for (int tt = 0; tt < 16; ++tt) {
        const int tl = tg * 16 + tt;
        const float bb = Bs[tl * 129 + d];
        const float qq = bf2f(qraw[tt]) * 0.08838834764831845f * __expf(bb);
        const float kk = bf2f(kraw[tt]) * __expf(-bb);
        *(bf16_t*)(lds + GL_QB + tl * 272 + d * 2) = (bf16_t)(pk_bf16(qq, 0.f) & 0xffff);
        *(bf16_t*)(lds + GL_KB + tl * 272 + d * 2) = (bf16_t)(pk_bf16(kk, 0.f) & 0xffff);
      }
    }
    __syncthreads();
    {
#pragma unroll
      for (int i = 0; i < 8; ++i) { const int id = tid + NT * i, e = id >> 4, c8 = id & 15; *(u32x4*)(lds + GL_ST + e * 272 + c8 * 16) = stv[i]; }
    }
    __syncthreads();
    bf16x8 qf[8];
#pragma unroll
    for (int s = 0; s < 8; ++s) qf[s] = *(const bf16x8*)(lds + GL_QB + (ib * 32 + r) * 272 + (16 * s + 8 * h) * 2);
    f32x16 X[2];
#pragma unroll
    for (int jb = 0; jb < 2; ++jb) {
#pragma unroll
      for (int i = 0; i < 16; ++i) X[jb][i] = 0.f;
      if (jb <= ib) {
        const int jrow = jb * 32 + perm23(r);
#pragma unroll
        for (int s = 0; s < 8; ++s) {
          const bf16x8 a = *(const bf16x8*)(lds + GL_KB + jrow * 272 + (16 * s + 8 * h) * 2);
          X[jb] = mfma32(a, qf[s], X[jb]);
        }
        if (jb == ib) {
#pragma unroll
          for (int gi = 0; gi < 16; ++gi) {
            const int jj = (gi & 3) + 4 * ((gi >> 2) & 1) + 8 * h + 16 * ((gi >> 3) & 1);
            if (jj > r) X[jb][gi] = 0.f;
          }
        }
      }
    }
    f32x16 acc[2];
#pragma unroll
    for (int eb = 0; eb < 2; ++eb)
#pragma unroll
      for (int i = 0; i < 16; ++i) acc[eb][i] = 0.f;
    const int e0 = eq * 64;
#pragma unroll
    for (int jb = 0; jb < 2; ++jb) {
      if (jb <= ib) {
#pragma unroll
        for (int s2 = 0; s2 < 2; ++s2) {
          const bf16x8 pf = pack8(X[jb][8 * s2 + 0], X[jb][8 * s2 + 1], X[jb][8 * s2 + 2], X[jb][8 * s2 + 3],
                                  X[jb][8 * s2 + 4], X[jb][8 * s2 + 5], X[jb][8 * s2 + 6], X[jb][8 * s2 + 7]);
#pragma unroll
          for (int eb = 0; eb < 2; ++eb) {
            const bf16x8 a = *(const bf16x8*)(lds + GL_VT + (e0 + eb * 32 + r) * 144 + (jb * 32 + 16 * s2 + 8 * h) * 2);
            acc[eb] = mfma32(a, pf, acc[eb]);
          }
        }
      }
    }
#pragma unroll
    for (int s = 0; s < 8; ++s)
#pragma unroll
      for (int eb = 0; eb < 2; ++eb) {
        const bf16x8 a = *(const bf16x8*)(lds + GL_ST + (e0 + eb * 32 + r) * 272 + (16 * s + 8 * h) * 2);
        acc[eb] = mfma32(a, qf[s], acc[eb]);
      }
    float ss = 0.f;
#pragma unroll
    for (int eb = 0; eb < 2; ++eb)
#pragma unroll
      for (int i = 0; i < 16; ++i) ss += acc[eb][i] * acc[eb][i];
    ss += shx(ss, 32, lane);
    if (h == 0) red[eq * 64 + ib * 32 + r] = ss;
    __syncthreads();
    const int il = ib * 32 + r;
    const float tsum = red[il] + red[64 + il] + red[128 + il] + red[192 + il];
    const float rstd = rsqrtf(tsum * (1.0f / 256.0f) + EPS);
    const int token = chunk * 64 + il;
#pragma unroll
    for (int eb = 0; eb < 2; ++eb)
#pragma unroll
      for (int g4 = 0; g4 < 4; ++g4) {
        const int eb0 = e0 + eb * 32 + 8 * g4 + 4 * h;
        const u32x2 gt = *(const u32x2*)(PROJ + (size_t)token * 4096 + 1024 + head * 256 + eb0);
        const f32x4 gn = *(const f32x4*)(gnorm + eb0);
        float gv[4] = {bflo(gt[0]), bfhi(gt[0]), bflo(gt[1]), bfhi(gt[1])};
        float y[4];
#pragma unroll
        for (int j = 0; j < 4; ++j) { const float sg = gv[j] * __builtin_amdgcn_rcpf(1.0f + __expf(-gv[j])); y[j] = acc[eb][g4 * 4 + j] * rstd * gn[j] * sg; }
        u32x2 w = {pk_bf16(y[0], y[1]), pk_bf16(y[2], y[3])};
        *(u32x2*)(O + (size_t)token * DM + head * 256 + eb0) = w;
      }
  }
  __syncthreads();
}

#define LDSADDR(p) ((unsigned)(unsigned long)(p))
DI void lds_rd128(bf16x8& dst, const unsigned addr) { asm volatile("ds_read_b128 %0, %1" : "=v"(dst) : "v"(addr)); }
DI void lgkm_wait(const int n, bf16x8& reg) {
  switch (n) {
    case 0: asm volatile("s_waitcnt lgkmcnt(0)" : "+v"(reg)); break;
    case 1: asm volatile("s_waitcnt lgkmcnt(1)" : "+v"(reg)); break;
    case 2: asm volatile("s_waitcnt lgkmcnt(2)" : "+v"(reg)); break;
    case 3: asm volatile("s_waitcnt lgkmcnt(3)" : "+v"(reg)); break;
    case 4: asm volatile("s_waitcnt lgkmcnt(4)" : "+v"(reg)); break;
    case 5: asm volatile("s_waitcnt lgkmcnt(5)" : "+v"(reg)); break;
    case 6: asm volatile("s_waitcnt lgkmcnt(6)" : "+v"(reg)); break;
    default: asm volatile("s_waitcnt lgkmcnt(7)" : "+v"(reg)); break;
  }
}
__device__ __forceinline__ void attn_finish(f32x16 (&o)[8], const float l, const Params& p, unsigned char* lds, const int tid, const int pr, const int comp, const int q0, const int head) {
  bf16_t* O = (bf16_t*)(p.ws + WS_O); const float* dnorm = p.in[10];
  {
      int t3 = tid; asm volatile("" : "+v"(t3));
      const float lt = l + __builtin_bit_cast(float, __builtin_amdgcn_ds_bpermute(((t3 & 63) ^ 32) << 2, __builtin_bit_cast(int, l)));
      float* ex = (float*)lds + (size_t)pr * 8192;
      const int lane_e = t3 & 63, h_e = lane_e >> 5, qrow_e = q0 + pr * 32 + (lane_e & 31);
      if (comp == 1) {
        float lam;
        {
          const float* q1 = p.in[6]; const float* k1 = p.in[7]; const float* q2 = p.in[8]; const float* k2 = p.in[9];
          float s1 = q1[lane_e] * k1[lane_e] + q1[lane_e + 64] * k1[lane_e + 64];
          float s2 = q2[lane_e] * k2[lane_e] + q2[lane_e + 64] * k2[lane_e + 64];
          s1 = wave_sum_l(s1, lane_e); s2 = wave_sum_l(s2, lane_e);
          lam = expf(s1) - expf(s2) + 0.2f;
        }
        const float sc = lam / lt;
#pragma unroll
        for (int dvb = 0; dvb < 8; ++dvb)
#pragma unroll
          for (int gi = 0; gi < 16; ++gi) ex[(dvb * 16 + gi) * 64 + lane_e] = o[dvb][gi] * sc;
      }
      __syncthreads();
      if (comp == 0) {
        const float sc = 1.0f / lt;
        float ss = 0.f;
#pragma unroll
        for (int dvb = 0; dvb < 8; ++dvb) {
#pragma unroll
          for (int gi = 0; gi < 16; ++gi) { const float dv = o[dvb][gi] * sc - ex[(dvb * 16 + gi) * 64 + lane_e]; o[dvb][gi] = dv; ss += dv * dv; }
          asm volatile("" : "+v"(o[dvb]), "+v"(ss) :: "memory");
        }
        ss += __builtin_bit_cast(float, __builtin_amdgcn_ds_bpermute((lane_e ^ 32) << 2, __builtin_bit_cast(int, ss)));
        const float rstd = rsqrtf(ss * (1.0f / 256.0f) + EPS) * 0.8f;
#pragma unroll
        for (int dvb = 0; dvb < 8; ++dvb)
#pragma unroll
          for (int g4 = 0; g4 < 4; ++g4) {
            const int dv0 = dvb * 32 + 8 * g4 + 4 * h_e;
            const f32x4 gn = *(const f32x4*)(dnorm + dv0);
            u32x2 w = {pk_bf16(o[dvb][g4 * 4 + 0] * rstd * gn[0], o[dvb][g4 * 4 + 1] * rstd * gn[1]),
                       pk_bf16(o[dvb][g4 * 4 + 2] * rstd * gn[2], o[dvb][g4 * 4 + 3] * rstd * gn[3])};
            *(u32x2*)(O + (size_t)qrow_e * DM + 1024 + head * 256 + dv0) = w;
          }
      }
      __syncthreads();
  }
}

__device__ __forceinline__ void attn_norms(const Params& p, const int g_wave64) {
  extern __shared__ __attribute__((aligned(16))) unsigned char lds[];
  const bf16_t* PROJ = (const bf16_t*)(p.ws + WS_PROJ); unsigned* NRM = (unsigned*)(p.ws + WS_NRM);
  OPAQUE_TID(tid); const int lane = tid & 63, wave = tid >> 6;
  float* red = (float*)lds;
  float mx0 = 0.f, mx1 = 0.f, mx2 = 0.f;
  for (int rb = blockIdx.x; rb < SEQ / 64; rb += gridDim.x) {
    const int row = rb * 64 + (tid >> 3), j = tid & 7;
    const bf16_t* qp = PROJ + (size_t)row * 4096 + 2048 + j * 128;
    const bf16_t* kp = qp + 1024;
    float qq = 0.f, kk = 0.f, qk = 0.f;
#pragma unroll
    for (int c = 0; c < 16; ++c) { const u32x4 v = *(const u32x4*)(qp + c * 8), w = *(const u32x4*)(kp + c * 8);
#pragma unroll
      for (int e = 0; e < 4; ++e) { const float a = bflo(v[e]), bb = bfhi(v[e]), c2 = bflo(w[e]), d2 = bfhi(w[e]); qq += a * a + bb * bb; kk += c2 * c2 + d2 * d2; qk += a * c2 + bb * d2; } }
    mx0 = fmaxf(mx0, qq); mx1 = fmaxf(mx1, kk); mx2 = fmaxf(mx2, -qk);
  }
  for (int o = 8; o < 64; o <<= 1) { mx0 = fmaxf(mx0, shx(mx0, o, lane)); mx1 = fmaxf(mx1, shx(mx1, o, lane)); mx2 = fmaxf(mx2, shx(mx2, o, lane)); }
  __syncthreads();
  if (lane < 8) { red[wave * 24 + lane] = mx0; red[wave * 24 + 8 + lane] = mx1; red[wave * 24 + 16 + lane] = mx2; }
  __syncthreads();
  if (tid < 24) { float mm = 0.f; for (int w = 0; w < 8; ++w) mm = fmaxf(mm, red[w * 24 + tid]); atomicMax(NRM + tid, __float_as_uint(mm)); }
  __syncthreads();
}
__device__ __forceinline__ void attn_plan(const Params& p, int (&dh)[4]) {
  unsigned* NRM = (unsigned*)(p.ws + WS_NRM);
#pragma unroll
  for (int hh = 0; hh < 4; ++hh) {
    float bound = 0.f;
#pragma unroll
    for (int c = 0; c < 2; ++c) {
      const float qn = __uint_as_float(__hip_atomic_load(NRM + hh * 2 + c, __ATOMIC_RELAXED, __HIP_MEMORY_SCOPE_AGENT));
      const float kn = __uint_as_float(__hip_atomic_load(NRM + 8 + hh * 2 + c, __ATOMIC_RELAXED, __HIP_MEMORY_SCOPE_AGENT));
      const float dg = __uint_as_float(__hip_atomic_load(NRM + 16 + hh * 2 + c, __ATOMIC_RELAXED, __HIP_MEMORY_SCOPE_AGENT));
      bound = fmaxf(bound, (sqrtf(qn * kn) + dg) * (0.08838834764831845f * LOG2E * 1.02f));
    }
    const float slope2 = exp2f(-2.0f * (float)(hh + 1)) * LOG2E;
    const float D = (bound + 152.0f) / slope2;
    dh[hh] = __builtin_amdgcn_readfirstlane((D < 1.0e9f) ? (int)D : 1000000000);
  }
}
__device__ __forceinline__ int attn_nsteps(const int head, const int qb, const int (&dh)[4]) {
  const int d = dh[0] * (head == 0) + dh[1] * (head == 1) + dh[2] * (head == 2) + dh[3] * (head == 3);
  int ttmin = (128 * qb - d) / 64 - 1; ttmin = ttmin < 0 ? 0 : ttmin;
  return 2 * qb + 2 - ttmin;
}
constexpr int ATT_TAB = 132096;
__device__ __forceinline__ void attn_build_plan(const Params& p, unsigned char* lds, const int tid) {
  int* tab = (int*)(lds + ATT_TAB);
  __syncthreads();
  int dh[4]; attn_plan(p, dh);
  if (tid < 256) {
    const int r = tid >> 5, j = tid & 31;
    int v = attn_nsteps(r >> 1, 127 - (r & 1) * 32 - j, dh) + attn_nsteps(r >> 1, (r & 1) * 32 + j, dh) + 2 * OVH;
    for (int o = 1; o < 32; o <<= 1) { const int w = __builtin_amdgcn_ds_bpermute(((tid & 63) ^ o) << 2, v); v = w > v ? w : v; }
    if (j == 0) tab[128 + r] = v;
  }
  __syncthreads();
  if (tid == 0) {
    const int xg = (int)blockIdx.x & 7, jq = (int)blockIdx.x >> 3;
    int R = 0;
#pragma unroll 1
    for (int r = 0; r < 8; ++r) R += tab[128 + r];
    const int Xa = (xg * R) / 8, Xb = ((xg + 1) * R) / 8;
    int P = 0; int first = 1;
#pragma unroll 1
    for (int r = 0; r < 8; ++r) {
      const int head = r >> 1, pg = r & 1, rlen = tab[128 + r];
      const int ra = (Xa > P ? Xa : P) - P, rb = (Xb < P + rlen ? Xb : P + rlen) - P;
      int off = 0;
#pragma unroll 1
      for (int part = 0; part < 2; ++part) {
        const int qb = part == 0 ? pg * 32 + jq : 127 - pg * 32 - jq;
        const int nst = attn_nsteps(head, qb, dh);
        int t_lo = ra - off, t_hi = rb - off;
        t_lo = t_lo < 0 ? 0 : t_lo; t_hi = t_hi > nst ? nst : t_hi;
        int* e = tab + (r * 2 + part) * 8;
        e[2] = nst; e[6] = qb;
        if (ra >= rb || t_lo >= t_hi) { e[0] = 0; e[1] = 0; e[3] = 0; e[4] = 0; e[5] = 0; }
        else {
          e[0] = t_lo; e[1] = t_hi; e[3] = 2 * (int)blockIdx.x + (first ? 0 : 1); first = 0;
          int cflag = 0, xend = xg;
          if (t_lo == 0 && t_hi < nst) {
            cflag = 1;
            for (int xx = xg + 1; xx < 8; ++xx) { if ((xx * R) / 8 - (P + off) >= nst) break; xend = xx; }
          }
          e[4] = cflag; e[5] = xend;
        }
        off += nst + OVH;
      }
      P += rlen;
    }
  }
  __syncthreads();
}
__device__ __forceinline__ void attn_phase(const Params& p, const int g_wave64) {
  extern __shared__ __attribute__((aligned(16))) unsigned char lds[];
  const bf16_t* PROJ = (const bf16_t*)(p.ws + WS_PROJ); const bf16_t* VT = (const bf16_t*)(p.ws + WS_VT);
  OPAQUE_TID(tid); const int lane = tid & 63, wave = __builtin_amdgcn_readfirstlane(tid >> 6), r = lane & 31, h = lane >> 5;
  const int comp = wave & 1, pr = wave >> 1;
  LAS unsigned char* L = (LAS unsigned char*)lds;
  const int pr_r = perm23(r);
  const unsigned kbase = (unsigned)pr_r * 256u, khs_c = (unsigned)((h ^ (pr_r & 15)) << 4);
  const unsigned vbase = (unsigned)r * 128u, vhs_c = (unsigned)((h ^ ((r >> 1) & 7)) << 4);
  const float C1 = 0.08838834764831845f * LOG2E;
  attn_build_plan(p, lds, tid);
  const int jq = (int)blockIdx.x >> 3;
#pragma unroll 1
  for (int rr = 0; rr < 16; ++rr) {
    const int* e = (const int*)(lds + ATT_TAB) + rr * 8;
    const int t_lo = __builtin_amdgcn_readfirstlane(e[0]), t_hi = __builtin_amdgcn_readfirstlane(e[1]), nst = __builtin_amdgcn_readfirstlane(e[2]), slot = __builtin_amdgcn_readfirstlane(e[3]);
    if (t_lo >= t_hi) continue;
    const int head = rr >> 2, qb = __builtin_amdgcn_readfirstlane(e[6]);
    const float slope2 = exp2f(-2.0f * (float)(head + 1)) * LOG2E;
    {
      const int q0 = qb * 128, ntiles = 2 * qb + 2;
      const int qrow = q0 + pr * 32 + r;
      bf16x8 qf[8];
      {
        int t4 = tid; asm volatile("" : "+v"(t4));
        const bf16_t* qp = PROJ + (size_t)(q0 + pr * 32 + (t4 & 31)) * 4096 + 2048 + head * 256 + comp * 128 + 8 * ((t4 >> 5) & 1);
#pragma unroll
        for (int s = 0; s < 8; ++s) {
          const u32x4 raw = *(const u32x4*)(qp + 16 * s);
          u32x4 sc;
#pragma unroll
          for (int j = 0; j < 4; ++j) sc[j] = pk_bf16(bflo(raw[j]) * C1, bfhi(raw[j]) * C1);
          qf[s] = __builtin_bit_cast(bf16x8, sc);
        }
      }
      f32x16 o[8];
#pragma unroll
      for (int dvb = 0; dvb < 8; ++dvb)
#pragma unroll
        for (int i = 0; i < 16; ++i) o[dvb][i] = 0.f;
      float m = -1e30f, l = 0.f;
#define ISSUE_TILE(T, BUF) do { int _t2 = tid; asm volatile("" : "+v"(_t2)); \
      const char* _kg = (const char*)PROJ + ((size_t)(T) * 64 * 4096 + 3072 + head * 256) * 2; \
      const char* _vg = (const char*)VT + ((size_t)(1024 + head * 256) * SEQ + (size_t)(T) * 64) * 2; \
      LAS unsigned char* _b = L + (BUF) * 65536 + wave * 1024; \
      _Pragma("unroll") for (int _i = 0; _i < 4; ++_i) { const int _slot = _t2 + NT * _i, _cmp = _slot >> 10, _sl = _slot & 1023, _row = _sl >> 4, _c = (_sl & 15) ^ (_row & 15); \
        __builtin_amdgcn_global_load_lds((const unsigned*)(_kg + (unsigned)((_row * 4096 + _cmp * 128 + _c * 8) * 2)), (LAS unsigned*)(_b + _i * 8192), 16, 0, 0); } \
      _Pragma("unroll") for (int _i = 0; _i < 4; ++_i) { const int _slot = _t2 + NT * _i, _row = _slot >> 3, _c = (_slot & 7) ^ ((_row >> 1) & 7); \
        __builtin_amdgcn_global_load_lds((const unsigned*)(_vg + (unsigned)((_row * SEQ + _c * 8) * 2)), (LAS unsigned*)(_b + 32768 + _i * 8192), 16, 0, 0); } } while (0)
#define ISSUE_PIECE(T, BUF, I) do { int _t2 = tid; asm volatile("" : "+v"(_t2)); LAS unsigned char* _b = L + (BUF) * 65536 + wave * 1024; \
      if ((I) < 4) { const int _slot = _t2 + NT * (I), _cmp = _slot >> 10, _sl = _slot & 1023, _row = _sl >> 4, _c = (_sl & 15) ^ (_row & 15); \
        const char* _kg = (const char*)PROJ + ((size_t)(T) * 64 * 4096 + 3072 + head * 256) * 2; \
        __builtin_amdgcn_global_load_lds((const unsigned*)(_kg + (unsigned)((_row * 4096 + _cmp * 128 + _c * 8) * 2)), (LAS unsigned*)(_b + (I) * 8192), 16, 0, 0); } \
      else { const int _slot = _t2 + NT * ((I) - 4), _row = _slot >> 3, _c = (_slot & 7) ^ ((_row >> 1) & 7); \
        const char* _vg = (const char*)VT + ((size_t)(1024 + head * 256) * SEQ + (size_t)(T) * 64) * 2; \
        __builtin_amdgcn_global_load_lds((const unsigned*)(_vg + (unsigned)((_row * SEQ + _c * 8) * 2)), (LAS unsigned*)(_b + 32768 + ((I) - 4) * 8192), 16, 0, 0); } } while (0)
      __syncthreads();
      ISSUE_TILE(ntiles - 1 - t_lo, 0);
      asm volatile("s_waitcnt vmcnt(0)" ::: "memory");
      __syncthreads();
      for (int t = t_lo; t < t_hi; ++t) {
        const int buf = (t - t_lo) & 1, tt = ntiles - 1 - t;
        const bool do_issue = (t + 1 < t_hi);
        const int k0 = tt * 64;
        const bool act = (k0 <= q0 + pr * 32 + 31);
        if (do_issue && !act) ISSUE_TILE(tt - 1, buf ^ 1);
        if (act) {
          LAS unsigned char* kb = L + (buf * 65536 + comp * 16384);
          LAS unsigned char* vb = L + (buf * 65536 + 32768);
#define KADDR(f) (kb + ((f) & 1) * 8192 + (kbase + ((unsigned)(((f) >> 1) * 32) ^ khs)))
#define VADDR(f) (vb + ((f) & 7) * 4096 + (vbase + ((unsigned)(((f) >> 3) * 32) ^ vhs)))
          unsigned khs = khs_c, vhs = vhs_c; asm volatile("" : "+v"(khs), "+v"(vhs));
          bf16x8 kf[KR];
#pragma unroll
          for (int f = 0; f < KR; ++f) lds_rd128(kf[f], LDSADDR(KADDR(f)));
          float sl2 = slope2; asm volatile("" : "+v"(sl2));
          const float mref = (m > -1e29f) ? m : 0.f;
          const float tb = sl2 * (float)(k0 + 8 * h - q0) - mref;
          f32x16 sa0, sa1;
          {
            const float s4x = sl2 * 4.0f, s16x = s4x * 4.0f, s32x = s16x + s16x;
            sa0[0] = tb; sa0[1] = tb + sl2; sa0[2] = sa0[1] + sl2; sa0[3] = sa0[2] + sl2;
#pragma unroll
            for (int gi = 0; gi < 4; ++gi) sa0[4 + gi] = sa0[gi] + s4x;
#pragma unroll
            for (int gi = 0; gi < 8; ++gi) sa0[8 + gi] = sa0[gi] + s16x;
#pragma unroll
            for (int gi = 0; gi < 16; ++gi) sa1[gi] = sa0[gi] + s32x;
          }
#pragma unroll
          for (int f = 0; f < 16; ++f) {
            lgkm_wait((15 - f) < (KR - 1) ? (15 - f) : (KR - 1), kf[f % KR]);
            if (f & 1) sa1 = mfma32(kf[f % KR], qf[f >> 1], sa1); else sa0 = mfma32(kf[f % KR], qf[f >> 1], sa0);
            if (f + KR < 16) lds_rd128(kf[f % KR], LDSADDR(KADDR(f + KR)));
            __builtin_amdgcn_sched_barrier(0);
          }
          bf16x8 vf[VR];
#pragma unroll
          for (int f = 0; f < VR; ++f) lds_rd128(vf[f], LDSADDR(VADDR(f)));
          __builtin_amdgcn_sched_barrier(0);
          if (do_issue) { ISSUE_PIECE(tt - 1, buf ^ 1, 0); ISSUE_PIECE(tt - 1, buf ^ 1, 1); ISSUE_PIECE(tt - 1, buf ^ 1, 2); ISSUE_PIECE(tt - 1, buf ^ 1, 3); }
          __builtin_amdgcn_sched_barrier(0);
          if (k0 + 63 > q0 + pr * 32) {
#pragma unroll
            for (int gi = 0; gi < 16; ++gi) {
              const int koff = (gi & 3) + 4 * ((gi >> 2) & 1) + 16 * ((gi >> 3) & 1);
              if (k0 + koff + 8 * h > qrow) sa0[gi] = -1e30f;
              if (k0 + koff + 32 + 8 * h > qrow) sa1[gi] = -1e30f;
            }
          }
          float mloc = fmaxf(sa0[0], sa1[0]);
#pragma unroll
          for (int gi = 1; gi < 16; ++gi) mloc = fmaxf(mloc, fmaxf(sa0[gi], sa1[gi]));
          mloc = fmaxf(mloc, shx(mloc, 32, lane));
          const float mrel = m - mref;
          const float delta = fmaxf(mrel, mloc);
          if (__ballot(delta > mrel) != 0ull) {
            const float alpha = __builtin_amdgcn_exp2f(mrel - delta);
            l *= alpha;
#pragma unroll
            for (int dvb = 0; dvb < 8; ++dvb) o[dvb] = o[dvb] * alpha;
#pragma unroll
            for (int gi = 0; gi < 16; ++gi) { sa0[gi] -= delta; sa1[gi] -= delta; }
          }
          m = mref + delta;
          float ps = 0.f;
#pragma unroll
          for (int gi = 0; gi < 16; ++gi) {
            const float p0 = __builtin_amdgcn_exp2f(sa0[gi]), p1 = __builtin_amdgcn_exp2f(sa1[gi]);
            sa0[gi] = p0; sa1[gi] = p1; ps += p0 + p1;
          }
          l += ps;
          __builtin_amdgcn_sched_barrier(0);
          if (do_issue) { ISSUE_PIECE(tt - 1, buf ^ 1, 4); ISSUE_PIECE(tt - 1, buf ^ 1, 5); ISSUE_PIECE(tt - 1, buf ^ 1, 6); ISSUE_PIECE(tt - 1, buf ^ 1, 7); }
          __builtin_amdgcn_sched_barrier(0);
          bf16x8 pf[4];
          pf[0] = pack8(sa0[0], sa0[1], sa0[2], sa0[3], sa0[4], sa0[5], sa0[6], sa0[7]);
          pf[1] = pack8(sa0[8], sa0[9], sa0[10], sa0[11], sa0[12], sa0[13], sa0[14], sa0[15]);
          pf[2] = pack8(sa1[0], sa1[1], sa1[2], sa1[3], sa1[4], sa1[5], sa1[6], sa1[7]);
          pf[3] = pack8(sa1[8], sa1[9], sa1[10], sa1[11], sa1[12], sa1[13], sa1[14], sa1[15]);
          __builtin_amdgcn_sched_barrier(0);
#pragma unroll
          for (int f = 0; f < 32; ++f) {
            lgkm_wait((31 - f) < (VR - 1) ? (31 - f) : (VR - 1), vf[f % VR]);
            o[f & 7] = mfma32(vf[f % VR], pf[f >> 3], o[f & 7]);
            if (f + VR < 32) lds_rd128(vf[f % VR], LDSADDR(VADDR(f + VR)));
            __builtin_amdgcn_sched_barrier(0);
          }
#undef KADDR
#undef VADDR
        }
        asm volatile("s_waitcnt vmcnt(0)" ::: "memory");
        __syncthreads();
      }
#undef ISSUE_TILE
#undef ISSUE_PIECE
      if (t_lo == 0 && t_hi == nst) {
        attn_finish(o, l, p, lds, tid, pr, comp, q0, head);
      } else {
        int t5 = tid; asm volatile("" : "+v"(t5));
        float* ps = part_slot(p, slot) + wave * 8192 + (t5 & 63);
#pragma unroll
        for (int dvb = 0; dvb < 8; ++dvb)
#pragma unroll
          for (int gi = 0; gi < 16; ++gi) ps[(dvb * 16 + gi) * 64] = o[dvb][gi];
        float* ml = (float*)(p.ws + WS_ML) + ((size_t)slot * 8 + wave) * 128 + (t5 & 63);
        ml[0] = m; ml[64] = l;
      }
    }
  }
  __syncthreads();
}

__device__ __forceinline__ void attn_combine(const Params& p, const int g_wave64) {
  extern __shared__ __attribute__((aligned(16))) unsigned char lds[];
  OPAQUE_TID(tid); const int lane = tid & 63, wave = __builtin_amdgcn_readfirstlane(tid >> 6);
  const int comp = wave & 1, pr = wave >> 1;
  attn_build_plan(p, lds, tid);
  const int xg = (int)blockIdx.x & 7, jq = (int)blockIdx.x >> 3;
#pragma unroll 1
  for (int rr = 0; rr < 16; ++rr) {
    const int* e = (const int*)(lds + ATT_TAB) + rr * 8;
    const int cflag = __builtin_amdgcn_readfirstlane(e[4]), xend = __builtin_amdgcn_readfirstlane(e[5]), slot0 = __builtin_amdgcn_readfirstlane(e[3]);
    if (!cflag) continue;
    const int head = rr >> 2, qb = __builtin_amdgcn_readfirstlane(e[6]);
    f32x16 o[8]; float m, l;
    {
      const int slot = slot0;
      const float* ps = part_slot(p, slot) + wave * 8192 + lane;
#pragma unroll
      for (int dvb = 0; dvb < 8; ++dvb)
#pragma unroll
        for (int gi = 0; gi < 16; ++gi) o[dvb][gi] = ps[(dvb * 16 + gi) * 64];
      const float* ml = (const float*)(p.ws + WS_ML) + ((size_t)slot * 8 + wave) * 128 + lane;
      m = ml[0]; l = ml[64];
    }
    for (int xx = xg + 1; xx <= xend; ++xx) {
      const int slot = 2 * (jq * 8 + xx);
      const float* ml = (const float*)(p.ws + WS_ML) + ((size_t)slot * 8 + wave) * 128 + lane;
      const float ms = ml[0], ls = ml[64];
      const float mn = fmaxf(m, ms);
      const float a0 = __builtin_amdgcn_exp2f(m - mn), a1 = __builtin_amdgcn_exp2f(ms - mn);
      const float* ps = part_slot(p, slot) + wave * 8192 + lane;
#pragma unroll
      for (int dvb = 0; dvb < 8; ++dvb) {
#pragma unroll
        for (int gi = 0; gi < 16; ++gi) o[dvb][gi] = o[dvb][gi] * a0 + ps[(dvb * 16 + gi) * 64] * a1;
        asm volatile("" : "+v"(o[dvb]) :: "memory");
      }
      l = l * a0 + ls * a1; m = mn;
    }
    attn_finish(o, l, p, lds, tid, pr, comp, qb * 128, head);
  }
  __syncthreads();
}

__device__ __forceinline__ void p6_post_attn(const Params& p, const int g_wave64) {
  const float* x = p.in[0]; const float* gp = p.in[12]; const float* gf = p.in[13];
  const bf16_t* Mb = (const bf16_t*)(p.ws + WS_M); bf16_t* H = (bf16_t*)(p.ws + WS_H);
  OPAQUE_TID(tid); const int lane = tid & 63, wave = tid >> 6;
  for (int row = blockIdx.x * 8 + wave; row < SEQ; row += gridDim.x * 8) {
    f32x4 mv[8];
    float s = 0.f;
#pragma unroll
    for (int ii = 0; ii < 8; ++ii) { const u32x2 rw = *(const u32x2*)(Mb + (size_t)row * DM + ii * 256 + lane * 4); mv[ii] = (f32x4){bflo(rw[0]), bfhi(rw[0]), bflo(rw[1]), bfhi(rw[1])}; s += mv[ii][0] * mv[ii][0] + mv[ii][1] * mv[ii][1] + mv[ii][2] * mv[ii][2] + mv[ii][3] * mv[ii][3]; }
    s = wave_sum_l(s, lane);
    const float rs = rsqrtf(s * (1.0f / DM) + EPS);
    float s2 = 0.f;
#pragma unroll
    for (int ii = 0; ii < 8; ++ii) {
      const f32x4 xv = *(const f32x4*)(x + (size_t)row * DM + ii * 256 + lane * 4);
      const f32x4 g = *(const f32x4*)(gp + ii * 256 + lane * 4);
      mv[ii] = xv + mv[ii] * rs * g;
      s2 += mv[ii][0] * mv[ii][0] + mv[ii][1] * mv[ii][1] + mv[ii][2] * mv[ii][2] + mv[ii][3] * mv[ii][3];
    }
    s2 = wave_sum_l(s2, lane);
    const float rs2 = rsqrtf(s2 * (1.0f / DM) + EPS);
#pragma unroll
    for (int ii = 0; ii < 8; ++ii) {
      const f32x4 g = *(const f32x4*)(gf + ii * 256 + lane * 4);
      const f32x4 hv = mv[ii] * rs2 * g;
      u32x2 w = {pk_bf16(hv[0], hv[1]), pk_bf16(hv[2], hv[3])};
      *(u32x2*)(H + (size_t)row * DM + ii * 256 + lane * 4) = w;
    }
  }
}

__device__ __forceinline__ void p10_final(const Params& p, const int g_wave64) {
  const float* x = p.in[0]; const float* gm = p.in[12]; const float* gp = p.in[18];
  const bf16_t* Mb = (const bf16_t*)(p.ws + WS_M); const bf16_t* F = (const bf16_t*)(p.ws + WS_F); float* out = p.out;
  OPAQUE_TID(tid); const int lane = tid & 63, wave = tid >> 6;
  for (int row = blockIdx.x * 8 + wave; row < SEQ; row += gridDim.x * 8) {
    f32x4 mv[8], fv[8];
    float s = 0.f, sm = 0.f;
#pragma unroll
    for (int ii = 0; ii < 8; ++ii) {
      const u32x2 rw = *(const u32x2*)(F + (size_t)row * DM + ii * 256 + lane * 4); fv[ii] = (f32x4){bflo(rw[0]), bfhi(rw[0]), bflo(rw[1]), bfhi(rw[1])};
      const u32x2 rm = *(const u32x2*)(Mb + (size_t)row * DM + ii * 256 + lane * 4); mv[ii] = (f32x4){bflo(rm[0]), bfhi(rm[0]), bflo(rm[1]), bfhi(rm[1])};
      s += fv[ii][0] * fv[ii][0] + fv[ii][1] * fv[ii][1] + fv[ii][2] * fv[ii][2] + fv[ii][3] * fv[ii][3];
      sm += mv[ii][0] * mv[ii][0] + mv[ii][1] * mv[ii][1] + mv[ii][2] * mv[ii][2] + mv[ii][3] * mv[ii][3];
    }
    s = wave_sum_l(s, lane); sm = wave_sum_l(sm, lane);
    const float rs = rsqrtf(s * (1.0f / DM) + EPS), rsm = rsqrtf(sm * (1.0f / DM) + EPS);
#pragma unroll
    for (int ii = 0; ii < 8; ++ii) {
      const f32x4 xv = *(const f32x4*)(x + (size_t)row * DM + ii * 256 + lane * 4);
      const f32x4 g1 = *(const f32x4*)(gm + ii * 256 + lane * 4);
      const f32x4 g = *(const f32x4*)(gp + ii * 256 + lane * 4);
      *(f32x4*)(out + (size_t)row * DM + ii * 256 + lane * 4) = (xv + mv[ii] * rsm * g1) + fv[ii] * rs * g;
    }
  }
}
__device__ __forceinline__ void p8_fixup(const Params& p, const int g_wave64) {
  const float* SA0 = (const float*)(p.ws + WS_SA0); const float* SB0 = (const float*)(p.ws + WS_SB0); const float* SAL = (const float*)(p.ws + WS_SAL);
  bf16_t* G = (bf16_t*)(p.ws + WS_BUP); const float* cw = p.in[15]; const float* cb = p.in[16];
  OPAQUE_TID(tid);
  constexpr int nM = SEQ / 256, nN = DM / 256, nwg = nM * nN;
  int pmprev = -1;
  for (int L = (int)blockIdx.x; L < nwg; L += (int)gridDim.x) {
    int w = L; { const int q = nwg / NXCD, r = nwg % NXCD, x = w % NXCD, o = w / NXCD; w = (x < r ? x * (q + 1) : r * (q + 1) + (x - r) * q) + o; }
    const int nig = WGM * nN, gid = w / nig, fm = gid * WGM, gsz = min(nM - fm, WGM);
    const int pm = fm + ((w % nig) % gsz);
    if (pm == pmprev) continue;
    pmprev = pm;
    for (int el = tid; el < 2 * DFF; el += NT) {
      const int c = el % DFF, r = el / DFF, pr2 = pm * 2 + r;
      const float at = SA0[(size_t)pr2 * DFF + c];
      const float l0 = pm > 0 ? SAL[((size_t)(pm - 1) * 2 + 0) * DFF + c] : 0.f, l1 = pm > 0 ? SAL[((size_t)(pm - 1) * 2 + 1) * DFF + c] : 0.f;
      const float a1 = r ? SA0[(size_t)(pr2 - 1) * DFF + c] : l1, a2 = r ? l1 : l0;
      const float y = cw[c] * a2 + cw[DFF + c] * a1 + cw[2 * DFF + c] * at + cb[c];
      const float e = __builtin_amdgcn_exp2f(-2.302208198f * (y + 0.044715f * y * y * y));
      const float g = y * __builtin_amdgcn_rcpf(1.0f + e) * SB0[(size_t)pr2 * DFF + c];
      G[(size_t)(pm * 256 + r) * DFF + c] = (bf16_t)(pk_bf16(g, 0.f) & 0xffffu);
    }
  }
  asm volatile("s_waitcnt vmcnt(0)" ::: "memory");
  __syncthreads();
}

__device__ __forceinline__ void p8_conv_glu(const Params& p, const int g_wave64) {
  const bf16_t* Aup = (const bf16_t*)(p.ws + WS_AUP); bf16_t* Bup = (bf16_t*)(p.ws + WS_BUP);
  const float* cw = p.in[15]; const float* cb = p.in[16];
  constexpr int NCG = DFF / 8, RUN = 32, NRUN = SEQ / RUN;
  OPAQUE_TID(tid);
  for (int item = blockIdx.x * NT + tid; item < NCG * NRUN; item += gridDim.x * NT) {
    const int cgi = item % NCG, run = item / NCG, c0 = cgi * 8, t0 = run * RUN;
    float w0[8], w1[8], w2[8], bb[8], am2[8], am1[8];
#pragma unroll
    for (int j = 0; j < 8; ++j) { w0[j] = cw[c0 + j]; w1[j] = cw[DFF + c0 + j]; w2[j] = cw[2 * DFF + c0 + j]; bb[j] = cb[c0 + j]; am2[j] = 0.f; am1[j] = 0.f; }
    if (t0 >= 2) {
      const u32x4 v2 = *(const u32x4*)(Aup + (size_t)(t0 - 2) * DFF + c0), v1 = *(const u32x4*)(Aup + (size_t)(t0 - 1) * DFF + c0);
#pragma unroll
      for (int j = 0; j < 4; ++j) { am2[2 * j] = bflo(v2[j]); am2[2 * j + 1] = bfhi(v2[j]); am1[2 * j] = bflo(v1[j]); am1[2 * j + 1] = bfhi(v1[j]); }
    }
    for (int t = t0; t < t0 + RUN; ++t) {
      const u32x4 va = *(const u32x4*)(Aup + (size_t)t * DFF + c0);
      const u32x4 vb = *(const u32x4*)(Bup + (size_t)t * DFF + c0);
      float ac[8], bv[8], y[8];
#pragma unroll
      for (int j = 0; j < 4; ++j) { ac[2 * j] = bflo(va[j]); ac[2 * j + 1] = bfhi(va[j]); bv[2 * j] = bflo(vb[j]); bv[2 * j + 1] = bfhi(vb[j]); }
#pragma unroll
      for (int j = 0; j < 8; ++j) {
        const float a = w0[j] * am2[j] + w1[j] * am1[j] + w2[j] * ac[j] + bb[j];
        const float uu = 0.7978845608028654f * (a + 0.044715f * a * a * a);
        const float th = 1.0f - 2.0f / (1.0f + __expf(2.0f * uu));
        y[j] = 0.5f * a * (1.0f + th) * bv[j];
        am2[j] = am1[j]; am1[j] = ac[j];
      }
      u32x4 w = {pk_bf16(y[0], y[1]), pk_bf16(y[2], y[3]), pk_bf16(y[4], y[5]), pk_bf16(y[6], y[7])};
      *(u32x4*)(Bup + (size_t)t * DFF + c0) = w;
    }
  }
}


#define XB_TMO      128
#define XB_XCNT(j)  (256  + 64 * (j))
#define XB_XSUB(j)  (1280 + 64 * (j))
#define XB_XGEN(j)  (2304 + 64 * (j))
#define XB_TOP      3328
#define XB_TOPGEN   3392
#define XCD_BAR_WORDS 3456
#define XB_SPIN_CAP (1u << 18)
DI unsigned xb_ld(unsigned* p) { return __hip_atomic_load(p, __ATOMIC_RELAXED, __HIP_MEMORY_SCOPE_AGENT); }
DI unsigned xb_add(unsigned* p, unsigned v) { return __hip_atomic_fetch_add(p, v, __ATOMIC_RELAXED, __HIP_MEMORY_SCOPE_AGENT); }
DI unsigned xb_xcc_id() { return (unsigned)__builtin_amdgcn_s_getreg((3 << 11) | 20) & 0xFu; }
#define XB_SPIN(cond, bar) do { unsigned _sp = 0; while (cond) { __builtin_amdgcn_s_sleep(1); \
    if ((++_sp & 255u) == 0u) { if (xb_ld(&(bar)[XB_TMO])) break; if (_sp > XB_SPIN_CAP) { atomicAdd(&(bar)[XB_TMO], 1u); break; } } } } while (0)
DI void xcd_barrier_complete(unsigned* bar, unsigned x, unsigned& nloc, unsigned& nx) {
  const unsigned G = gridDim.x;
  unsigned sum, cnt, mine, sp = 0u;
  for (;;) {
    sum = 0u; cnt = 0u; mine = 0u;
#pragma unroll
    for (unsigned j = 0; j < 16; ++j) { const unsigned c = xb_ld(&bar[XB_XCNT(j)]); sum += c; cnt += (c > 0u) ? 1u : 0u; mine = (j == x) ? c : mine; }
    if (sum == G) break;
    __builtin_amdgcn_s_sleep(1);
    if ((++sp & 255u) == 0u) { if (xb_ld(&bar[XB_TMO])) break; if (sp > XB_SPIN_CAP) { atomicAdd(&bar[XB_TMO], 1u); break; } }
  }
  nloc = mine > 0u ? mine : 1u; nx = cnt > 0u ? cnt : 1u;
}
__device__ __forceinline__ void xcd_barrier(unsigned* bar, volatile LAS unsigned* st) {
  asm volatile("s_waitcnt vmcnt(0)" ::: "memory");
  __syncthreads();
  if (threadIdx.x == 0) {
    const unsigned x = xb_xcc_id();
    __builtin_amdgcn_s_waitcnt(0);
    unsigned nloc = st[0], nx = st[1];
    if (nloc == 0u) { xcd_barrier_complete(bar, x, nloc, nx); st[0] = nloc; st[1] = nx; }
    const unsigned old = xb_add(&bar[XB_XSUB(x)], 1u);
    const unsigned gen = old / nloc;
    if (old + 1u == (gen + 1u) * nloc) {
      __builtin_amdgcn_fence(__ATOMIC_RELEASE, "agent");
      asm volatile("s_waitcnt vmcnt(0)" ::: "memory");
      const unsigned og = xb_add(&bar[XB_TOP], 1u);
      const unsigned tg = og / nx;
      if (og + 1u == (tg + 1u) * nx) xb_add(&bar[XB_TOPGEN], 1u);
      else XB_SPIN(xb_ld(&bar[XB_TOPGEN]) == tg, bar);
      __builtin_amdgcn_fence(__ATOMIC_ACQUIRE, "agent");
      xb_add(&bar[XB_XGEN(x)], 1u);
      asm volatile("s_waitcnt vmcnt(0)" ::: "memory");
    } else {
      XB_SPIN(xb_ld(&bar[XB_XGEN(x)]) == gen, bar);
      __builtin_amdgcn_fence(__ATOMIC_ACQUIRE, "agent");
      asm volatile("s_waitcnt vmcnt(0)" ::: "memory");
    }
  }
  __syncthreads();
}
__global__ void __launch_bounds__(NT, 2) mega(Params p) {
  cg::grid_group grid = cg::this_grid();
  extern __shared__ __attribute__((aligned(16))) unsigned char lds_all[];
  volatile LAS unsigned* xb_st = (volatile LAS unsigned*)((LAS unsigned char*)lds_all + (LDS_BYTES - 16));
  unsigned* xb_bar = (unsigned*)(p.ws + WS_BAR);
  if (threadIdx.x == 0) { xb_st[0] = 0u; xb_st[1] = 0u; (void)xb_add(&xb_bar[XB_XCNT(xb_xcc_id())], 1u); }
  __syncthreads();
  const int g_wave64 = __builtin_amdgcn_readfirstlane((int)threadIdx.x & ~63);
  unsigned char* ws = p.ws;
  bf16_t* H = (bf16_t*)(ws + WS_H);
#ifndef PH
#define PH -1
#endif
#define ON(k) (PH < 0 || PH == (k))
  if (ON(0)) { p0_norm_ga(p, g_wave64); }
  if (ON(1)) { p0_transposes(p, g_wave64); }
  if (p.ws == nullptr) grid.sync();
  xcd_barrier(xb_bar, xb_st);
  if (ON(2)) {
  gemm_phase<false, SEQ, 4096, DM, 4096, 1 << 20>(H, (const bf16_t*)(ws + WS_WIN), ws + WS_PROJ, ws + WS_PROJ, g_wave64);
  gemm_phase<false, 2048, SEQ, DM, SEQ, 1 << 20>((const bf16_t*)(ws + WS_WV), H, ws + WS_VT, ws + WS_VT, g_wave64);
  }
  xcd_barrier(xb_bar, xb_st);
  if (ON(3)) { attn_norms(p, g_wave64); gla_g1(p, g_wave64); }
  xcd_barrier(xb_bar, xb_st);
  if (ON(4)) gla_g2(p, g_wave64);
  xcd_barrier(xb_bar, xb_st);
  if (ON(5)) gla_g3(p, g_wave64);
  if (ON(6)) { attn_phase(p, g_wave64); xcd_barrier(xb_bar, xb_st); attn_combine(p, g_wave64); }
  xcd_barrier(xb_bar, xb_st);
  if (ON(7)) gemm_phase<false, SEQ, DM, DM, DM, 1 << 20>((const bf16_t*)(ws + WS_O), (const bf16_t*)(ws + WS_WO), ws + WS_M, ws + WS_M, g_wave64);
  xcd_barrier(xb_bar, xb_st);
  if (ON(8)) p6_post_attn(p, g_wave64);
  xcd_barrier(xb_bar, xb_st);
  if (ON(2)) gemm_phase<false, SEQ, 2 * DFF, DM, DFF, 1 << 20, 2>(H, (const bf16_t*)(ws + WS_WFI), ws + WS_BUP, ws + WS_BUP, g_wave64,
                                                                ConvEpi{p.in[15], p.in[16], (float*)(ws + WS_SA0), (float*)(ws + WS_SB0), (float*)(ws + WS_SAL)});
  xcd_barrier(xb_bar, xb_st);
  if (ON(9)) p8_fixup(p, g_wave64);
  if (ON(7)) gemm_phase<false, SEQ, DM, DFF, DM, 1 << 20>((const bf16_t*)(ws + WS_BUP), (const bf16_t*)(ws + WS_WFO), ws + WS_F, ws + WS_F, g_wave64);
  xcd_barrier(xb_bar, xb_st);
  if (ON(10)) p10_final(p, g_wave64);
}

extern "C" void kernel_launch(void* const* d_in, const int* in_sizes, int n_in, void* d_out, int out_size, void* d_ws, size_t ws_size,
                              hipStream_t stream) {
  static int grid_blocks = 0;
  if (!grid_blocks) {
    int dev = 0, cus = 0, per_cu = 0;
    hipGetDevice(&dev);
    hipDeviceGetAttribute(&cus, hipDeviceAttributeMultiprocessorCount, dev);
    hipFuncSetAttribute((const void*)mega, hipFuncAttributeMaxDynamicSharedMemorySize, LDS_BYTES);
    hipOccupancyMaxActiveBlocksPerMultiprocessor(&per_cu, (const void*)mega, NT, LDS_BYTES);
    (void)hipGetLastError();
    if (per_cu < 1) per_cu = 1;
    grid_blocks = 256;
    if (cus != 256) fprintf(stderr, "kernel_launch: built for 256 CUs, device reports %d\n", cus);
    if (ws_size < WS_END2) fprintf(stderr, "kernel_launch: workspace too small: %zu < %zu\n", ws_size, (size_t)WS_END);
  }
  Params p{};
  for (int i = 0; i < 19; ++i) p.in[i] = (const float*)d_in[i];
  p.out = (float*)d_out; p.ws = (unsigned char*)d_ws;
  (void)hipMemsetAsync((unsigned char*)d_ws + WS_BAR, 0, 16384 + 128, stream);
  void* args[] = {&p};
  hipError_t e = hipLaunchCooperativeKernel((const void*)mega, dim3(grid_blocks), dim3(NT), args, LDS_BYTES, stream);
  if (e != hipSuccess) fprintf(stderr, "cooperative launch failed: %s (grid %d)\n", hipGetErrorString(e), grid_blocks);
}
```

```cpp
#include <hip/hip_runtime.h>
#include <hip/hip_cooperative_groups.h>
#include <cstdio>
#include <cstdint>
namespace cg = cooperative_groups;

typedef unsigned short bf16_t;
typedef short bf16x8 __attribute__((ext_vector_type(8)));
typedef float f32x2 __attribute__((ext_vector_type(2)));
typedef float f32x4 __attribute__((ext_vector_type(4)));
typedef float f32x16 __attribute__((ext_vector_type(16)));
typedef unsigned u32x2 __attribute__((ext_vector_type(2)));
typedef unsigned u32x4 __attribute__((ext_vector_type(4)));
typedef __bf16 bf2_t __attribute__((ext_vector_type(2)));

#define DI __device__ __forceinline__
#define OPAQUE_TID(t) int t; asm volatile("v_mbcnt_lo_u32_b32 %0, -1, 0\n\tv_mbcnt_hi_u32_b32 %0, -1, %0\n\tv_add_u32 %0, %1, %0" : "=&v"(t) : "s"(g_wave64))
#define LAS __attribute__((address_space(3)))
#define LDSP(p) ((LAS unsigned*)(p))

constexpr int SEQ = 16384, DM = 2048, DFF = 5632, INC = 6160;
#ifndef OVH
#define OVH 6
#endif
#ifndef KR
#define KR 6
#endif
#ifndef VR
#define VR 8
#endif
constexpr int NT = 512;
constexpr int LDS_BYTES = 147456;
constexpr float EPS = 1e-6f;
constexpr float LOG2E = 1.4426950408889634f;

constexpr size_t MB = 1048576;
constexpr size_t WS_BAR = 1 * MB + 768 * 1024, WS_NRM = WS_BAR + 16384, WS_ML = 484 * MB, WS_SA0 = 486 * MB, WS_SB0 = 489 * MB, WS_SAL = 492 * MB, WS_END2 = 495 * MB;
constexpr size_t WS_GA = 0, WS_GDEC = 1 * MB, WS_WFI = 2 * MB, WS_WFO = 46 * MB, WS_H = 68 * MB, WS_R = 132 * MB;
constexpr size_t WS_WIN = WS_R, WS_WV = WS_R + 16 * MB, WS_WO = WS_R + 24 * MB, WS_PROJ = WS_R + 32 * MB, WS_VT = WS_R + 160 * MB,
                 WS_O = WS_R + 224 * MB, WS_PART2 = WS_R + 288 * MB, WS_M = WS_PROJ, WS_AUP = WS_R, WS_BUP = WS_R + 176 * MB, WS_F = WS_R + 96 * MB, WS_END = WS_R + 352 * MB;

struct Params { const float* in[19]; float* out; unsigned char* ws; };

DI unsigned pk_bf16(float lo, float hi) { f32x2 v = {lo, hi}; bf2_t r = __builtin_convertvector(v, bf2_t); return __builtin_bit_cast(unsigned, r); }
DI float bf2f(bf16_t u) { return __uint_as_float(((unsigned)u) << 16); }
DI float bflo(unsigned u) { return __uint_as_float(u << 16); }
DI float bfhi(unsigned u) { return __uint_as_float(u & 0xffff0000u); }
DI f32x16 mfma32(bf16x8 a, bf16x8 b, f32x16 c) { return __builtin_amdgcn_mfma_f32_32x32x16_bf16(a, b, c, 0, 0, 0); }
DI float shx(float v, const int mask, const int lane) { return __builtin_bit_cast(float, __builtin_amdgcn_ds_bpermute((lane ^ mask) << 2, __builtin_bit_cast(int, v))); }
DI float wave_sum_l(float v, const int lane) { for (int o = 32; o > 0; o >>= 1) v += __builtin_bit_cast(float, __builtin_amdgcn_ds_bpermute((lane ^ o) << 2, __builtin_bit_cast(int, v))); return v; }
DI float wave_sum(float v) { for (int o = 32; o > 0; o >>= 1) v += __shfl_xor(v, o); return v; }
DI bf16x8 pack8(float a0, float a1, float a2, float a3, float a4, float a5, float a6, float a7) {
  u32x4 p = {pk_bf16(a0, a1), pk_bf16(a2, a3), pk_bf16(a4, a5), pk_bf16(a6, a7)}; return __builtin_bit_cast(bf16x8, p);
}
DI int perm32(int rho) { const int n = rho >> 4, i = rho & 15; return 8 * (i >> 2) + 4 * n + (i & 3); }
DI float* part_slot(const Params& p, const int slot) { return slot < 256 ? p.out + (size_t)slot * 65536 : (float*)(p.ws + WS_PART2) + (size_t)(slot - 256) * 65536; }
DI int perm23(int r) { return (r & ~12) | ((r & 4) << 1) | ((r & 8) >> 1); }

constexpr int BM = 256, BK = 64, HALF = 128, HT = HALF * BK, NXCD = 8, WGM = 8;
DI int lds_byte(int r, int c) { int st = (r >> 4) * 2 + (c >> 5), rr = r & 15, cc = c & 31, ob = rr * 64 + cc * 2; return st * 1024 + (ob ^ (((ob >> 9) & 1) << 5)); }
DI void stage_rc(int b, int& R, int& C) { int st = b / 1024, sb = b % 1024, swz = sb ^ (((sb >> 9) & 1) << 5); R = (st >> 1) * 16 + swz / 64; C = (st & 1) * 32 + (swz % 64) / 2; }

struct ConvEpi { const float* cw; const float* cb; float* sa0; float* sb0; float* sal; };
template <bool OUT_F32, int M, int N, int K, int ldc, int split_pn, int EPI = 0>
__device__ __forceinline__ void gemm_phase(const bf16_t* __restrict__ A, const bf16_t* __restrict__ Bt, void* out0, void* out1, const int g_wave64, const ConvEpi ce = ConvEpi{}) {
  OPAQUE_TID(tidx);
  extern __shared__ __attribute__((aligned(16))) unsigned char shm_raw[];
  LAS unsigned char* ldsb = (LAS unsigned char*)shm_raw;
#define SA(b, h) (((b) * 2 + (h)) * (HT * 2))
#define SB(b, h) ((4 + (b) * 2 + (h)) * (HT * 2))
#define STAGE(P, BASE, br, kt) do { const char* _gb = (const char*)(BASE) + ((size_t)(br) * K + (size_t)(kt) * BK) * 2; \
      __builtin_amdgcn_global_load_lds((const unsigned*)(_gb + so0), (LAS unsigned*)(ldsb + (P) + ldsw), 16, 0, 0); \
      __builtin_amdgcn_global_load_lds((const unsigned*)(_gb + so1), (LAS unsigned*)(ldsb + (P) + ldsw + 8192), 16, 0, 0); } while (0)
#define STAGEB(P, BASE, br, kt) do { const char* _gb = (const char*)(BASE) + ((size_t)(br) * K + (size_t)(kt) * BK) * 2; \
      __builtin_amdgcn_global_load_lds((const unsigned*)(_gb + sb0), (LAS unsigned*)(ldsb + (P) + ldsw), 16, 0, 0); \
      __builtin_amdgcn_global_load_lds((const unsigned*)(_gb + sb1), (LAS unsigned*)(ldsb + (P) + ldsw + 8192), 16, 0, 0); } while (0)
#define LDA(dst, b, h) _Pragma("unroll") for (int m = 0; m < 4; ++m) _Pragma("unroll") for (int k = 0; k < 2; ++k) \
    dst[m][k] = *(const LAS bf16x8*)(ldsb + SA(b, h) + aoff + m * 2048 + k * 1024)
#define LDB(dst, b, h) _Pragma("unroll") for (int n = 0; n < 2; ++n) _Pragma("unroll") for (int k = 0; k < 2; ++k) \
    dst[n][k] = *(const LAS bf16x8*)(ldsb + SB(b, h) + boff + n * 2048 + k * 1024)
#define MMA(ai, bj, At, Bq) do { __builtin_amdgcn_s_setprio(1); \
    _Pragma("unroll") for (int m = 0; m < 4; ++m) _Pragma("unroll") for (int n = 0; n < 2; ++n) _Pragma("unroll") for (int k = 0; k < 2; ++k) \
      acc[ai][bj][m][n] = __builtin_amdgcn_mfma_f32_16x16x32_bf16(Bq[n][k], At[m][k], acc[ai][bj][m][n], 0, 0, 0); \
    __builtin_amdgcn_s_setprio(0); } while (0)
#define WAIT_V(n) asm volatile("s_waitcnt vmcnt(" #n ")" ::: "memory")
#define WAIT_L(n) asm volatile("s_waitcnt lgkmcnt(" #n ")" ::: "memory")
#define BAR __builtin_amdgcn_s_barrier()
#define SCHED __builtin_amdgcn_sched_barrier(0)
  const int nM = M / BM, nN = N / BM, nwg = nM * nN;
  const int wid = __builtin_amdgcn_readfirstlane(tidx >> 6), lane = tidx & 63, wr = wid >> 2, wc = wid & 3, fr = lane & 15, fq = lane >> 4;
  constexpr int nt = K / BK;
  unsigned so0, so1, sb0, sb1;
  { int _r, _c; stage_rc(tidx * 16, _r, _c); so0 = (unsigned)(_r * K + _c) * 2u; sb0 = (unsigned)(((_r & ~31) + perm32(_r & 31)) * K + _c) * 2u;
    stage_rc(tidx * 16 + 8192, _r, _c); so1 = (unsigned)(_r * K + _c) * 2u; sb1 = (unsigned)(((_r & ~31) + perm32(_r & 31)) * K + _c) * 2u; }
  const unsigned ldsw = (unsigned)wid * 1024u;
  const int aoff = lds_byte(wr * 64 + fr, fq * 8), boff = lds_byte(wc * 32 + fr, fq * 8);
#define UNIT_OF(L, PM, PN) do { int _w = (L); { const int _q = nwg / NXCD, _r = nwg % NXCD, _x = _w % NXCD, _o = _w / NXCD; _w = (_x < _r ? _x * (_q + 1) : _r * (_q + 1) + (_x - _r) * _q) + _o; } \
    const int _nig = WGM * nN, _gid = _w / _nig, _fm = _gid * WGM, _gsz = min(nM - _fm, WGM); PM = _fm + ((_w % _nig) % _gsz); PN = (_w % _nig) / _gsz; } while (0)
  if ((int)blockIdx.x < nwg) {
    int pm, pn; UNIT_OF((int)blockIdx.x, pm, pn);
    int brow = pm * BM, bcol = pn * BM;
    __syncthreads();
    f32x4 acc[2][2][4][2] = {};
    bf16x8 At[4][2], B0[2][2], B1[2][2];
    STAGEB(SB(0, 0), Bt, bcol, 0); STAGEB(SB(0, 1), Bt, bcol + HALF, 0); STAGE(SA(0, 0), A, brow, 0); STAGE(SA(0, 1), A, brow + HALF, 0);
    if (wr == 1) BAR;
    WAIT_V(2); BAR;
    STAGEB(SB(1, 0), Bt, bcol, 1); STAGE(SA(1, 0), A, brow, 1); STAGEB(SB(1, 1), Bt, bcol + HALF, 1);
    WAIT_V(6); BAR;
    for (int it = 0;; ++it) {
      const int Ln = (it + 1) * (int)gridDim.x + (int)blockIdx.x;
      const bool has_next = Ln < nwg;
      int npm = pm, npn = pn; if (has_next) UNIT_OF(Ln, npm, npn);
      const int nbrow = npm * BM, nbcol = npn * BM;
      for (int t = 0; t < nt; t += 2) {
        const bool last = (t == nt - 2);
        const int r2 = last ? nbrow : brow, c2 = last ? nbcol : bcol, k2 = last ? 0 : t + 2, k3 = k2 + 1;
        LDB(B0, 0, 0); LDB(B1, 0, 1); SCHED; LDA(At, 0, 0); STAGE(SA(1, 1), A, brow + HALF, t + 1);
        WAIT_V(8); WAIT_L(0); BAR; MMA(0, 0, At, B0); MMA(0, 1, At, B1); BAR; SCHED;
        LDA(At, 0, 1); STAGEB(SB(0, 0), Bt, c2, k2); STAGEB(SB(0, 1), Bt, c2 + HALF, k2); STAGE(SA(0, 0), A, r2, k2);
        WAIT_V(8); WAIT_L(0); BAR; MMA(1, 0, At, B0); MMA(1, 1, At, B1); BAR; SCHED;
        LDB(B0, 1, 0); LDB(B1, 1, 1); SCHED; LDA(At, 1, 0); STAGE(SA(0, 1), A, r2 + HALF, k2);
        WAIT_V(8); WAIT_L(0); BAR; MMA(0, 0, At, B0); MMA(0, 1, At, B1); BAR; SCHED;
        LDA(At, 1, 1); STAGEB(SB(1, 0), Bt, c2, k3); STAGEB(SB(1, 1), Bt, c2 + HALF, k3); STAGE(SA(1, 0), A, r2, k3);
        WAIT_V(8); WAIT_L(0); BAR; MMA(1, 0, At, B0); MMA(1, 1, At, B1); BAR; SCHED;
      }
      if (wr == 0) BAR;
      if constexpr (EPI == 2) {
        LAS float* halo = (LAS float*)(ldsb + 133120);
        const int cl = wc * 32 + fq * 8;
        float w0[8], w1[8], w2[8], cbv[8];
        {
          const float* wp = ce.cw + 128 * pn + cl; const float* bp = ce.cb + 128 * pn + cl;
#pragma unroll
          for (int x4 = 0; x4 < 2; ++x4) { const f32x4 a0 = *(const f32x4*)(wp + 4 * x4), a1 = *(const f32x4*)(wp + DFF + 4 * x4), a2 = *(const f32x4*)(wp + 2 * DFF + 4 * x4), a3 = *(const f32x4*)(bp + 4 * x4);
#pragma unroll
            for (int j = 0; j < 4; ++j) { w0[x4 * 4 + j] = a0[j]; w1[x4 * 4 + j] = a1[j]; w2[x4 * 4 + j] = a2[j]; cbv[x4 * 4 + j] = a3[j]; } }
        }
        if (fr >= 14) {
#pragma unroll
          for (int ai = 0; ai < 2; ++ai) { LAS float* hp = halo + ((ai * 2 + wr) * 2 + (fr - 14)) * 128 + cl; *(LAS f32x4*)hp = acc[ai][0][3][0]; *(LAS f32x4*)(hp + 4) = acc[ai][0][3][1]; }
          if (wr == 1) { float* sp = ce.sal + ((size_t)pm * 2 + (fr - 14)) * DFF + 128 * pn + cl; *(f32x4*)sp = acc[1][0][3][0]; *(f32x4*)(sp + 4) = acc[1][0][3][1]; }
        }
        if (wr == 0 && fr < 2) {
          float* sp = ce.sa0 + ((size_t)pm * 2 + fr) * DFF + 128 * pn + cl; *(f32x4*)sp = acc[0][0][0][0]; *(f32x4*)(sp + 4) = acc[0][0][0][1];
          float* sq = ce.sb0 + ((size_t)pm * 2 + fr) * DFF + 128 * pn + cl; *(f32x4*)sq = acc[0][1][0][0]; *(f32x4*)(sq + 4) = acc[0][1][0][1];
        }
        WAIT_L(0); BAR;
        bf16_t* gp = (bf16_t*)out0 + (size_t)(brow + wr * 64 + fr) * DFF + 128 * pn + cl;
#pragma unroll
        for (int ai = 0; ai < 2; ++ai) {
          const int blk = ai * 2 + wr;
          float h62[8], h63[8];
          if (blk > 0) {
            const LAS float* hq = halo + ((blk - 1) * 2) * 128 + cl;
            const f32x4 q0 = *(const LAS f32x4*)hq, q1 = *(const LAS f32x4*)(hq + 4), q2 = *(const LAS f32x4*)(hq + 128), q3 = *(const LAS f32x4*)(hq + 132);
#pragma unroll
            for (int j = 0; j < 4; ++j) { h62[j] = q0[j]; h62[4 + j] = q1[j]; h63[j] = q2[j]; h63[4 + j] = q3[j]; }
          } else {
#pragma unroll
            for (int j = 0; j < 8; ++j) { h62[j] = 0.f; h63[j] = 0.f; }
          }
#pragma unroll
          for (int m = 0; m < 4; ++m) {
            float gv[8];
#pragma unroll
            for (int x = 0; x < 8; ++x) {
              const float cur = acc[ai][0][m][x >> 2][x & 3], bb = acc[ai][1][m][x >> 2][x & 3];
              int o1, o2;
              if (m == 0) { o1 = __float_as_int(h63[x]); o2 = __float_as_int(fr == 0 ? h62[x] : h63[x]); }
              else { const int pv = __float_as_int(acc[ai][0][m - 1][x >> 2][x & 3]);
                     o1 = __builtin_amdgcn_update_dpp(pv, pv, 0x121, 0xf, 0xf, false); o2 = __builtin_amdgcn_update_dpp(pv, pv, 0x122, 0xf, 0xf, false); }
              const float a1 = __int_as_float(__builtin_amdgcn_update_dpp(o1, __float_as_int(cur), 0x111, 0xf, 0xf, false));
              const float a2 = __int_as_float(__builtin_amdgcn_update_dpp(o2, __float_as_int(cur), 0x112, 0xf, 0xf, false));
              const float y = w0[x] * a2 + w1[x] * a1 + w2[x] * cur + cbv[x];
              const float e = __builtin_amdgcn_exp2f(-2.302208198f * (y + 0.044715f * y * y * y));
              gv[x] = y * __builtin_amdgcn_rcpf(1.0f + e) * bb;
            }
            if (!(blk == 0 && m == 0 && fr < 2)) {
              u32x4 w = {pk_bf16(gv[0], gv[1]), pk_bf16(gv[2], gv[3]), pk_bf16(gv[4], gv[5]), pk_bf16(gv[6], gv[7])};
              *(u32x4*)(gp + (size_t)(ai * HALF + m * 16) * DFF) = w;
            }
          }
        }
#pragma unroll
        for (int ai = 0; ai < 2; ++ai)
#pragma unroll
          for (int bj = 0; bj < 2; ++bj)
#pragma unroll
            for (int m = 0; m < 4; ++m) { acc[ai][bj][m][0] = (f32x4){0.f, 0.f, 0.f, 0.f}; acc[ai][bj][m][1] = (f32x4){0.f, 0.f, 0.f, 0.f}; }
      } else {
      constexpr int ES = OUT_F32 ? 4 : 2;
      char* rp = (char*)((pn < split_pn) ? out0 : out1) +
                 ((size_t)(brow + wr * 64 + fr) * ldc + (size_t)(((pn < split_pn) ? bcol : bcol - split_pn * BM) + wc * 32 + fq * 8)) * ES;
#pragma unroll
      for (int ai = 0; ai < 2; ++ai) {
#pragma unroll
        for (int m = 0; m < 4; ++m) {
#pragma unroll
          for (int bj = 0; bj < 2; ++bj) {
            const f32x4 v0 = acc[ai][bj][m][0], v1 = acc[ai][bj][m][1];
            if (OUT_F32) { *(f32x4*)(rp + (bj * HALF) * ES) = v0; *(f32x4*)(rp + (bj * HALF + 4) * ES) = v1; }
            else { u32x4 w = {pk_bf16(v0[0], v0[1]), pk_bf16(v0[2], v0[3]), pk_bf16(v1[0], v1[1]), pk_bf16(v1[2], v1[3])}; *(u32x4*)(rp + (bj * HALF) * ES) = w; }
            acc[ai][bj][m][0] = (f32x4){0.f, 0.f, 0.f, 0.f}; acc[ai][bj][m][1] = (f32x4){0.f, 0.f, 0.f, 0.f};
          }
          rp += (size_t)16 * ldc * ES;
          asm volatile("" : "+v"(rp));
        }
        rp += (size_t)(HALF - 64) * ldc * ES;
      }
      }
      if (!has_next) break;
      pm = npm; pn = npn; brow = nbrow; bcol = nbcol;
      if (wr == 1) BAR;
    }
    WAIT_V(0);
    BAR;
  }
#undef UNIT_OF
  __syncthreads();
#undef SA
#undef SB
#undef STAGE
#undef STAGEB
#undef LDA
#undef LDB
#undef MMA
}

__device__ __forceinline__ void p0_norm_ga(const Params& p, const int g_wave64) {
  extern __shared__ __attribute__((aligned(16))) float ldsf[];
  const float* x = p.in[0]; const float* g = p.in[1]; const float* w_in = p.in[2];
  bf16_t* H = (bf16_t*)(p.ws + WS_H); float* GA = (float*)(p.ws + WS_GA);
  OPAQUE_TID(tid); const int lane = tid & 63, wave = tid >> 6;
  {
    float wtmp[64];
#pragma unroll
    for (int i = 0; i < 64; ++i) { const int idx = tid + NT * i; wtmp[i] = w_in[(size_t)(idx >> 4) * INC + 3072 + (idx & 15)]; }
#pragma unroll
    for (int i = 0; i < 64; ++i) { const int idx = tid + NT * i; ldsf[(idx & 15) * 2052 + (idx >> 4)] = wtmp[i]; }
  }
  __syncthreads();
  for (int rb = blockIdx.x; rb < SEQ / 64; rb += gridDim.x) {
    for (int rp = 0; rp < 4; ++rp) {
      const int row0 = rb * 64 + wave * 8 + rp * 2;
      f32x4 xv[2][8];
#pragma unroll
      for (int q = 0; q < 2; ++q)
#pragma unroll
        for (int ii = 0; ii < 8; ++ii) xv[q][ii] = *(const f32x4*)(x + (size_t)(row0 + q) * DM + ii * 256 + lane * 4);
      float rs[2];
#pragma unroll
      for (int q = 0; q < 2; ++q) {
        float s = 0.f;
#pragma unroll
        for (int ii = 0; ii < 8; ++ii) s += xv[q][ii][0] * xv[q][ii][0] + xv[q][ii][1] * xv[q][ii][1] + xv[q][ii][2] * xv[q][ii][2] + xv[q][ii][3] * xv[q][ii][3];
        s = wave_sum_l(s, lane); rs[q] = rsqrtf(s * (1.0f / DM) + EPS);
      }
#pragma unroll
      for (int ii = 0; ii < 8; ++ii) {
        const f32x4 gv = *(const f32x4*)(g + ii * 256 + lane * 4);
#pragma unroll
        for (int q = 0; q < 2; ++q) {
          xv[q][ii] = xv[q][ii] * rs[q] * gv;
          u32x2 w = {pk_bf16(xv[q][ii][0], xv[q][ii][1]), pk_bf16(xv[q][ii][2], xv[q][ii][3])};
          *(u32x2*)(H + (size_t)(row0 + q) * DM + ii * 256 + lane * 4) = w;
        }
      }
      float a0[16], a1[16];
#pragma unroll
      for (int j = 0; j < 16; ++j) {
        float s0 = 0.f, s1 = 0.f;
#pragma unroll
        for (int ii = 0; ii < 8; ++ii) {
          const f32x4 wv = *(const f32x4*)(ldsf + j * 2052 + ii * 256 + lane * 4);
          s0 += xv[0][ii][0] * wv[0] + xv[0][ii][1] * wv[1] + xv[0][ii][2] * wv[2] + xv[0][ii][3] * wv[3];
          s1 += xv[1][ii][0] * wv[0] + xv[1][ii][1] * wv[1] + xv[1][ii][2] * wv[2] + xv[1][ii][3] * wv[3];
        }
        a0[j] = s0; a1[j] = s1;
        asm volatile("" : "+v"(a0[j]), "+v"(a1[j]) :: "memory");
      }
#define BFLY(N, MASK) _Pragma("unroll") for (int i = 0; i < (N) / 2; ++i) { const bool up = (lane & (MASK)) != 0; \
        const float sd0 = up ? a0[i] : a0[i + (N) / 2], kp0 = up ? a0[i + (N) / 2] : a0[i]; a0[i] = kp0 + shx(sd0, (MASK), lane); \
        const float sd1 = up ? a1[i] : a1[i + (N) / 2], kp1 = up ? a1[i + (N) / 2] : a1[i]; a1[i] = kp1 + shx(sd1, (MASK), lane); }
      BFLY(16, 32) BFLY(8, 16) BFLY(4, 8) BFLY(2, 4)
#undef BFLY
      float g0 = a0[0], g1 = a1[0];
      g0 += shx(g0, 2, lane); g1 += shx(g1, 2, lane);
      g0 += shx(g0, 1, lane); g1 += shx(g1, 1, lane);
      if ((lane & 3) == 0) { const int j = ((lane >> 5) & 1) * 8 + ((lane >> 4) & 1) * 4 + ((lane >> 3) & 1) * 2 + ((lane >> 2) & 1); GA[(size_t)row0 * 16 + j] = g0; GA[(size_t)(row0 + 1) * 16 + j] = g1; }
    }
  }
  __syncthreads();
}

struct TSeg { const float* src; int ld, col0, ncols, K; bf16_t* dst; };
__device__ __forceinline__ void p0_transposes(const Params& p, const int g_wave64) {
  extern __shared__ __attribute__((aligned(16))) float ldsf[];
  OPAQUE_TID(tid);
  const int ntile[8] = {32 * 16, 32 * 16, 32 * 32, 32 * 16, 32 * 16, 32 * 32, 32 * 176, 88 * 32};
  int total = 0;
  for (int i = 0; i < 8; ++i) total += ntile[i];
  const int lane = tid & 63, wave = __builtin_amdgcn_readfirstlane(tid >> 6);
  for (int tix = blockIdx.x * 8 + wave; tix < total; tix += gridDim.x * 8) {
    int s = 0, rem = tix;
    while (rem >= ntile[s]) { rem -= ntile[s]; ++s; }
    const float* src; int ld, col0, nct, K; bf16_t* dst;
    bf16_t* WinT = (bf16_t*)(p.ws + WS_WIN); bf16_t* WvT = (bf16_t*)(p.ws + WS_WV);
    switch (s) {
      case 0: src = p.in[2]; ld = INC; col0 = 0; nct = 16; K = 2048; dst = WinT; break;
      case 1: src = p.in[2]; ld = INC; col0 = 2048; nct = 16; K = 2048; dst = WinT + (size_t)1024 * 2048; break;
      case 2: src = p.in[2]; ld = INC; col0 = 3088; nct = 32; K = 2048; dst = WinT + (size_t)2048 * 2048; break;
      case 3: src = p.in[2]; ld = INC; col0 = 1024; nct = 16; K = 2048; dst = WvT; break;
      case 4: src = p.in[2]; ld = INC; col0 = 5136; nct = 16; K = 2048; dst = WvT + (size_t)1024 * 2048; break;
      case 5: src = p.in[11]; ld = 2048; col0 = 0; nct = 32; K = 2048; dst = (bf16_t*)(p.ws + WS_WO); break;
      case 6: src = p.in[14]; ld = 2 * DFF; col0 = 0; nct = 176; K = 2048; dst = (bf16_t*)(p.ws + WS_WFI); break;
      default: src = p.in[17]; ld = 2048; col0 = 0; nct = 32; K = DFF; dst = (bf16_t*)(p.ws + WS_WFO); break;
    }
    const int kt = rem / nct, ct = rem % nct;
    float* t = ldsf + wave * (64 * 65);
    f32x4 v[16];
#pragma unroll
    for (int i = 0; i < 16; ++i) v[i] = *(const f32x4*)(src + (size_t)(kt * 64 + i * 4 + (lane >> 4)) * ld + col0 + ct * 64 + (lane & 15) * 4);
#pragma unroll
    for (int i = 0; i < 16; ++i) { float* tp = t + (i * 4 + (lane >> 4)) * 65 + (lane & 15) * 4; tp[0] = v[i][0]; tp[1] = v[i][1]; tp[2] = v[i][2]; tp[3] = v[i][3]; }
    asm volatile("s_waitcnt lgkmcnt(0)" ::: "memory");
#pragma unroll
    for (int i = 0; i < 8; ++i) {
      const int nl = (lane >> 3) + 8 * i, kl = (lane & 7) * 8;
      const float* tp = t + kl * 65 + nl;
      u32x4 w = {pk_bf16(tp[0], tp[65]), pk_bf16(tp[130], tp[195]), pk_bf16(tp[260], tp[325]), pk_bf16(tp[390], tp[455])};
      int drow0 = ct * 64;
      if (s == 6) drow0 = (ct < 88) ? 256 * (ct >> 1) + 64 * (ct & 1) : 256 * ((ct - 88) >> 1) + 128 + 64 * ((ct - 88) & 1);
      *(u32x4*)(dst + (size_t)(drow0 + nl) * K + kt * 64 + kl) = w;
    }
    asm volatile("s_waitcnt lgkmcnt(0)" ::: "memory");
  }
  __syncthreads();
}

DI void gla_cumsum(const Params& p, float* Bs, float* tot, float* gas, int head, int chunk, int tid_in) {
  const float* GA = (const float*)(p.ws + WS_GA); const float* wup = p.in[3]; const float* ba = p.in[4];
  const int tid = tid_in, d = tid & 127, tg = tid >> 7;
  float w[16];
#pragma unroll
  for (int r = 0; r < 16; ++r) w[r] = wup[r * 512 + head * 128 + d];
  const float bias = ba[head * 128 + d];
  if (tid < 256) { const f32x4 gv = *(const f32x4*)(GA + (size_t)(chunk * 64 + (tid >> 2)) * 16 + (tid & 3) * 4); *(f32x4*)(gas + (tid >> 2) * 16 + (tid & 3) * 4) = gv; }
  __syncthreads();
  float run = 0.f;
#pragma unroll 4
  for (int tt = 0; tt < 16; ++tt) {
    const f32x4* gp = (const f32x4*)(gas + (tg * 16 + tt) * 16);
    const f32x4 g0 = gp[0], g1 = gp[1], g2 = gp[2], g3 = gp[3];
    float xx = bias;
    xx += g0[0] * w[0] + g0[1] * w[1] + g0[2] * w[2] + g0[3] * w[3];
    xx += g1[0] * w[4] + g1[1] * w[5] + g1[2] * w[6] + g1[3] * w[7];
    xx += g2[0] * w[8] + g2[1] * w[9] + g2[2] * w[10] + g2[3] * w[11];
    xx += g3[0] * w[12] + g3[1] * w[13] + g3[2] * w[14] + g3[3] * w[15];
    const float ls = -(fmaxf(-xx, 0.f) + __logf(1.0f + __expf(-fabsf(xx))));
    run += ls * (1.0f / 16.0f);
    Bs[(tg * 16 + tt) * 129 + d] = run;
  }
  tot[tg * 128 + d] = run;
  __syncthreads();
  float pre = 0.f;
  for (int gq = 0; gq < tg; ++gq) pre += tot[gq * 128 + d];
  for (int tt = 0; tt < 16; ++tt) Bs[(tg * 16 + tt) * 129 + d] += pre;
  __syncthreads();
}

constexpr int GL_QB = 0, GL_KB = 17408, GL_VT = 34816, GL_B = 71680, GL_TOT = GL_B + 33024, GL_ST = 71680, GL_RED = 141312, GL_GA = 142336;

DI void gla_load_vt(const Params& p, unsigned char* lds, int head, int chunk, int tid) {
  const bf16_t* VT = (const bf16_t*)(p.ws + WS_VT);
#pragma unroll
  for (int i = 0; i < 4; ++i) {
    const int id = tid + NT * i, row = id >> 3, c = id & 7;
    const u32x4 v = *(const u32x4*)(VT + (size_t)(head * 256 + row) * SEQ + chunk * 64 + c * 8);
    *(u32x4*)(lds + GL_VT + row * 144 + c * 16) = v;
  }
}

__device__ __forceinline__ void gla_g1(const Params& p, const int g_wave64) {
  extern __shared__ __attribute__((aligned(16))) unsigned char lds[];
  const bf16_t* PROJ = (const bf16_t*)(p.ws + WS_PROJ);
  float* UT = p.out; float* GDEC = (float*)(p.ws + WS_GDEC);
  OPAQUE_TID(tid); const int lane = tid & 63, wave = tid >> 6, r = lane & 31, h = lane >> 5;
  float* Bs = (float*)(lds + GL_B); float* tot = (float*)(lds + GL_TOT);
  for (int u = blockIdx.x; u < 1024; u += gridDim.x) {
    const int head = u >> 8, chunk = u & 255;
    __syncthreads();
    bf16_t kraw[16];
    {
      const int d = tid & 127, tg = tid >> 7;
#pragma unroll
      for (int tt = 0; tt < 16; ++tt) kraw[tt] = PROJ[(size_t)(chunk * 64 + tg * 16 + tt) * 4096 + 512 + head * 128 + d];
    }
    gla_load_vt(p, lds, head, chunk, tid);
    gla_cumsum(p, Bs, tot, (float*)(lds + GL_GA), head, chunk, tid);
    {
      const int d = tid & 127, tg = tid >> 7;
      const float bl = Bs[63 * 129 + d];
      float kv[16];
#pragma unroll
      for (int tt = 0; tt < 16; ++tt) {
        const int tl = tg * 16 + tt;
        const float kk = bf2f(kraw[tt]);
        kv[tt] = kk * __expf(bl - Bs[tl * 129 + d]);
      }
      u32x4 w0 = {pk_bf16(kv[0], kv[1]), pk_bf16(kv[2], kv[3]), pk_bf16(kv[4], kv[5]), pk_bf16(kv[6], kv[7])};
      u32x4 w1 = {pk_bf16(kv[8], kv[9]), pk_bf16(kv[10], kv[11]), pk_bf16(kv[12], kv[13]), pk_bf16(kv[14], kv[15])};
      *(u32x4*)(lds + GL_QB + d * 144 + tg * 32) = w0;
      *(u32x4*)(lds + GL_QB + d * 144 + tg * 32 + 16) = w1;
      if (tid < 128) GDEC[(size_t)u * 128 + d] = __expf(bl);
    }
    __syncthreads();
    f32x16 acc[4];
#pragma unroll
    for (int nb = 0; nb < 4; ++nb)
#pragma unroll
      for (int i = 0; i < 16; ++i) acc[nb][i] = 0.f;
#pragma unroll
    for (int s = 0; s < 4; ++s) {
      const bf16x8 a = *(const bf16x8*)(lds + GL_VT + (wave * 32 + r) * 144 + (16 * s + 8 * h) * 2);
#pragma unroll
      for (int nb = 0; nb < 4; ++nb) {
        const bf16x8 b = *(const bf16x8*)(lds + GL_QB + (nb * 32 + r) * 144 + (16 * s + 8 * h) * 2);
        acc[nb] = mfma32(a, b, acc[nb]);
      }
    }
    bf16_t* up = (bf16_t*)UT + (size_t)u * 32768;
#pragma unroll
    for (int nb = 0; nb < 4; ++nb)
#pragma unroll
      for (int gi = 0; gi < 16; ++gi) {
        const int e = wave * 32 + (gi & 3) + 8 * (gi >> 2) + 4 * h;
        up[e * 128 + nb * 32 + r] = (bf16_t)(pk_bf16(acc[nb][gi], 0.f) & 0xffffu);
      }
  }
  __syncthreads();
}

__device__ __forceinline__ void gla_g2(const Params& p, const int g_wave64) {
  const bf16_t* UB = (const bf16_t*)p.out; bf16_t* SB = (bf16_t*)p.out + (size_t)1024 * 32768; const float* GDEC = (const float*)(p.ws + WS_GDEC);
  OPAQUE_TID(tid);
  for (int el = blockIdx.x * NT + tid; el < 4 * 32768; el += gridDim.x * NT) {
    const int head = el >> 15, ed = el & 32767, d = ed & 127;
    const bf16_t* up = UB + (size_t)head * 256 * 32768 + ed;
    bf16_t* sp = SB + (size_t)head * 256 * 32768 + ed;
    const float* gp = GDEC + (size_t)head * 256 * 128 + d;
    float st = 0.f;
    for (int c0 = 0; c0 < 256; c0 += 32) {
      float uu[32], gg[32];
#pragma unroll
      for (int i = 0; i < 32; ++i) { uu[i] = bf2f(up[(size_t)(c0 + i) * 32768]); gg[i] = gp[(c0 + i) * 128]; }
#pragma unroll
      for (int i = 0; i < 32; ++i) { sp[(size_t)(c0 + i) * 32768] = (bf16_t)(pk_bf16(st, 0.f) & 0xffffu); st = gg[i] * st + uu[i]; }
    }
  }
}

__device__ __forceinline__ void gla_g3(const Params& p, const int g_wave64) {
  extern __shared__ __attribute__((aligned(16))) unsigned char lds[];
  const bf16_t* PROJ = (const bf16_t*)(p.ws + WS_PROJ);
  const float* ST = p.out; bf16_t* O = (bf16_t*)(p.ws + WS_O); const float* gnorm = p.in[5];
  OPAQUE_TID(tid); const int lane = tid & 63, wave = tid >> 6, r = lane & 31, h = lane >> 5;
  const int ib = wave & 1, eq = wave >> 1;
  float* Bs = (float*)(lds + GL_B); float* tot = (float*)(lds + GL_TOT); float* red = (float*)(lds + GL_RED);
  for (int u = blockIdx.x; u < 1024; u += gridDim.x) {
    const int head = u >> 8, chunk = u & 255;
    __syncthreads();
    u32x4 stv[8];
    {
      const bf16_t* sp = (const bf16_t*)ST + (size_t)1024 * 32768 + (size_t)u * 32768;
#pragma unroll
      for (int i = 0; i < 8; ++i) { const int id = tid + NT * i, e = id >> 4, c8 = id & 15; stv[i] = *(const u32x4*)(sp + e * 128 + c8 * 8); }
    }
    bf16_t qraw[16], kraw[16];
    {
      const int d = tid & 127, tg = tid >> 7;
#pragma unroll
      for (int tt = 0; tt < 16; ++tt) { const size_t ro = (size_t)(chunk * 64 + tg * 16 + tt) * 4096 + head * 128 + d; qraw[tt] = PROJ[ro]; kraw[tt] = PROJ[ro + 512]; }
    }
    gla_load_vt(p, lds, head, chunk, tid);
    gla_cumsum(p, Bs, tot, (float*)(lds + GL_GA), head, chunk, tid);
    {
      const int d = tid & 127, tg = tid >> 7;
#pragma unroll
      for (int tt = 0; tt < 16; ++tt) {
        const int tl = tg * 16 + tt;
        const float bb = Bs[tl * 129 + d];
        const float qq = bf2f(qraw[tt]) * 0.08838834764831845f * __expf(bb);
        const float kk = bf2f(kraw[tt]) * __expf(-bb);
        *(bf16_t*)(lds + GL_QB + tl * 272 + d * 2) = (bf16_t)(pk_bf16(qq, 0.f) & 0xffff);
        *(bf16_t*)(lds + GL_KB + tl * 272 + d * 2) = (bf16_t)(pk_bf16(kk, 0.f) & 0xffff);
      }
    }
    __syncthreads();
    {
#pragma unroll
      for (int i = 0; i < 8; ++i) { const int id = tid + NT * i, e = id >> 4, c8 = id & 15; *(u32x4*)(lds + GL_ST + e * 272 + c8 * 16) = stv[i]; }
    }
    __syncthreads();
    bf16x8 qf[8];
#pragma unroll
    for (int s = 0; s < 8; ++s) qf[s] = *(const bf16x8*)(lds + GL_QB + (ib * 32 + r) * 272 + (16 * s + 8 * h) * 2);
    f32x16 X[2];
#pragma unroll
    for (int jb = 0; jb < 2; ++jb) {
#pragma unroll
      for (int i = 0; i < 16; ++i) X[jb][i] = 0.f;
      if (jb <= ib) {
        const int jrow = jb * 32 + perm23(r);
#pragma unroll
        for (int s = 0; s < 8; ++s) {
          const bf16x8 a = *(const bf16x8*)(lds + GL_KB + jrow * 272 + (16 * s + 8 * h) * 2);
          X[jb] = mfma32(a, qf[s], X[jb]);
        }
        if (jb == ib) {
#pragma unroll
          for (int gi = 0; gi < 16; ++gi) {
            const int jj = (gi & 3) + 4 * ((gi >> 2) & 1) + 8 * h + 16 * ((gi >> 3) & 1);
            if (jj > r) X[jb][gi] = 0.f;
          }
        }
      }
    }
    f32x16 acc[2];
#pragma unroll
    for (int eb = 0; eb < 2; ++eb)
#pragma unroll
      for (int i = 0; i < 16; ++i) acc[eb][i] = 0.f;
    const int e0 = eq * 64;
#pragma unroll
    for (int jb = 0; jb < 2; ++jb) {
      if (jb <= ib) {
#pragma unroll
        for (int s2 = 0; s2 < 2; ++s2) {
          const bf16x8 pf = pack8(X[jb][8 * s2 + 0], X[jb][8 * s2 + 1], X[jb][8 * s2 + 2], X[jb][8 * s2 + 3],
                                  X[jb][8 * s2 + 4], X[jb][8 * s2 + 5], X[jb][8 * s2 + 6], X[jb][8 * s2 + 7]);
#pragma unroll
          for (int eb = 0; eb < 2; ++eb) {
            const bf16x8 a = *(const bf16x8*)(lds + GL_VT + (e0 + eb * 32 + r) * 144 + (jb * 32 + 16 * s2 + 8 * h) * 2);
            acc[eb] = mfma32(a, pf, acc[eb]);
          }
        }
      }
    }
#pragma unroll
    for (int s = 0; s < 8; ++s)
#pragma unroll
      for (int eb = 0; eb < 2; ++eb) {
        const bf16x8 a = *(const bf16x8*)(lds + GL_ST + (e0 + eb * 32 + r) * 272 + (16 * s + 8 * h) * 2);
        acc[eb] = mfma32(a, qf[s], acc[eb]);
      }
    float ss = 0.f;
#pragma unroll
    for (int eb = 0; eb < 2; ++eb)
#pragma unroll
      for (int i = 0; i < 16; ++i) ss += acc[eb][i] * acc[eb][i];
    ss += shx(ss, 32, lane);
    if (h == 0) red[eq * 64 + ib * 32 + r] = ss;
    __syncthreads();
    const int il = ib * 32 + r;
    const float tsum = red[il] + red[64 + il] + red[128 + il] + red[192 + il];
    const float rstd = rsqrtf(tsum * (1.0f / 256.0f) + EPS);
    const int token = chunk * 64 + il;
#pragma unroll
    for (int eb = 0; eb < 2; ++eb)
#pragma unroll
      for (int g4 = 0; g4 < 4; ++g4) {
        const int eb0 = e0 + eb * 32 + 8 * g4 + 4 * h;
        const u32x2 gt = *(const u32x2*)(PROJ + (size_t)token * 4096 + 1024 + head * 256 + eb0);
        const f32x4 gn = *(const f32x4*)(gnorm + eb0);
        float gv[4] = {bflo(gt[0]), bfhi(gt[0]), bflo(gt[1]), bfhi(gt[1])};
        float y[4];
#pragma unroll
        for (int j = 0; j < 4; ++j) { const float sg = gv[j] * __builtin_amdgcn_rcpf(1.0f + __expf(-gv[j])); y[j] = acc[eb][g4 * 4 + j] * rstd * gn[j] * sg; }
        u32x2 w = {pk_bf16(y[0], y[1]), pk_bf16(y[2], y[3])};
        *(u32x2*)(O + (size_t)token * DM + head * 256 + eb0) = w;
      }
  }
  __syncthreads();
}

#define LDSADDR(p) ((unsigned)(unsigned long)(p))
DI void lds_rd128(bf16x8& dst, const unsigned addr) { asm volatile("ds_read_b128 %0, %1" : "=v"(dst) : "v"(addr)); }
DI void lgkm_wait(const int n, bf16x8& reg) {
  switch (n) {
    case 0: asm volatile("s_waitcnt lgkmcnt(0)" : "+v"(reg)); break;
    case 1: asm volatile("s_waitcnt lgkmcnt(1)" : "+v"(reg)); break;
    case 2: asm volatile("s_waitcnt lgkmcnt(2)" : "+v"(reg)); break;
    case 3: asm volatile("s_waitcnt lgkmcnt(3)" : "+v"(reg)); break;
    case 4: asm volatile("s_waitcnt lgkmcnt(4)" : "+v"(reg)); break;
    case 5: asm volatile("s_waitcnt lgkmcnt(5)" : "+v"(reg)); break;
    case 6: asm volatile("s_waitcnt lgkmcnt(6)" : "+v"(reg)); break;
    default: asm volatile("s_waitcnt lgkmcnt(7)" : "+v"(reg)); break;
  }
}
__device__ __forceinline__ void attn_finish(f32x16 (&o)[8], const float l, const Params& p, unsigned char* lds, const int tid, const int pr, const int comp, const int q0, const int head) {
  bf16_t* O = (bf16_t*)(p.ws + WS_O); const float* dnorm = p.in[10];
  {
      int t3 = tid; asm volatile("" : "+v"(t3));
      const float lt = l + __builtin_bit_cast(float, __builtin_amdgcn_ds_bpermute(((t3 & 63) ^ 32) << 2, __builtin_bit_cast(int, l)));
      float* ex = (float*)lds + (size_t)pr * 8192;
      const int lane_e = t3 & 63, h_e = lane_e >> 5, qrow_e = q0 + pr * 32 + (lane_e & 31);
      if (comp == 1) {
        float lam;
        {
          const float* q1 = p.in[6]; const float* k1 = p.in[7]; const float* q2 = p.in[8]; const float* k2 = p.in[9];
          float s1 = q1[lane_e] * k1[lane_e] + q1[lane_e + 64] * k1[lane_e + 64];
          float s2 = q2[lane_e] * k2[lane_e] + q2[lane_e + 64] * k2[lane_e + 64];
          s1 = wave_sum_l(s1, lane_e); s2 = wave_sum_l(s2, lane_e);
          lam = expf(s1) - expf(s2) + 0.2f;
        }
        const float sc = lam / lt;
#pragma unroll
        for (int dvb = 0; dvb < 8; ++dvb)
#pragma unroll
          for (int gi = 0; gi < 16; ++gi) ex[(dvb * 16 + gi) * 64 + lane_e] = o[dvb][gi] * sc;
      }
      __syncthreads();
      if (comp == 0) {
        const float sc = 1.0f / lt;
        float ss = 0.f;
#pragma unroll
        for (int dvb = 0; dvb < 8; ++dvb) {
#pragma unroll
          for (int gi = 0; gi < 16; ++gi) { const float dv = o[dvb][gi] * sc - ex[(dvb * 16 + gi) * 64 + lane_e]; o[dvb][gi] = dv; ss += dv * dv; }
          asm volatile("" : "+v"(o[dvb]), "+v"(ss) :: "memory");
        }
        ss += __builtin_bit_cast(float, __builtin_amdgcn_ds_bpermute((lane_e ^ 32) << 2, __builtin_bit_cast(int, ss)));
        const float rstd = rsqrtf(ss * (1.0f / 256.0f) + EPS) * 0.8f;
#pragma unroll
        for (int dvb = 0; dvb < 8; ++dvb)
#pragma unroll
          for (int g4 = 0; g4 < 4; ++g4) {
            const int dv0 = dvb * 32 + 8 * g4 + 4 * h_e;
            const f32x4 gn = *(const f32x4*)(dnorm + dv0);
            u32x2 w = {pk_bf16(o[dvb][g4 * 4 + 0] * rstd * gn[0], o[dvb][g4 * 4 + 1] * rstd * gn[1]),
                       pk_bf16(o[dvb][g4 * 4 + 2] * rstd * gn[2], o[dvb][g4 * 4 + 3] * rstd * gn[3])};
            *(u32x2*)(O + (size_t)qrow_e * DM + 1024 + head * 256 + dv0) = w;
          }
      }
      __syncthreads();
  }
}

__device__ __forceinline__ void attn_norms(const Params& p, const int g_wave64) {
  extern __shared__ __attribute__((aligned(16))) unsigned char lds[];
  const bf16_t* PROJ = (const bf16_t*)(p.ws + WS_PROJ); unsigned* NRM = (unsigned*)(p.ws + WS_NRM);
  OPAQUE_TID(tid); const int lane = tid & 63, wave = tid >> 6;
  float* red = (float*)lds;
  float mx0 = 0.f, mx1 = 0.f, mx2 = 0.f;
  for (int rb = blockIdx.x; rb < SEQ / 64; rb += gridDim.x) {
    const int row = rb * 64 + (tid >> 3), j = tid & 7;
    const bf16_t* qp = PROJ + (size_t)row * 4096 + 2048 + j * 128;
    const bf16_t* kp = qp + 1024;
    float qq = 0.f, kk = 0.f, qk = 0.f;
#pragma unroll
    for (int c = 0; c < 16; ++c) { const u32x4 v = *(const u32x4*)(qp + c * 8), w = *(const u32x4*)(kp + c * 8);
#pragma unroll
      for (int e = 0; e < 4; ++e) { const float a = bflo(v[e]), bb = bfhi(v[e]), c2 = bflo(w[e]), d2 = bfhi(w[e]); qq += a * a + bb * bb; kk += c2 * c2 + d2 * d2; qk += a * c2 + bb * d2; } }
    mx0 = fmaxf(mx0, qq); mx1 = fmaxf(mx1, kk); mx2 = fmaxf(mx2, -qk);
  }
  for (int o = 8; o < 64; o <<= 1) { mx0 = fmaxf(mx0, shx(mx0, o, lane)); mx1 = fmaxf(mx1, shx(mx1, o, lane)); mx2 = fmaxf(mx2, shx(mx2, o, lane)); }
  __syncthreads();
  if (lane < 8) { red[wave * 24 + lane] = mx0; red[wave * 24 + 8 + lane] = mx1; red[wave * 24 + 16 + lane] = mx2; }
  __syncthreads();
  if (tid < 24) { float mm = 0.f; for (int w = 0; w < 8; ++w) mm = fmaxf(mm, red[w * 24 + tid]); atomicMax(NRM + tid, __float_as_uint(mm)); }
  __syncthreads();
}
__device__ __forceinline__ void attn_plan(const Params& p, int (&dh)[4]) {
  unsigned* NRM = (unsigned*)(p.ws + WS_NRM);
#pragma unroll
  for (int hh = 0; hh < 4; ++hh) {
    float bound = 0.f;
#pragma unroll
    for (int c = 0; c < 2; ++c) {
      const float qn = __uint_as_float(__hip_atomic_load(NRM + hh * 2 + c, __ATOMIC_RELAXED, __HIP_MEMORY_SCOPE_AGENT));
      const float kn = __uint_as_float(__hip_atomic_load(NRM + 8 + hh * 2 + c, __ATOMIC_RELAXED, __HIP_MEMORY_SCOPE_AGENT));
      const float dg = __uint_as_float(__hip_atomic_load(NRM + 16 + hh * 2 + c, __ATOMIC_RELAXED, __HIP_MEMORY_SCOPE_AGENT));
      bound = fmaxf(bound, (sqrtf(qn * kn) + dg) * (0.08838834764831845f * LOG2E * 1.02f));
    }
    const float slope2 = exp2f(-2.0f * (float)(hh + 1)) * LOG2E;
    const float D = (bound + 152.0f) / slope2;
    dh[hh] = __builtin_amdgcn_readfirstlane((D < 1.0e9f) ? (int)D : 1000000000);
  }
}
__device__ __forceinline__ int attn_nsteps(const int head, const int qb, const int (&dh)[4]) {
  const int d = dh[0] * (head == 0) + dh[1] * (head == 1) + dh[2] * (head == 2) + dh[3] * (head == 3);
  int ttmin = (128 * qb - d) / 64 - 1; ttmin = ttmin < 0 ? 0 : ttmin;
  return 2 * qb + 2 - ttmin;
}
constexpr int ATT_TAB = 132096;
__device__ __forceinline__ void attn_build_plan(const Params& p, unsigned char* lds, const int tid) {
  int* tab = (int*)(lds + ATT_TAB);
  __syncthreads();
  int dh[4]; attn_plan(p, dh);
  if (tid < 256) {
    const int r = tid >> 5, j = tid & 31;
    int v = attn_nsteps(r >> 1, 127 - (r & 1) * 32 - j, dh) + attn_nsteps(r >> 1, (r & 1) * 32 + j, dh) + 2 * OVH;
    for (int o = 1; o < 32; o <<= 1) { const int w = __builtin_amdgcn_ds_bpermute(((tid & 63) ^ o) << 2, v); v = w > v ? w : v; }
    if (j == 0) tab[128 + r] = v;
  }
  __syncthreads();
  if (tid == 0) {
    const int xg = (int)blockIdx.x & 7, jq = (int)blockIdx.x >> 3;
    int R = 0;
#pragma unroll 1
    for (int r = 0; r < 8; ++r) R += tab[128 + r];
    const int Xa = (xg * R) / 8, Xb = ((xg + 1) * R) / 8;
    int P = 0; int first = 1;
#pragma unroll 1
    for (int r = 0; r < 8; ++r) {
      const int head = r >> 1, pg = r & 1, rlen = tab[128 + r];
      const int ra = (Xa > P ? Xa : P) - P, rb = (Xb < P + rlen ? Xb : P + rlen) - P;
      int off = 0;
#pragma unroll 1
      for (int part = 0; part < 2; ++part) {
        const int qb = part == 0 ? pg * 32 + jq : 127 - pg * 32 - jq;
        const int nst = attn_nsteps(head, qb, dh);
        int t_lo = ra - off, t_hi = rb - off;
        t_lo = t_lo < 0 ? 0 : t_lo; t_hi = t_hi > nst ? nst : t_hi;
        int* e = tab + (r * 2 + part) * 8;
        e[2] = nst; e[6] = qb;
        if (ra >= rb || t_lo >= t_hi) { e[0] = 0; e[1] = 0; e[3] = 0; e[4] = 0; e[5] = 0; }
        else {
          e[0] = t_lo; e[1] = t_hi; e[3] = 2 * (int)blockIdx.x + (first ? 0 : 1); first = 0;
          int cflag = 0, xend = xg;
          if (t_lo == 0 && t_hi < nst) {
            cflag = 1;
            for (int xx = xg + 1; xx < 8; ++xx) { if ((xx * R) / 8 - (P + off) >= nst) break; xend = xx; }
          }
          e[4] = cflag; e[5] = xend;
        }
        off += nst + OVH;
      }
      P += rlen;
    }
  }
  __syncthreads();
}
__device__ __forceinline__ void attn_phase(const Params& p, const int g_wave64) {
  extern __shared__ __attribute__((aligned(16))) unsigned char lds[];
  const bf16_t* PROJ = (const bf16_t*)(p.ws + WS_PROJ); const bf16_t* VT = (const bf16_t*)(p.ws + WS_VT);
  OPAQUE_TID(tid); const int lane = tid & 63, wave = __builtin_amdgcn_readfirstlane(tid >> 6), r = lane & 31, h = lane >> 5;
  const int comp = wave & 1, pr = wave >> 1;
  LAS unsigned char* L = (LAS unsigned char*)lds;
  const int pr_r = perm23(r);
  const unsigned kbase = (unsigned)pr_r * 256u, khs_c = (unsigned)((h ^ (pr_r & 15)) << 4);
  const unsigned vbase = (unsigned)r * 128u, vhs_c = (unsigned)((h ^ ((r >> 1) & 7)) << 4);
  const float C1 = 0.08838834764831845f * LOG2E;
  attn_build_plan(p, lds, tid);
  const int jq = (int)blockIdx.x >> 3;
#pragma unroll 1
  for (int rr = 0; rr < 16; ++rr) {
    const int* e = (const int*)(lds + ATT_TAB) + rr * 8;
    const int t_lo = __builtin_amdgcn_readfirstlane(e[0]), t_hi = __builtin_amdgcn_readfirstlane(e[1]), nst = __builtin_amdgcn_readfirstlane(e[2]), slot = __builtin_amdgcn_readfirstlane(e[3]);
    if (t_lo >= t_hi) continue;
    const int head = rr >> 2, qb = __builtin_amdgcn_readfirstlane(e[6]);
    const float slope2 = exp2f(-2.0f * (float)(head + 1)) * LOG2E;
    {
      const int q0 = qb * 128, ntiles = 2 * qb + 2;
      const int qrow = q0 + pr * 32 + r;
      bf16x8 qf[8];
      {
        int t4 = tid; asm volatile("" : "+v"(t4));
        const bf16_t* qp = PROJ + (size_t)(q0 + pr * 32 + (t4 & 31)) * 4096 + 2048 + head * 256 + comp * 128 + 8 * ((t4 >> 5) & 1);
#pragma unroll
        for (int s = 0; s < 8; ++s) {
          const u32x4 raw = *(const u32x4*)(qp + 16 * s);
          u32x4 sc;
#pragma unroll
          for (int j = 0; j < 4; ++j) sc[j] = pk_bf16(bflo(raw[j]) * C1, bfhi(raw[j]) * C1);
          qf[s] = __builtin_bit_cast(bf16x8, sc);
        }
      }
      f32x16 o[8];
#pragma unroll
      for (int dvb = 0; dvb < 8; ++dvb)
#pragma unroll
        for (int i = 0; i < 16; ++i) o[dvb][i] = 0.f;
      float m = -1e30f, l = 0.f;
#define ISSUE_TILE(T, BUF) do { int _t2 = tid; asm volatile("" : "+v"(_t2)); \
      const char* _kg = (const char*)PROJ + ((size_t)(T) * 64 * 4096 + 3072 + head * 256) * 2; \
      const char* _vg = (const char*)VT + ((size_t)(1024 + head * 256) * SEQ + (size_t)(T) * 64) * 2; \
      LAS unsigned char* _b = L + (BUF) * 65536 + wave * 1024; \
      _Pragma("unroll") for (int _i = 0; _i < 4; ++_i) { const int _slot = _t2 + NT * _i, _cmp = _slot >> 10, _sl = _slot & 1023, _row = _sl >> 4, _c = (_sl & 15) ^ (_row & 15); \
        __builtin_amdgcn_global_load_lds((const unsigned*)(_kg + (unsigned)((_row * 4096 + _cmp * 128 + _c * 8) * 2)), (LAS unsigned*)(_b + _i * 8192), 16, 0, 0); } \
      _Pragma("unroll") for (int _i = 0; _i < 4; ++_i) { const int _slot = _t2 + NT * _i, _row = _slot >> 3, _c = (_slot & 7) ^ ((_row >> 1) & 7); \
        __builtin_amdgcn_global_load_lds((const unsigned*)(_vg + (unsigned)((_row * SEQ + _c * 8) * 2)), (LAS unsigned*)(_b + 32768 + _i * 8192), 16, 0, 0); } } while (0)
#define ISSUE_PIECE(T, BUF, I) do { int _t2 = tid; asm volatile("" : "+v"(_t2)); LAS unsigned char* _b = L + (BUF) * 65536 + wave * 1024; \
      if ((I) < 4) { const int _slot = _t2 + NT * (I), _cmp = _slot >> 10, _sl = _slot & 1023, _row = _sl >> 4, _c = (_sl & 15) ^ (_row & 15); \
        const char* _kg = (const char*)PROJ + ((size_t)(T) * 64 * 4096 + 3072 + head * 256) * 2; \
        __builtin_amdgcn_global_load_lds((const unsigned*)(_kg + (unsigned)((_row * 4096 + _cmp * 128 + _c * 8) * 2)), (LAS unsigned*)(_b + (I) * 8192), 16, 0, 0); } \
      else { const int _slot = _t2 + NT * ((I) - 4), _row = _slot >> 3, _c = (_slot & 7) ^ ((_row >> 1) & 7); \
        const char* _vg = (const char*)VT + ((size_t)(1024 + head * 256) * SEQ + (size_t)(T) * 64) * 2; \
        __builtin_amdgcn_global_load_lds((const unsigned*)(_vg + (unsigned)((_row * SEQ + _c * 8) * 2)), (LAS unsigned*)(_b + 32768 + ((I) - 4) * 8192), 16, 0, 0); } } while (0)
      __syncthreads();
      ISSUE_TILE(ntiles - 1 - t_lo, 0);
      asm volatile("s_waitcnt vmcnt(0)" ::: "memory");
      __syncthreads();
      for (int t = t_lo; t < t_hi; ++t) {
        const int buf = (t - t_lo) & 1, tt = ntiles - 1 - t;
        const bool do_issue = (t + 1 < t_hi);
        const int k0 = tt * 64;
        const bool act = (k0 <= q0 + pr * 32 + 31);
        if (do_issue && !act) ISSUE_TILE(tt - 1, buf ^ 1);
        if (act) {
          LAS unsigned char* kb = L + (buf * 65536 + comp * 16384);
          LAS unsigned char* vb = L + (buf * 65536 + 32768);
#define KADDR(f) (kb + ((f) & 1) * 8192 + (kbase + ((unsigned)(((f) >> 1) * 32) ^ khs)))
#define VADDR(f) (vb + ((f) & 7) * 4096 + (vbase + ((unsigned)(((f) >> 3) * 32) ^ vhs)))
          unsigned khs = khs_c, vhs = vhs_c; asm volatile("" : "+v"(khs), "+v"(vhs));
          bf16x8 kf[KR];
#pragma unroll
          for (int f = 0; f < KR; ++f) lds_rd128(kf[f], LDSADDR(KADDR(f)));
          float sl2 = slope2; asm volatile("" : "+v"(sl2));
          const float mref = (m > -1e29f) ? m : 0.f;
          const float tb = sl2 * (float)(k0 + 8 * h - q0) - mref;
          f32x16 sa0, sa1;
          {
            const float s4x = sl2 * 4.0f, s16x = s4x * 4.0f, s32x = s16x + s16x;
            sa0[0] = tb; sa0[1] = tb + sl2; sa0[2] = sa0[1] + sl2; sa0[3] = sa0[2] + sl2;
#pragma unroll
            for (int gi = 0; gi < 4; ++gi) sa0[4 + gi] = sa0[gi] + s4x;
#pragma unroll
            for (int gi = 0; gi < 8; ++gi) sa0[8 + gi] = sa0[gi] + s16x;
#pragma unroll
            for (int gi = 0; gi < 16; ++gi) sa1[gi] = sa0[gi] + s32x;
          }
#pragma unroll
          for (int f = 0; f < 16; ++f) {
            lgkm_wait((15 - f) < (KR - 1) ? (15 - f) : (KR - 1), kf[f % KR]);
            if (f & 1) sa1 = mfma32(kf[f % KR], qf[f >> 1], sa1); else sa0 = mfma32(kf[f % KR], qf[f >> 1], sa0);
            if (f + KR < 16) lds_rd128(kf[f % KR], LDSADDR(KADDR(f + KR)));
            __builtin_amdgcn_sched_barrier(0);
          }
          bf16x8 vf[VR];
#pragma unroll
          for (int f = 0; f < VR; ++f) lds_rd128(vf[f], LDSADDR(VADDR(f)));
          __builtin_amdgcn_sched_barrier(0);
          if (do_issue) { ISSUE_PIECE(tt - 1, buf ^ 1, 0); ISSUE_PIECE(tt - 1, buf ^ 1, 1); ISSUE_PIECE(tt - 1, buf ^ 1, 2); ISSUE_PIECE(tt - 1, buf ^ 1, 3); }
          __builtin_amdgcn_sched_barrier(0);
          if (k0 + 63 > q0 + pr * 32) {
#pragma unroll
            for (int gi = 0; gi < 16; ++gi) {
              const int koff = (gi & 3) + 4 * ((gi >> 2) & 1) + 16 * ((gi >> 3) & 1);
              if (k0 + koff + 8 * h > qrow) sa0[gi] = -1e30f;
              if (k0 + koff + 32 + 8 * h > qrow) sa1[gi] = -1e30f;
            }
          }
          float mloc = fmaxf(sa0[0], sa1[0]);
#pragma unroll
          for (int gi = 1; gi < 16; ++gi) mloc = fmaxf(mloc, fmaxf(sa0[gi], sa1[gi]));
          mloc = fmaxf(mloc, shx(mloc, 32, lane));
          const float mrel = m - mref;
          const float delta = fmaxf(mrel, mloc);
          if (__ballot(delta > mrel) != 0ull) {
            const float alpha = __builtin_amdgcn_exp2f(mrel - delta);
            l *= alpha;
#pragma unroll
            for (int dvb = 0; dvb < 8; ++dvb) o[dvb] = o[dvb] * alpha;
#pragma unroll
            for (int gi = 0; gi < 16; ++gi) { sa0[gi] -= delta; sa1[gi] -= delta; }
          }
          m = mref + delta;
          float ps = 0.f;
#pragma unroll
          for (int gi = 0; gi < 16; ++gi) {
            const float p0 = __builtin_amdgcn_exp2f(sa0[gi]), p1 = __builtin_amdgcn_exp2f(sa1[gi]);
            sa0[gi] = p0; sa1[gi] = p1; ps += p0 + p1;
          }
          l += ps;
          __builtin_amdgcn_sched_barrier(0);
          if (do_issue) { ISSUE_PIECE(tt - 1, buf ^ 1, 4); ISSUE_PIECE(tt - 1, buf ^ 1, 5); ISSUE_PIECE(tt - 1, buf ^ 1, 6); ISSUE_PIECE(tt - 1, buf ^ 1, 7); }
          __builtin_amdgcn_sched_barrier(0);
          bf16x8 pf[4];
          pf[0] = pack8(sa0[0], sa0[1], sa0[2], sa0[3], sa0[4], sa0[5], sa0[6], sa0[7]);
          pf[1] = pack8(sa0[8], sa0[9], sa0[10], sa0[11], sa0[12], sa0[13], sa0[14], sa0[15]);
          pf[2] = pack8(sa1[0], sa1[1], sa1[2], sa1[3], sa1[4], sa1[5], sa1[6], sa1[7]);
          pf[3] = pack8(sa1[8], sa1[9], sa1[10], sa1[11], sa1[12], sa1[13], sa1[14], sa1[15]);
          __builtin_amdgcn_sched_barrier(0);
#pragma unroll
          for (int f = 0; f < 32; ++f) {
            lgkm_wait((31 - f) < (VR - 1) ? (31 - f) : (VR - 1), vf[f % VR]);
            o[f & 7] = mfma32(vf[f % VR], pf[f >> 3], o[f & 7]);
            if (f + VR < 32) lds_rd128(vf[f % VR], LDSADDR(VADDR(f + VR)));
            __builtin_amdgcn_sched_barrier(0);
          }
#undef KADDR
#undef VADDR
        }
        asm volatile("s_waitcnt vmcnt(0)" ::: "memory");
        __syncthreads();
      }
#undef ISSUE_TILE
#undef ISSUE_PIECE
      if (t_lo == 0 && t_hi == nst) {
        attn_finish(o, l, p, lds, tid, pr, comp, q0, head);
      } else {
        int t5 = tid; asm volatile("" : "+v"(t5));
        float* ps = part_slot(p, slot) + wave * 8192 + (t5 & 63);
#pragma unroll
        for (int dvb = 0; dvb < 8; ++dvb)
#pragma unroll
          for (int gi = 0; gi < 16; ++gi) ps[(dvb * 16 + gi) * 64] = o[dvb][gi];
        float* ml = (float*)(p.ws + WS_ML) + ((size_t)slot * 8 + wave) * 128 + (t5 & 63);
        ml[0] = m; ml[64] = l;
      }
    }
  }
  __syncthreads();
}

__device__ __forceinline__ void attn_combine(const Params& p, const int g_wave64) {
  extern __shared__ __attribute__((aligned(16))) unsigned char lds[];
  OPAQUE_TID(tid); const int lane = tid & 63, wave = __builtin_amdgcn_readfirstlane(tid >> 6);
  const int comp = wave & 1, pr = wave >> 1;
  attn_build_plan(p, lds, tid);
  const int xg = (int)blockIdx.x & 7, jq = (int)blockIdx.x >> 3;
#pragma unroll 1
  for (int rr = 0; rr < 16; ++rr) {
    const int* e = (const int*)(lds + ATT_TAB) + rr * 8;
    const int cflag = __builtin_amdgcn_readfirstlane(e[4]), xend = __builtin_amdgcn_readfirstlane(e[5]), slot0 = __builtin_amdgcn_readfirstlane(e[3]);
    if (!cflag) continue;
    const int head = rr >> 2, qb = __builtin_amdgcn_readfirstlane(e[6]);
    f32x16 o[8]; float m, l;
    {
      const int slot = slot0;
      const float* ps = part_slot(p, slot) + wave * 8192 + lane;
#pragma unroll
      for (int dvb = 0; dvb < 8; ++dvb)
#pragma unroll
        for (int gi = 0; gi < 16; ++gi) o[dvb][gi] = ps[(dvb * 16 + gi) * 64];
      const float* ml = (const float*)(p.ws + WS_ML) + ((size_t)slot * 8 + wave) * 128 + lane;
      m = ml[0]; l = ml[64];
    }
    for (int xx = xg + 1; xx <= xend; ++xx) {
      const int slot = 2 * (jq * 8 + xx);
      const float* ml = (const float*)(p.ws + WS_ML) + ((size_t)slot * 8 + wave) * 128 + lane;
      const float ms = ml[0], ls = ml[64];
      const float mn = fmaxf(m, ms);
      const float a0 = __builtin_amdgcn_exp2f(m - mn), a1 = __builtin_amdgcn_exp2f(ms - mn);
      const float* ps = part_slot(p, slot) + wave * 8192 + lane;
#pragma unroll
      for (int dvb = 0; dvb < 8; ++dvb) {
#pragma unroll
        for (int gi = 0; gi < 16; ++gi) o[dvb][gi] = o[dvb][gi] * a0 + ps[(dvb * 16 + gi) * 64] * a1;
        asm volatile("" : "+v"(o[dvb]) :: "memory");
      }
      l = l * a0 + ls * a1; m = mn;
    }
    attn_finish(o, l, p, lds, tid, pr, comp, qb * 128, head);
  }
  __syncthreads();
}

__device__ __forceinline__ void p6_post_attn(const Params& p, const int g_wave64) {
  const float* x = p.in[0]; const float* gp = p.in[12]; const float* gf = p.in[13];
  const bf16_t* Mb = (const bf16_t*)(p.ws + WS_M); bf16_t* H = (bf16_t*)(p.ws + WS_H);
  OPAQUE_TID(tid); const int lane = tid & 63, wave = tid >> 6;
  for (int row = blockIdx.x * 8 + wave; row < SEQ; row += gridDim.x * 8) {
    f32x4 mv[8];
    float s = 0.f;
#pragma unroll
    for (int ii = 0; ii < 8; ++ii) { const u32x2 rw = *(const u32x2*)(Mb + (size_t)row * DM + ii * 256 + lane * 4); mv[ii] = (f32x4){bflo(rw[0]), bfhi(rw[0]), bflo(rw[1]), bfhi(rw[1])}; s += mv[ii][0] * mv[ii][0] + mv[ii][1] * mv[ii][1] + mv[ii][2] * mv[ii][2] + mv[ii][3] * mv[ii][3]; }
    s = wave_sum_l(s, lane);
    const float rs = rsqrtf(s * (1.0f / DM) + EPS);
    float s2 = 0.f;
#pragma unroll
    for (int ii = 0; ii < 8; ++ii) {
      const f32x4 xv = *(const f32x4*)(x + (size_t)row * DM + ii * 256 + lane * 4);
      const f32x4 g = *(const f32x4*)(gp + ii * 256 + lane * 4);
      mv[ii] = xv + mv[ii] * rs * g;
      s2 += mv[ii][0] * mv[ii][0] + mv[ii][1] * mv[ii][1] + mv[ii][2] * mv[ii][2] + mv[ii][3] * mv[ii][3];
    }
    s2 = wave_sum_l(s2, lane);
    const float rs2 = rsqrtf(s2 * (1.0f / DM) + EPS);
#pragma unroll
    for (int ii = 0; ii < 8; ++ii) {
      const f32x4 g = *(const f32x4*)(gf + ii * 256 + lane * 4);
      const f32x4 hv = mv[ii] * rs2 * g;
      u32x2 w = {pk_bf16(hv[0], hv[1]), pk_bf16(hv[2], hv[3])};
      *(u32x2*)(H + (size_t)row * DM + ii * 256 + lane * 4) = w;
    }
  }
}

__device__ __forceinline__ void p10_final(const Params& p, const int g_wave64) {
  const float* x = p.in[0]; const float* gm = p.in[12]; const float* gp = p.in[18];
  const bf16_t* Mb = (const bf16_t*)(p.ws + WS_M); const bf16_t* F = (const bf16_t*)(p.ws + WS_F); float* out = p.out;
  OPAQUE_TID(tid); const int lane = tid & 63, wave = tid >> 6;
  for (int row = blockIdx.x * 8 + wave; row < SEQ; row += gridDim.x * 8) {
    f32x4 mv[8], fv[8];
    float s = 0.f, sm = 0.f;
#pragma unroll
    for (int ii = 0; ii < 8; ++ii) {
      const u32x2 rw = *(const u32x2*)(F + (size_t)row * DM + ii * 256 + lane * 4); fv[ii] = (f32x4){bflo(rw[0]), bfhi(rw[0]), bflo(rw[1]), bfhi(rw[1])};
      const u32x2 rm = *(const u32x2*)(Mb + (size_t)row * DM + ii * 256 + lane * 4); mv[ii] = (f32x4){bflo(rm[0]), bfhi(rm[0]), bflo(rm[1]), bfhi(rm[1])};
      s += fv[ii][0] * fv[ii][0] + fv[ii][1] * fv[ii][1] + fv[ii][2] * fv[ii][2] + fv[ii][3] * fv[ii][3];
      sm += mv[ii][0] * mv[ii][0] + mv[ii][1] * mv[ii][1] + mv[ii][2] * mv[ii][2] + mv[ii][3] * mv[ii][3];
    }
    s = wave_sum_l(s, lane); sm = wave_sum_l(sm, lane);
    const float rs = rsqrtf(s * (1.0f / DM) + EPS), rsm = rsqrtf(sm * (1.0f / DM) + EPS);
#pragma unroll
    for (int ii = 0; ii < 8; ++ii) {
      const f32x4 xv = *(const f32x4*)(x + (size_t)row * DM + ii * 256 + lane * 4);
      const f32x4 g1 = *(const f32x4*)(gm + ii * 256 + lane * 4);
      const f32x4 g = *(const f32x4*)(gp + ii * 256 + lane * 4);
      *(f32x4*)(out + (size_t)row * DM + ii * 256 + lane * 4) = (xv + mv[ii] * rsm * g1) + fv[ii] * rs * g;
    }
  }
}
__device__ __forceinline__ void p8_fixup(const Params& p, const int g_wave64) {
  const float* SA0 = (const float*)(p.ws + WS_SA0); const float* SB0 = (const float*)(p.ws + WS_SB0); const float* SAL = (const float*)(p.ws + WS_SAL);
  bf16_t* G = (bf16_t*)(p.ws + WS_BUP); const float* cw = p.in[15]; const float* cb = p.in[16];
  OPAQUE_TID(tid);
  constexpr int nM = SEQ / 256, nN = DM / 256, nwg = nM * nN;
  int pmprev = -1;
  for (int L = (int)blockIdx.x; L < nwg; L += (int)gridDim.x) {
    int w = L; { const int q = nwg / NXCD, r = nwg % NXCD, x = w % NXCD, o = w / NXCD; w = (x < r ? x * (q + 1) : r * (q + 1) + (x - r) * q) + o; }
    const int nig = WGM * nN, gid = w / nig, fm = gid * WGM, gsz = min(nM - fm, WGM);
    const int pm = fm + ((w % nig) % gsz);
    if (pm == pmprev) continue;
    pmprev = pm;
    float a0v[11], a1v[11], b0v[11], b1v[11], l0v[11], l1v[11], w0v[11], w1v[11], w2v[11], cbv[11];
#pragma unroll
    for (int i = 0; i < 11; ++i) {
      const int c = tid + NT * i;
      a0v[i] = SA0[(size_t)(pm * 2) * DFF + c]; a1v[i] = SA0[(size_t)(pm * 2 + 1) * DFF + c];
      b0v[i] = SB0[(size_t)(pm * 2) * DFF + c]; b1v[i] = SB0[(size_t)(pm * 2 + 1) * DFF + c];
      l0v[i] = pm > 0 ? SAL[((size_t)(pm - 1) * 2 + 0) * DFF + c] : 0.f; l1v[i] = pm > 0 ? SAL[((size_t)(pm - 1) * 2 + 1) * DFF + c] : 0.f;
      w0v[i] = cw[c]; w1v[i] = cw[DFF + c]; w2v[i] = cw[2 * DFF + c]; cbv[i] = cb[c];
    }
#pragma unroll
    for (int i = 0; i < 11; ++i) {
      const int c = tid + NT * i;
      const float y0 = w0v[i] * l0v[i] + w1v[i] * l1v[i] + w2v[i] * a0v[i] + cbv[i];
      const float y1 = w0v[i] * l1v[i] + w1v[i] * a0v[i] + w2v[i] * a1v[i] + cbv[i];
      const float e0 = __builtin_amdgcn_exp2f(-2.302208198f * (y0 + 0.044715f * y0 * y0 * y0));
      const float e1 = __builtin_amdgcn_exp2f(-2.302208198f * (y1 + 0.044715f * y1 * y1 * y1));
      const float g0 = y0 * __builtin_amdgcn_rcpf(1.0f + e0) * b0v[i], g1 = y1 * __builtin_amdgcn_rcpf(1.0f + e1) * b1v[i];
      G[(size_t)(pm * 256) * DFF + c] = (bf16_t)(pk_bf16(g0, 0.f) & 0xffffu);
      G[(size_t)(pm * 256 + 1) * DFF + c] = (bf16_t)(pk_bf16(g1, 0.f) & 0xffffu);
    }
  }
  asm volatile("s_waitcnt vmcnt(0)" ::: "memory");
  __syncthreads();
}

__device__ __forceinline__ void p8_conv_glu(const Params& p, const int g_wave64) {
  const bf16_t* Aup = (const bf16_t*)(p.ws + WS_AUP); bf16_t* Bup = (bf16_t*)(p.ws + WS_BUP);
  const float* cw = p.in[15]; const float* cb = p.in[16];
  constexpr int NCG = DFF / 8, RUN = 32, NRUN = SEQ / RUN;
  OPAQUE_TID(tid);
  for (int item = blockIdx.x * NT + tid; item < NCG * NRUN; item += gridDim.x * NT) {
    const int cgi = item % NCG, run = item / NCG, c0 = cgi * 8, t0 = run * RUN;
    float w0[8], w1[8], w2[8], bb[8], am2[8], am1[8];
#pragma unroll
    for (int j = 0; j < 8; ++j) { w0[j] = cw[c0 + j]; w1[j] = cw[DFF + c0 + j]; w2[j] = cw[2 * DFF + c0 + j]; bb[j] = cb[c0 + j]; am2[j] = 0.f; am1[j] = 0.f; }
    if (t0 >= 2) {
      const u32x4 v2 = *(const u32x4*)(Aup + (size_t)(t0 - 2) * DFF + c0), v1 = *(const u32x4*)(Aup + (size_t)(t0 - 1) * DFF + c0);
#pragma unroll
      for (int j = 0; j < 4; ++j) { am2[2 * j] = bflo(v2[j]); am2[2 * j + 1] = bfhi(v2[j]); am1[2 * j] = bflo(v1[j]); am1[2 * j + 1] = bfhi(v1[j]); }
    }
    for (int t = t0; t < t0 + RUN; ++t) {
      const u32x4 va = *(const u32x4*)(Aup + (size_t)t * DFF + c0);
      const u32x4 vb = *(const u32x4*)(Bup + (size_t)t * DFF + c0);
      float ac[8], bv[8], y[8];
#pragma unroll
      for (int j = 0; j < 4; ++j) { ac[2 * j] = bflo(va[j]); ac[2 * j + 1] = bfhi(va[j]); bv[2 * j] = bflo(vb[j]); bv[2 * j + 1] = bfhi(vb[j]); }
#pragma unroll
      for (int j = 0; j < 8; ++j) {
        const float a = w0[j] * am2[j] + w1[j] * am1[j] + w2[j] * ac[j] + bb[j];
        const float uu = 0.7978845608028654f * (a + 0.044715f * a * a * a);
        const float th = 1.0f - 2.0f / (1.0f + __expf(2.0f * uu));
        y[j] = 0.5f * a * (1.0f + th) * bv[j];
        am2[j] = am1[j]; am1[j] = ac[j];
      }
      u32x4 w = {pk_bf16(y[0], y[1]), pk_bf16(y[2], y[3]), pk_bf16(y[4], y[5]), pk_bf16(y[6], y[7])};
      *(u32x4*)(Bup + (size_t)t * DFF + c0) = w;
    }
  }
}


#define XB_TMO      128
#define XB_XCNT(j)  (256  + 64 * (j))
#define XB_XSUB(j)  (1280 + 64 * (j))
#define XB_XGEN(j)  (2304 + 64 * (j))
#define XB_TOP      3328
#define XB_TOPGEN   3392
#define XCD_BAR_WORDS 3456
#define XB_SPIN_CAP (1u << 18)
DI unsigned xb_ld(unsigned* p) { return __hip_atomic_load(p, __ATOMIC_RELAXED, __HIP_MEMORY_SCOPE_AGENT); }
DI unsigned xb_add(unsigned* p, unsigned v) { return __hip_atomic_fetch_add(p, v, __ATOMIC_RELAXED, __HIP_MEMORY_SCOPE_AGENT); }
DI unsigned xb_xcc_id() { return (unsigned)__builtin_amdgcn_s_getreg((3 << 11) | 20) & 0xFu; }
#define XB_SPIN(cond, bar) do { unsigned _sp = 0; while (cond) { __builtin_amdgcn_s_sleep(1); \
    if ((++_sp & 255u) == 0u) { if (xb_ld(&(bar)[XB_TMO])) break; if (_sp > XB_SPIN_CAP) { atomicAdd(&(bar)[XB_TMO], 1u); break; } } } } while (0)
DI void xcd_barrier_complete(unsigned* bar, unsigned x, unsigned& nloc, unsigned& nx) {
  const unsigned G = gridDim.x;
  unsigned sum, cnt, mine, sp = 0u;
  for (;;) {
    sum = 0u; cnt = 0u; mine = 0u;
#pragma unroll
    for (unsigned j = 0; j < 16; ++j) { const unsigned c = xb_ld(&bar[XB_XCNT(j)]); sum += c; cnt += (c > 0u) ? 1u : 0u; mine = (j == x) ? c : mine; }
    if (sum == G) break;
    __builtin_amdgcn_s_sleep(1);
    if ((++sp & 255u) == 0u) { if (xb_ld(&bar[XB_TMO])) break; if (sp > XB_SPIN_CAP) { atomicAdd(&bar[XB_TMO], 1u); break; } }
  }
  nloc = mine > 0u ? mine : 1u; nx = cnt > 0u ? cnt : 1u;
}
__device__ __forceinline__ void xcd_barrier(unsigned* bar, volatile LAS unsigned* st) {
  asm volatile("s_waitcnt vmcnt(0)" ::: "memory");
  __syncthreads();
  if (threadIdx.x == 0) {
    const unsigned x = xb_xcc_id();
    __builtin_amdgcn_s_waitcnt(0);
    unsigned nloc = st[0], nx = st[1];
    if (nloc == 0u) { xcd_barrier_complete(bar, x, nloc, nx); st[0] = nloc; st[1] = nx; }
    const unsigned old = xb_add(&bar[XB_XSUB(x)], 1u);
    const unsigned gen = old / nloc;
    if (old + 1u == (gen + 1u) * nloc) {
      __builtin_amdgcn_fence(__ATOMIC_RELEASE, "agent");
      asm volatile("s_waitcnt vmcnt(0)" ::: "memory");
      const unsigned og = xb_add(&bar[XB_TOP], 1u);
      const unsigned tg = og / nx;
      if (og + 1u == (tg + 1u) * nx) xb_add(&bar[XB_TOPGEN], 1u);
      else XB_SPIN(xb_ld(&bar[XB_TOPGEN]) == tg, bar);
      __builtin_amdgcn_fence(__ATOMIC_ACQUIRE, "agent");
      xb_add(&bar[XB_XGEN(x)], 1u);
      asm volatile("s_waitcnt vmcnt(0)" ::: "memory");
    } else {
      XB_SPIN(xb_ld(&bar[XB_XGEN(x)]) == gen, bar);
      __builtin_amdgcn_fence(__ATOMIC_ACQUIRE, "agent");
      asm volatile("s_waitcnt vmcnt(0)" ::: "memory");
    }
  }
  __syncthreads();
}
__global__ void __launch_bounds__(NT, 2) mega(Params p) {
  cg::grid_group grid = cg::this_grid();
  extern __shared__ __attribute__((aligned(16))) unsigned char lds_all[];
  volatile LAS unsigned* xb_st = (volatile LAS unsigned*)((LAS unsigned char*)lds_all + (LDS_BYTES - 16));
  unsigned* xb_bar = (unsigned*)(p.ws + WS_BAR);
  if (threadIdx.x == 0) { xb_st[0] = 0u; xb_st[1] = 0u; (void)xb_add(&xb_bar[XB_XCNT(xb_xcc_id())], 1u); }
  __syncthreads();
  const int g_wave64 = __builtin_amdgcn_readfirstlane((int)threadIdx.x & ~63);
  unsigned char* ws = p.ws;
  bf16_t* H = (bf16_t*)(ws + WS_H);
#ifndef PH
#define PH -1
#endif
#define ON(k) (PH < 0 || PH == (k))
  if (ON(0)) { p0_norm_ga(p, g_wave64); }
  if (ON(1)) { p0_transposes(p, g_wave64); }
  if (p.ws == nullptr) grid.sync();
  xcd_barrier(xb_bar, xb_st);
  if (ON(2)) {
  gemm_phase<false, SEQ, 4096, DM, 4096, 1 << 20>(H, (const bf16_t*)(ws + WS_WIN), ws + WS_PROJ, ws + WS_PROJ, g_wave64);
  gemm_phase<false, 2048, SEQ, DM, SEQ, 1 << 20>((const bf16_t*)(ws + WS_WV), H, ws + WS_VT, ws + WS_VT, g_wave64);
  }
  xcd_barrier(xb_bar, xb_st);
  if (ON(3)) { attn_norms(p, g_wave64); gla_g1(p, g_wave64); }
  xcd_barrier(xb_bar, xb_st);
  if (ON(4)) gla_g2(p, g_wave64);
  xcd_barrier(xb_bar, xb_st);
  if (ON(5)) gla_g3(p, g_wave64);
  if (ON(6)) { attn_phase(p, g_wave64); xcd_barrier(xb_bar, xb_st); attn_combine(p, g_wave64); }
  xcd_barrier(xb_bar, xb_st);
  if (ON(7)) gemm_phase<false, SEQ, DM, DM, DM, 1 << 20>((const bf16_t*)(ws + WS_O), (const bf16_t*)(ws + WS_WO), ws + WS_M, ws + WS_M, g_wave64);
  xcd_barrier(xb_bar, xb_st);
  if (ON(8)) p6_post_attn(p, g_wave64);
  xcd_barrier(xb_bar, xb_st);
  if (ON(2)) gemm_phase<false, SEQ, 2 * DFF, DM, DFF, 1 << 20, 2>(H, (const bf16_t*)(ws + WS_WFI), ws + WS_BUP, ws + WS_BUP, g_wave64,
                                                                ConvEpi{p.in[15], p.in[16], (float*)(ws + WS_SA0), (float*)(ws + WS_SB0), (float*)(ws + WS_SAL)});
  xcd_barrier(xb_bar, xb_st);
  if (ON(9)) p8_fixup(p, g_wave64);
  if (ON(7)) gemm_phase<false, SEQ, DM, DFF, DM, 1 << 20>((const bf16_t*)(ws + WS_BUP), (const bf16_t*)(ws + WS_WFO), ws + WS_F, ws + WS_F, g_wave64);
  xcd_barrier(xb_bar, xb_st);
  if (ON(10)) p10_final(p, g_wave64);
}

extern "C" void kernel_launch(void* const* d_in, const int* in_sizes, int n_in, void* d_out, int out_size, void* d_ws, size_t ws_size,
                              hipStream_t stream) {
  static int grid_blocks = 0;
  if (!grid_blocks) {
    int dev = 0, cus = 0, per_cu = 0;
    hipGetDevice(&dev);
    hipDeviceGetAttribute(&cus, hipDeviceAttributeMultiprocessorCount, dev);
    hipFuncSetAttribute((const void*)mega, hipFuncAttributeMaxDynamicSharedMemorySize, LDS_BYTES);
    hipOccupancyMaxActiveBlocksPerMultiprocessor(&per_cu, (const void*)mega, NT, LDS_BYTES);
    (void)hipGetLastError();
    if (per_cu < 1) per_cu = 1;
    grid_blocks = 256;
    if (cus != 256) fprintf(stderr, "kernel_launch: built for 256 CUs, device reports %d\n", cus);
    if (ws_size < WS_END2) fprintf(stderr, "kernel_launch: workspace too small: %zu < %zu\n", ws_size, (size_t)WS_END);
  }
  Params p{};
  for (int i = 0; i < 19; ++i) p.in[i] = (const float*)d_in[i];
  p.out = (float*)d_out; p.ws = (unsigned char*)d_ws;
  (void)hipMemsetAsync((unsigned char*)d_ws + WS_BAR, 0, 16384 + 128, stream);
  void* args[] = {&p};
  hipError_t e = hipLaunchCooperativeKernel((const void*)mega, dim3(grid_blocks), dim3(NT), args, LDS_BYTES, stream);
  if (e != hipSuccess) fprintf(stderr, "cooperative launch failed: %s (grid %d)\n", hipGetErrorString(e), grid_blocks);
}
```

```cpp
#include <hip/hip_runtime.h>
#include <hip/hip_cooperative_groups.h>
#include <cstdio>
#include <cstdint>
namespace cg = cooperative_groups;

typedef unsigned short bf16_t;
typedef short bf16x8 __attribute__((ext_vector_type(8)));
typedef float f32x2 __attribute__((ext_vector_type(2)));
typedef float f32x4 __attribute__((ext_vector_type(4)));
typedef float f32x16 __attribute__((ext_vector_type(16)));
typedef unsigned u32x2 __attribute__((ext_vector_type(2)));
typedef unsigned u32x4 __attribute__((ext_vector_type(4)));
typedef __bf16 bf2_t __attribute__((ext_vector_type(2)));

#define DI __device__ __forceinline__
#define OPAQUE_TID(t) int t; asm volatile("v_mbcnt_lo_u32_b32 %0, -1, 0\n\tv_mbcnt_hi_u32_b32 %0, -1, %0\n\tv_add_u32 %0, %1, %0" : "=&v"(t) : "s"(g_wave64))
#define LAS __attribute__((address_space(3)))
#define LDSP(p) ((LAS unsigned*)(p))

constexpr int SEQ = 16384, DM = 2048, DFF = 5632, INC = 6160;
#ifndef OVH
#define OVH 6
#endif
#ifndef KR
#define KR 6
#endif
#ifndef VR
#define VR 8
#endif
constexpr int NT = 512;
constexpr int LDS_BYTES = 147456;
constexpr float EPS = 1e-6f;
constexpr float LOG2E = 1.4426950408889634f;

constexpr size_t MB = 1048576;
constexpr size_t WS_BAR = 1 * MB + 768 * 1024, WS_NRM = WS_BAR + 16384, WS_ML = 484 * MB, WS_SA0 = 486 * MB, WS_SB0 = 489 * MB, WS_SAL = 492 * MB, WS_END2 = 495 * MB;
constexpr size_t WS_GA = 0, WS_GDEC = 1 * MB, WS_WFI = 2 * MB, WS_WFO = 46 * MB, WS_H = 68 * MB, WS_R = 132 * MB;
constexpr size_t WS_WIN = WS_R, WS_WV = WS_R + 16 * MB, WS_WO = WS_R + 24 * MB, WS_PROJ = WS_R + 32 * MB, WS_VT = WS_R + 160 * MB,
                 WS_O = WS_R + 224 * MB, WS_PART2 = WS_R + 288 * MB, WS_M = WS_PROJ, WS_AUP = WS_R, WS_BUP = WS_R + 176 * MB, WS_F = WS_R + 96 * MB, WS_END = WS_R + 352 * MB;

struct Params { const float* in[19]; float* out; unsigned char* ws; };

DI unsigned pk_bf16(float lo, float hi) { f32x2 v = {lo, hi}; bf2_t r = __builtin_convertvector(v, bf2_t); return __builtin_bit_cast(unsigned, r); }
DI float bf2f(bf16_t u) { return __uint_as_float(((unsigned)u) << 16); }
DI float bflo(unsigned u) { return __uint_as_float(u << 16); }
DI float bfhi(unsigned u) { return __uint_as_float(u & 0xffff0000u); }
DI f32x16 mfma32(bf16x8 a, bf16x8 b, f32x16 c) { return __builtin_amdgcn_mfma_f32_32x32x16_bf16(a, b, c, 0, 0, 0); }
DI float shx(float v, const int mask, const int lane) { return __builtin_bit_cast(float, __builtin_amdgcn_ds_bpermute((lane ^ mask) << 2, __builtin_bit_cast(int, v))); }
DI float wave_sum_l(float v, const int lane) { for (int o = 32; o > 0; o >>= 1) v += __builtin_bit_cast(float, __builtin_amdgcn_ds_bpermute((lane ^ o) << 2, __builtin_bit_cast(int, v))); return v; }
DI float wave_sum(float v) { for (int o = 32; o > 0; o >>= 1) v += __shfl_xor(v, o); return v; }
DI bf16x8 pack8(float a0, float a1, float a2, float a3, float a4, float a5, float a6, float a7) {
  u32x4 p = {pk_bf16(a0, a1), pk_bf16(a2, a3), pk_bf16(a4, a5), pk_bf16(a6, a7)}; return __builtin_bit_cast(bf16x8, p);
}
DI int perm32(int rho) { const int n = rho >> 4, i = rho & 15; return 8 * (i >> 2) + 4 * n + (i & 3); }
DI float* part_slot(const Params& p, const int slot) { return slot < 256 ? p.out + (size_t)slot * 65536 : (float*)(p.ws + WS_PART2) + (size_t)(slot - 256) * 65536; }
DI int perm23(int r) { return (r & ~12) | ((r & 4) << 1) | ((r & 8) >> 1); }

constexpr int BM = 256, BK = 64, HALF = 128, HT = HALF * BK, NXCD = 8, WGM = 8;
DI int lds_byte(int r, int c) { int st = (r >> 4) * 2 + (c >> 5), rr = r & 15, cc = c & 31, ob = rr * 64 + cc * 2; return st * 1024 + (ob ^ (((ob >> 9) & 1) << 5)); }
DI void stage_rc(int b, int& R, int& C) { int st = b / 1024, sb = b % 1024, swz = sb ^ (((sb >> 9) & 1) << 5); R = (st >> 1) * 16 + swz / 64; C = (st & 1) * 32 + (swz % 64) / 2; }

struct ConvEpi { const float* cw; const float* cb; float* sa0; float* sb0; float* sal; };
template <bool OUT_F32, int M, int N, int K, int ldc, int split_pn, int EPI = 0>
__device__ __forceinline__ void gemm_phase(const bf16_t* __restrict__ A, const bf16_t* __restrict__ Bt, void* out0, void* out1, const int g_wave64, const ConvEpi ce = ConvEpi{}) {
  OPAQUE_TID(tidx);
  extern __shared__ __attribute__((aligned(16))) unsigned char shm_raw[];
  LAS unsigned char* ldsb = (LAS unsigned char*)shm_raw;
#define SA(b, h) (((b) * 2 + (h)) * (HT * 2))
#define SB(b, h) ((4 + (b) * 2 + (h)) * (HT * 2))
#define STAGE(P, BASE, br, kt) do { const char* _gb = (const char*)(BASE) + ((size_t)(br) * K + (size_t)(kt) * BK) * 2; \
      __builtin_amdgcn_global_load_lds((const unsigned*)(_gb + so0), (LAS unsigned*)(ldsb + (P) + ldsw), 16, 0, 0); \
      __builtin_amdgcn_global_load_lds((const unsigned*)(_gb + so1), (LAS unsigned*)(ldsb + (P) + ldsw + 8192), 16, 0, 0); } while (0)
#define STAGEB(P, BASE, br, kt) do { const char* _gb = (const char*)(BASE) + ((size_t)(br) * K + (size_t)(kt) * BK) * 2; \
      __builtin_amdgcn_global_load_lds((const unsigned*)(_gb + sb0), (LAS unsigned*)(ldsb + (P) + ldsw), 16, 0, 0); \
      __builtin_amdgcn_global_load_lds((const unsigned*)(_gb + sb1), (LAS unsigned*)(ldsb + (P) + ldsw + 8192), 16, 0, 0); } while (0)
#define LDA(dst, b, h) _Pragma("unroll") for (int m = 0; m < 4; ++m) _Pragma("unroll") for (int k = 0; k < 2; ++k) \
    dst[m][k] = *(const LAS bf16x8*)(ldsb + SA(b, h) + aoff + m * 2048 + k * 1024)
#define LDB(dst, b, h) _Pragma("unroll") for (int n = 0; n < 2; ++n) _Pragma("unroll") for (int k = 0; k < 2; ++k) \
    dst[n][k] = *(const LAS bf16x8*)(ldsb + SB(b, h) + boff + n * 2048 + k * 1024)
#define MMA(ai, bj, At, Bq) do { __builtin_amdgcn_s_setprio(1); \
    _Pragma("unroll") for (int m = 0; m < 4; ++m) _Pragma("unroll") for (int n = 0; n < 2; ++n) _Pragma("unroll") for (int k = 0; k < 2; ++k) \
      acc[ai][bj][m][n] = __builtin_amdgcn_mfma_f32_16x16x32_bf16(Bq[n][k], At[m][k], acc[ai][bj][m][n], 0, 0, 0); \
    __builtin_amdgcn_s_setprio(0); } while (0)
#define WAIT_V(n) asm volatile("s_waitcnt vmcnt(" #n ")" ::: "memory")
#define WAIT_L(n) asm volatile("s_waitcnt lgkmcnt(" #n ")" ::: "memory")
#define BAR __builtin_amdgcn_s_barrier()
#define SCHED __builtin_amdgcn_sched_barrier(0)
  const int nM = M / BM, nN = N / BM, nwg = nM * nN;
  const int wid = __builtin_amdgcn_readfirstlane(tidx >> 6), lane = tidx & 63, wr = wid >> 2, wc = wid & 3, fr = lane & 15, fq = lane >> 4;
  constexpr int nt = K / BK;
  unsigned so0, so1, sb0, sb1;
  { int _r, _c; stage_rc(tidx * 16, _r, _c); so0 = (unsigned)(_r * K + _c) * 2u; sb0 = (unsigned)(((_r & ~31) + perm32(_r & 31)) * K + _c) * 2u;
    stage_rc(tidx * 16 + 8192, _r, _c); so1 = (unsigned)(_r * K + _c) * 2u; sb1 = (unsigned)(((_r & ~31) + perm32(_r & 31)) * K + _c) * 2u; }
  const unsigned ldsw = (unsigned)wid * 1024u;
  const int aoff = lds_byte(wr * 64 + fr, fq * 8), boff = lds_byte(wc * 32 + fr, fq * 8);
#define UNIT_OF(L, PM, PN) do { int _w = (L); { const int _q = nwg / NXCD, _r = nwg % NXCD, _x = _w % NXCD, _o = _w / NXCD; _w = (_x < _r ? _x * (_q + 1) : _r * (_q + 1) + (_x - _r) * _q) + _o; } \
    const int _nig = WGM * nN, _gid = _w / _nig, _fm = _gid * WGM, _gsz = min(nM - _fm, WGM); PM = _fm + ((_w % _nig) % _gsz); PN = (_w % _nig) / _gsz; } while (0)
  if ((int)blockIdx.x < nwg) {
    int pm, pn; UNIT_OF((int)blockIdx.x, pm, pn);
    int brow = pm * BM, bcol = pn * BM;
    __syncthreads();
    f32x4 acc[2][2][4][2] = {};
    bf16x8 At[4][2], B0[2][2], B1[2][2];
    STAGEB(SB(0, 0), Bt, bcol, 0); STAGEB(SB(0, 1), Bt, bcol + HALF, 0); STAGE(SA(0, 0), A, brow, 0); STAGE(SA(0, 1), A, brow + HALF, 0);
    if (wr == 1) BAR;
    WAIT_V(2); BAR;
    STAGEB(SB(1, 0), Bt, bcol, 1); STAGE(SA(1, 0), A, brow, 1); STAGEB(SB(1, 1), Bt, bcol + HALF, 1);
    WAIT_V(6); BAR;
    for (int it = 0;; ++it) {
      const int Ln = (it + 1) * (int)gridDim.x + (int)blockIdx.x;
      const bool has_next = Ln < nwg;
      int npm = pm, npn = pn; if (has_next) UNIT_OF(Ln, npm, npn);
      const int nbrow = npm * BM, nbcol = npn * BM;
      for (int t = 0; t < nt; t += 2) {
        const bool last = (t == nt - 2);
        const int r2 = last ? nbrow : brow, c2 = last ? nbcol : bcol, k2 = last ? 0 : t + 2, k3 = k2 + 1;
        LDB(B0, 0, 0); LDB(B1, 0, 1); SCHED; LDA(At, 0, 0); STAGE(SA(1, 1), A, brow + HALF, t + 1);
        WAIT_V(8); WAIT_L(0); BAR; MMA(0, 0, At, B0); MMA(0, 1, At, B1); BAR; SCHED;
        LDA(At, 0, 1); STAGEB(SB(0, 0), Bt, c2, k2); STAGEB(SB(0, 1), Bt, c2 + HALF, k2); STAGE(SA(0, 0), A, r2, k2);
        WAIT_V(8); WAIT_L(0); BAR; MMA(1, 0, At, B0); MMA(1, 1, At, B1); BAR; SCHED;
        LDB(B0, 1, 0); LDB(B1, 1, 1); SCHED; LDA(At, 1, 0); STAGE(SA(0, 1), A, r2 + HALF, k2);
        WAIT_V(8); WAIT_L(0); BAR; MMA(0, 0, At, B0); MMA(0, 1, At, B1); BAR; SCHED;
        LDA(At, 1, 1); STAGEB(SB(1, 0), Bt, c2, k3); STAGEB(SB(1, 1), Bt, c2 + HALF, k3); STAGE(SA(1, 0), A, r2, k3);
        WAIT_V(8); WAIT_L(0); BAR; MMA(1, 0, At, B0); MMA(1, 1, At, B1); BAR; SCHED;
      }
      if (wr == 0) BAR;
      if constexpr (EPI == 2) {
        LAS float* halo = (LAS float*)(ldsb + 133120);
        const int cl = wc * 32 + fq * 8;
        float w0[8], w1[8], w2[8], cbv[8];
        {
          const float* wp = ce.cw + 128 * pn + cl; const float* bp = ce.cb + 128 * pn + cl;
#pragma unroll
          for (int x4 = 0; x4 < 2; ++x4) { const f32x4 a0 = *(const f32x4*)(wp + 4 * x4), a1 = *(const f32x4*)(wp + DFF + 4 * x4), a2 = *(const f32x4*)(wp + 2 * DFF + 4 * x4), a3 = *(const f32x4*)(bp + 4 * x4);
#pragma unroll
            for (int j = 0; j < 4; ++j) { w0[x4 * 4 + j] = a0[j]; w1[x4 * 4 + j] = a1[j]; w2[x4 * 4 + j] = a2[j]; cbv[x4 * 4 + j] = a3[j]; } }
        }
        if (fr >= 14) {
#pragma unroll
          for (int ai = 0; ai < 2; ++ai) { LAS float* hp = halo + ((ai * 2 + wr) * 2 + (fr - 14)) * 128 + cl; *(LAS f32x4*)hp = acc[ai][0][3][0]; *(LAS f32x4*)(hp + 4) = acc[ai][0][3][1]; }
          if (wr == 1) { float* sp = ce.sal + ((size_t)pm * 2 + (fr - 14)) * DFF + 128 * pn + cl; *(f32x4*)sp = acc[1][0][3][0]; *(f32x4*)(sp + 4) = acc[1][0][3][1]; }
        }
        if (wr == 0 && fr < 2) {
          float* sp = ce.sa0 + ((size_t)pm * 2 + fr) * DFF + 128 * pn + cl; *(f32x4*)sp = acc[0][0][0][0]; *(f32x4*)(sp + 4) = acc[0][0][0][1];
          float* sq = ce.sb0 + ((size_t)pm * 2 + fr) * DFF + 128 * pn + cl; *(f32x4*)sq = acc[0][1][0][0]; *(f32x4*)(sq + 4) = acc[0][1][0][1];
        }
        WAIT_L(0); BAR;
        bf16_t* gp = (bf16_t*)out0 + (size_t)(brow + wr * 64 + fr) * DFF + 128 * pn + cl;
#pragma unroll
        for (int ai = 0; ai < 2; ++ai) {
          const int blk = ai * 2 + wr;
          float h62[8], h63[8];
          if (blk > 0) {
            const LAS float* hq = halo + ((blk - 1) * 2) * 128 + cl;
            const f32x4 q0 = *(const LAS f32x4*)hq, q1 = *(const LAS f32x4*)(hq + 4), q2 = *(const LAS f32x4*)(hq + 128), q3 = *(const LAS f32x4*)(hq + 132);
#pragma unroll
            for (int j = 0; j < 4; ++j) { h62[j] = q0[j]; h62[4 + j] = q1[j]; h63[j] = q2[j]; h63[4 + j] = q3[j]; }
          } else {
#pragma unroll
            for (int j = 0; j < 8; ++j) { h62[j] = 0.f; h63[j] = 0.f; }
          }
#pragma unroll
          for (int m = 0; m < 4; ++m) {
            float gv[8];
#pragma unroll
            for (int x = 0; x < 8; ++x) {
              const float cur = acc[ai][0][m][x >> 2][x & 3], bb = acc[ai][1][m][x >> 2][x & 3];
              int o1, o2;
              if (m == 0) { o1 = __float_as_int(h63[x]); o2 = __float_as_int(fr == 0 ? h62[x] : h63[x]); }
              else { const int pv = __float_as_int(acc[ai][0][m - 1][x >> 2][x & 3]);
                     o1 = __builtin_amdgcn_update_dpp(pv, pv, 0x121, 0xf, 0xf, false); o2 = __builtin_amdgcn_update_dpp(pv, pv, 0x122, 0xf, 0xf, false); }
              const float a1 = __int_as_float(__builtin_amdgcn_update_dpp(o1, __float_as_int(cur), 0x111, 0xf, 0xf, false));
              const float a2 = __int_as_float(__builtin_amdgcn_update_dpp(o2, __float_as_int(cur), 0x112, 0xf, 0xf, false));
              const float y = w0[x] * a2 + w1[x] * a1 + w2[x] * cur + cbv[x];
              const float e = __builtin_amdgcn_exp2f(-2.302208198f * (y + 0.044715f * y * y * y));
              gv[x] = y * __builtin_amdgcn_rcpf(1.0f + e) * bb;
            }
            if (!(blk == 0 && m == 0 && fr < 2)) {
              u32x4 w = {pk_bf16(gv[0], gv[1]), pk_bf16(gv[2], gv[3]), pk_bf16(gv[4], gv[5]), pk_bf16(gv[6], gv[7])};
              *(u32x4*)(gp + (size_t)(ai * HALF + m * 16) * DFF) = w;
            }
          }
        }
#pragma unroll
        for (int ai = 0; ai < 2; ++ai)
#pragma unroll
          for (int bj = 0; bj < 2; ++bj)
#pragma unroll
            for (int m = 0; m < 4; ++m) { acc[ai][bj][m][0] = (f32x4){0.f, 0.f, 0.f, 0.f}; acc[ai][bj][m][1] = (f32x4){0.f, 0.f, 0.f, 0.f}; }
      } else {
      constexpr int ES = OUT_F32 ? 4 : 2;
      char* rp = (char*)((pn < split_pn) ? out0 : out1) +
                 ((size_t)(brow + wr * 64 + fr) * ldc + (size_t)(((pn < split_pn) ? bcol : bcol - split_pn * BM) + wc * 32 + fq * 8)) * ES;
#pragma unroll
      for (int ai = 0; ai < 2; ++ai) {
#pragma unroll
        for (int m = 0; m < 4; ++m) {
#pragma unroll
          for (int bj = 0; bj < 2; ++bj) {
            const f32x4 v0 = acc[ai][bj][m][0], v1 = acc[ai][bj][m][1];
            if (OUT_F32) { *(f32x4*)(rp + (bj * HALF) * ES) = v0; *(f32x4*)(rp + (bj * HALF + 4) * ES) = v1; }
            else { u32x4 w = {pk_bf16(v0[0], v0[1]), pk_bf16(v0[2], v0[3]), pk_bf16(v1[0], v1[1]), pk_bf16(v1[2], v1[3])}; *(u32x4*)(rp + (bj * HALF) * ES) = w; }
            acc[ai][bj][m][0] = (f32x4){0.f, 0.f, 0.f, 0.f}; acc[ai][bj][m][1] = (f32x4){0.f, 0.f, 0.f, 0.f};
          }
          rp += (size_t)16 * ldc * ES;
          asm volatile("" : "+v"(rp));
        }
        rp += (size_t)(HALF - 64) * ldc * ES;
      }
      }
      if (!has_next) break;
      pm = npm; pn = npn; brow = nbrow; bcol = nbcol;
      if (wr == 1) BAR;
    }
    WAIT_V(0);
    BAR;
  }
#undef UNIT_OF
  __syncthreads();
#undef SA
#undef SB
#undef STAGE
#undef STAGEB
#undef LDA
#undef LDB
#undef MMA
}

__device__ __forceinline__ void p0_norm_ga(const Params& p, const int g_wave64) {
  extern __shared__ __attribute__((aligned(16))) float ldsf[];
  const float* x = p.in[0]; const float* g = p.in[1]; const float* w_in = p.in[2];
  bf16_t* H = (bf16_t*)(p.ws + WS_H); float* GA = (float*)(p.ws + WS_GA);
  OPAQUE_TID(tid); const int lane = tid & 63, wave = tid >> 6;
  {
    float wtmp[64];
#pragma unroll
    for (int i = 0; i < 64; ++i) { const int idx = tid + NT * i; wtmp[i] = w_in[(size_t)(idx >> 4) * INC + 3072 + (idx & 15)]; }
#pragma unroll
    for (int i = 0; i < 64; ++i) { const int idx = tid + NT * i; ldsf[(idx & 15) * 2052 + (idx >> 4)] = wtmp[i]; }
  }
  __syncthreads();
  for (int rb = blockIdx.x; rb < SEQ / 64; rb += gridDim.x) {
    for (int rp = 0; rp < 4; ++rp) {
      const int row0 = rb * 64 + wave * 8 + rp * 2;
      f32x4 xv[2][8];
#pragma unroll
      for (int q = 0; q < 2; ++q)
#pragma unroll
        for (int ii = 0; ii < 8; ++ii) xv[q][ii] = *(const f32x4*)(x + (size_t)(row0 + q) * DM + ii * 256 + lane * 4);
      float rs[2];
#pragma unroll
      for (int q = 0; q < 2; ++q) {
        float s = 0.f;
#pragma unroll
        for (int ii = 0; ii < 8; ++ii) s += xv[q][ii][0] * xv[q][ii][0] + xv[q][ii][1] * xv[q][ii][1] + xv[q][ii][2] * xv[q][ii][2] + xv[q][ii][3] * xv[q][ii][3];
        s = wave_sum_l(s, lane); rs[q] = rsqrtf(s * (1.0f / DM) + EPS);
      }
#pragma unroll
      for (int ii = 0; ii < 8; ++ii) {
        const f32x4 gv = *(const f32x4*)(g + ii * 256 + lane * 4);
#pragma unroll
        for (int q = 0; q < 2; ++q) {
          xv[q][ii] = xv[q][ii] * rs[q] * gv;
          u32x2 w = {pk_bf16(xv[q][ii][0], xv[q][ii][1]), pk_bf16(xv[q][ii][2], xv[q][ii][3])};
          *(u32x2*)(H + (size_t)(row0 + q) * DM + ii * 256 + lane * 4) = w;
        }
      }
      float a0[16], a1[16];
#pragma unroll
      for (int j = 0; j < 16; ++j) {
        float s0 = 0.f, s1 = 0.f;
#pragma unroll
        for (int ii = 0; ii < 8; ++ii) {
          const f32x4 wv = *(const f32x4*)(ldsf + j * 2052 + ii * 256 + lane * 4);
          s0 += xv[0][ii][0] * wv[0] + xv[0][ii][1] * wv[1] + xv[0][ii][2] * wv[2] + xv[0][ii][3] * wv[3];
          s1 += xv[1][ii][0] * wv[0] + xv[1][ii][1] * wv[1] + xv[1][ii][2] * wv[2] + xv[1][ii][3] * wv[3];
        }
        a0[j] = s0; a1[j] = s1;
        asm volatile("" : "+v"(a0[j]), "+v"(a1[j]) :: "memory");
      }
#define BFLY(N, MASK) _Pragma("unroll") for (int i = 0; i < (N) / 2; ++i) { const bool up = (lane & (MASK)) != 0; \
        const float sd0 = up ? a0[i] : a0[i + (N) / 2], kp0 = up ? a0[i + (N) / 2] : a0[i]; a0[i] = kp0 + shx(sd0, (MASK), lane); \
        const float sd1 = up ? a1[i] : a1[i + (N) / 2], kp1 = up ? a1[i + (N) / 2] : a1[i]; a1[i] = kp1 + shx(sd1, (MASK), lane); }
      BFLY(16, 32) BFLY(8, 16) BFLY(4, 8) BFLY(2, 4)
#undef BFLY
      float g0 = a0[0], g1 = a1[0];
      g0 += shx(g0, 2, lane); g1 += shx(g1, 2, lane);
      g0 += shx(g0, 1, lane); g1 += shx(g1, 1, lane);
      if ((lane & 3) == 0) { const int j = ((lane >> 5) & 1) * 8 + ((lane >> 4) & 1) * 4 + ((lane >> 3) & 1) * 2 + ((lane >> 2) & 1); GA[(size_t)row0 * 16 + j] = g0; GA[(size_t)(row0 + 1) * 16 + j] = g1; }
    }
  }
  __syncthreads();
}

struct TSeg { const float* src; int ld, col0, ncols, K; bf16_t* dst; };
__device__ __forceinline__ void p0_transposes(const Params& p, const int g_wave64) {
  extern __shared__ __attribute__((aligned(16))) float ldsf[];
  OPAQUE_TID(tid);
  const int ntile[8] = {32 * 16, 32 * 16, 32 * 32, 32 * 16, 32 * 16, 32 * 32, 32 * 176, 88 * 32};
  int total = 0;
  for (int i = 0; i < 8; ++i) total += ntile[i];
  const int lane = tid & 63, wave = __builtin_amdgcn_readfirstlane(tid >> 6);
  for (int tix = blockIdx.x * 8 + wave; tix < total; tix += gridDim.x * 8) {
    int s = 0, rem = tix;
    while (rem >= ntile[s]) { rem -= ntile[s]; ++s; }
    const float* src; int ld, col0, nct, K; bf16_t* dst;
    bf16_t* WinT = (bf16_t*)(p.ws + WS_WIN); bf16_t* WvT = (bf16_t*)(p.ws + WS_WV);
    switch (s) {
      case 0: src = p.in[2]; ld = INC; col0 = 0; nct = 16; K = 2048; dst = WinT; break;
      case 1: src = p.in[2]; ld = INC; col0 = 2048; nct = 16; K = 2048; dst = WinT + (size_t)1024 * 2048; break;
      case 2: src = p.in[2]; ld = INC; col0 = 3088; nct = 32; K = 2048; dst = WinT + (size_t)2048 * 2048; break;
      case 3: src = p.in[2]; ld = INC; col0 = 1024; nct = 16; K = 2048; dst = WvT; break;
      case 4: src = p.in[2]; ld = INC; col0 = 5136; nct = 16; K = 2048; dst = WvT + (size_t)1024 * 2048; break;
      case 5: src = p.in[11]; ld = 2048; col0 = 0; nct = 32; K = 2048; dst = (bf16_t*)(p.ws + WS_WO); break;
      case 6: src = p.in[14]; ld = 2 * DFF; col0 = 0; nct = 176; K = 2048; dst = (bf16_t*)(p.ws + WS_WFI); break;
      default: src = p.in[17]; ld = 2048; col0 = 0; nct = 32; K = DFF; dst = (bf16_t*)(p.ws + WS_WFO); break;
    }
    const int kt = rem / nct, ct = rem % nct;
    float* t = ldsf + wave * (64 * 65);
    f32x4 v[16];
#pragma unroll
    for (int i = 0; i < 16; ++i) v[i] = *(const f32x4*)(src + (size_t)(kt * 64 + i * 4 + (lane >> 4)) * ld + col0 + ct * 64 + (lane & 15) * 4);
#pragma unroll
    for (int i = 0; i < 16; ++i) { float* tp = t + (i * 4 + (lane >> 4)) * 65 + (lane & 15) * 4; tp[0] = v[i][0]; tp[1] = v[i][1]; tp[2] = v[i][2]; tp[3] = v[i][3]; }
    asm volatile("s_waitcnt lgkmcnt(0)" ::: "memory");
#pragma unroll
    for (int i = 0; i < 8; ++i) {
      const int nl = (lane >> 3) + 8 * i, kl = (lane & 7) * 8;
      const float* tp = t + kl * 65 + nl;
      u32x4 w = {pk_bf16(tp[0], tp[65]), pk_bf16(tp[130], tp[195]), pk_bf16(tp[260], tp[325]), pk_bf16(tp[390], tp[455])};
      int drow0 = ct * 64;
      if (s == 6) drow0 = (ct < 88) ? 256 * (ct >> 1) + 64 * (ct & 1) : 256 * ((ct - 88) >> 1) + 128 + 64 * ((ct - 88) & 1);
      *(u32x4*)(dst + (size_t)(drow0 + nl) * K + kt * 64 + kl) = w;
    }
    asm volatile("s_waitcnt lgkmcnt(0)" ::: "memory");
  }
  __syncthreads();
}

DI void gla_cumsum(const Params& p, float* Bs, float* tot, float* gas, int head, int chunk, int tid_in) {
  const float* GA = (const float*)(p.ws + WS_GA); const float* wup = p.in[3]; const float* ba = p.in[4];
  const int tid = tid_in, d = tid & 127, tg = tid >> 7;
  float w[16];
#pragma unroll
  for (int r = 0; r < 16; ++r) w[r] = wup[r * 512 + head * 128 + d];
  const float bias = ba[head * 128 + d];
  if (tid < 256) { const f32x4 gv = *(const f32x4*)(GA + (size_t)(chunk * 64 + (tid >> 2)) * 16 + (tid & 3) * 4); *(f32x4*)(gas + (tid >> 2) * 16 + (tid & 3) * 4) = gv; }
  __syncthreads();
  float run = 0.f;
#pragma unroll 4
  for (int tt = 0; tt < 16; ++tt) {
    const f32x4* gp = (const f32x4*)(gas + (tg * 16 + tt) * 16);
    const f32x4 g0 = gp[0], g1 = gp[1], g2 = gp[2], g3 = gp[3];
    float xx = bias;
    xx += g0[0] * w[0] + g0[1] * w[1] + g0[2] * w[2] + g0[3] * w[3];
    xx += g1[0] * w[4] + g1[1] * w[5] + g1[2] * w[6] + g1[3] * w[7];
    xx += g2[0] * w[8] + g2[1] * w[9] + g2[2] * w[10] + g2[3] * w[11];
    xx += g3[0] * w[12] + g3[1] * w[13] + g3[2] * w[14] + g3[3] * w[15];
    const float ls = -(fmaxf(-xx, 0.f) + __logf(1.0f + __expf(-fabsf(xx))));
    run += ls * (1.0f / 16.0f);
    Bs[(tg * 16 + tt) * 129 + d] = run;
  }
  tot[tg * 128 + d] = run;
  __syncthreads();
  float pre = 0.f;
  for (int gq = 0; gq < tg; ++gq) pre += tot[gq * 128 + d];
  for (int tt = 0; tt < 16; ++tt) Bs[(tg * 16 + tt) * 129 + d] += pre;
  __syncthreads();
}

constexpr int GL_QB = 0, GL_KB = 17408, GL_VT = 34816, GL_B = 71680, GL_TOT = GL_B + 33024, GL_ST = 71680, GL_RED = 141312, GL_GA = 142336;

DI void gla_load_vt(const Params& p, unsigned char* lds, int head, int chunk, int tid) {
  const bf16_t* VT = (const bf16_t*)(p.ws + WS_VT);
#pragma unroll
  for (int i = 0; i < 4; ++i) {
    const int id = tid + NT * i, row = id >> 3, c = id & 7;
    const u32x4 v = *(const u32x4*)(VT + (size_t)(head * 256 + row) * SEQ + chunk * 64 + c * 8);
    *(u32x4*)(lds + GL_VT + row * 144 + c * 16) = v;
  }
}

__device__ __forceinline__ void gla_g1(const Params& p, const int g_wave64) {
  extern __shared__ __attribute__((aligned(16))) unsigned char lds[];
  const bf16_t* PROJ = (const bf16_t*)(p.ws + WS_PROJ);
  float* UT = p.out; float* GDEC = (float*)(p.ws + WS_GDEC);
  OPAQUE_TID(tid); const int lane = tid & 63, wave = tid >> 6, r = lane & 31, h = lane >> 5;
  float* Bs = (float*)(lds + GL_B); float* tot = (float*)(lds + GL_TOT);
  for (int u = blockIdx.x; u < 1024; u += gridDim.x) {
    const int head = u >> 8, chunk = u & 255;
    __syncthreads();
    bf16_t kraw[16];
    {
      const int d = tid & 127, tg = tid >> 7;
#pragma unroll
      for (int tt = 0; tt < 16; ++tt) kraw[tt] = PROJ[(size_t)(chunk * 64 + tg * 16 + tt) * 4096 + 512 + head * 128 + d];
    }
    gla_load_vt(p, lds, head, chunk, tid);
    gla_cumsum(p, Bs, tot, (float*)(lds + GL_GA), head, chunk, tid);
    {
      const int d = tid & 127, tg = tid >> 7;
      const float bl = Bs[63 * 129 + d];
      float kv[16];
#pragma unroll
      for (int tt = 0; tt < 16; ++tt) {
        const int tl = tg * 16 + tt;
        const float kk = bf2f(kraw[tt]);
        kv[tt] = kk * __expf(bl - Bs[tl * 129 + d]);
      }
      u32x4 w0 = {pk_bf16(kv[0], kv[1]), pk_bf16(kv[2], kv[3]), pk_bf16(kv[4], kv[5]), pk_bf16(kv[6], kv[7])};
      u32x4 w1 = {pk_bf16(kv[8], kv[9]), pk_bf16(kv[10], kv[11]), pk_bf16(kv[12], kv[13]), pk_bf16(kv[14], kv[15])};
      *(u32x4*)(lds + GL_QB + d * 144 + tg * 32) = w0;
      *(u32x4*)(lds + GL_QB + d * 144 + tg * 32 + 16) = w1;
      if (tid < 128) GDEC[(size_t)u * 128 + d] = __expf(bl);
    }
    __syncthreads();
    f32x16 acc[4];
#pragma unroll
    for (int nb = 0; nb < 4; ++nb)
#pragma unroll
      for (int i = 0; i < 16; ++i) acc[nb][i] = 0.f;
#pragma unroll
    for (int s = 0; s < 4; ++s) {
      const bf16x8 a = *(const bf16x8*)(lds + GL_VT + (wave * 32 + r) * 144 + (16 * s + 8 * h) * 2);
#pragma unroll
      for (int nb = 0; nb < 4; ++nb) {
        const bf16x8 b = *(const bf16x8*)(lds + GL_QB + (nb * 32 + r) * 144 + (16 * s + 8 * h) * 2);
        acc[nb] = mfma32(a, b, acc[nb]);
      }
    }
    bf16_t* up = (bf16_t*)UT + (size_t)u * 32768;
#pragma unroll
    for (int nb = 0; nb < 4; ++nb)
#pragma unroll
      for (int gi = 0; gi < 16; ++gi) {
        const int e = wave * 32 + (gi & 3) + 8 * (gi >> 2) + 4 * h;
        up[e * 128 + nb * 32 + r] = (bf16_t)(pk_bf16(acc[nb][gi], 0.f) & 0xffffu);
      }
  }
  __syncthreads();
}

__device__ __forceinline__ void gla_g2(const Params& p, const int g_wave64) {
  const bf16_t* UB = (const bf16_t*)p.out; bf16_t* SB = (bf16_t*)p.out + (size_t)1024 * 32768; const float* GDEC = (const float*)(p.ws + WS_GDEC);
  OPAQUE_TID(tid);
  for (int el = blockIdx.x * NT + tid; el < 4 * 32768; el += gridDim.x * NT) {
    const int head = el >> 15, ed = el & 32767, d = ed & 127;
    const bf16_t* up = UB + (size_t)head * 256 * 32768 + ed;
    bf16_t* sp = SB + (size_t)head * 256 * 32768 + ed;
    const float* gp = GDEC + (size_t)head * 256 * 128 + d;
    float st = 0.f;
    for (int c0 = 0; c0 < 256; c0 += 32) {
      float uu[32], gg[32];
#pragma unroll
      for (int i = 0; i < 32; ++i) { uu[i] = bf2f(up[(size_t)(c0 + i) * 32768]); gg[i] = gp[(c0 + i) * 128]; }
#pragma unroll
      for (int i = 0; i < 32; ++i) { sp[(size_t)(c0 + i) * 32768] = (bf16_t)(pk_bf16(st, 0.f) & 0xffffu); st = gg[i] * st + uu[i]; }
    }
  }
}

__device__ __forceinline__ void gla_g3(const Params& p, const int g_wave64) {
  extern __shared__ __attribute__((aligned(16))) unsigned char lds[];
  const bf16_t* PROJ = (const bf16_t*)(p.ws + WS_PROJ);
  const float* ST = p.out; bf16_t* O = (bf16_t*)(p.ws + WS_O); const float* gnorm = p.in[5];
  OPAQUE_TID(tid); const int lane = tid & 63, wave = tid >> 6, r = lane & 31, h = lane >> 5;
  const int ib = wave & 1, eq = wave >> 1;
  float* Bs = (float*)(lds + GL_B); float* tot = (float*)(lds + GL_TOT); float* red = (float*)(lds + GL_RED);
  for (int u = blockIdx.x; u < 1024; u += gridDim.x) {
    const int head = u >> 8, chunk = u & 255;
    __syncthreads();
    u32x4 stv[8];
    {
      const bf16_t* sp = (const bf16_t*)ST + (size_t)1024 * 32768 + (size_t)u * 32768;
#pragma unroll
      for (int i = 0; i < 8; ++i) { const int id = tid + NT * i, e = id >> 4, c8 = id & 15; stv[i] = *(const u32x4*)(sp + e * 128 + c8 * 8); }
    }
    bf16_t qraw[16], kraw[16];
    {
      const int d = tid & 127, tg = tid >> 7;
#pragma unroll
      for (int tt = 0; tt < 16; ++tt) { const size_t ro = (size_t)(chunk * 64 + tg * 16 + tt) * 4096 + head * 128 + d; qraw[tt] = PROJ[ro]; kraw[tt] = PROJ[ro + 512]; }
    }
    gla_load_vt(p, lds, head, chunk, tid);
    gla_cumsum(p, Bs, tot, (float*)(lds + GL_GA), head, chunk, tid);
    {
      const int d = tid & 127, tg = tid >> 7;
#pragma unroll
      for (int tt = 0; tt < 16; ++tt) {
        const int tl = tg * 16 + tt;
        const float bb = Bs[tl * 129 + d];
        const float qq = bf2f(qraw[tt]) * 0.08838834764831845f * __expf(bb);
        const float kk = bf2f(kraw[tt]) * __expf(-bb);
        *(bf16_t*)(lds + GL_QB + tl * 272 + d * 2) = (bf16_t)(pk_bf16(qq, 0.f) & 0xffff);
        *(bf16_t*)(lds + GL_KB + tl * 272 + d * 2) = (bf16_t)(pk_bf16(kk, 0.f) & 0xffff);
      }
    }
    __syncthreads();
    {
#pragma unroll
      for (int i = 0; i < 8; ++i) { const int id = tid + NT * i, e = id >> 4, c8 = id & 15; *(u32x4*)(lds + GL_ST + e * 272 + c8 * 16) = stv[i]; }
    }
    __syncthreads();
    bf16x8 qf[8];
#pragma unroll
    for (int s = 0; s < 8; ++s) qf[s] = *(const bf16x8*)(lds + GL_QB + (ib * 32 + r) * 272 + (16 * s + 8 * h) * 2);
    f32x16 X[2];
#pragma unroll
    for (int jb = 0; jb < 2; ++jb) {
#pragma unroll
      for (int i = 0; i < 16; ++i) X[jb][i] = 0.f;
      if (jb <= ib) {
        const int jrow = jb * 32 + perm23(r);
#pragma unroll
        for (int s = 0; s < 8; ++s) {
          const bf16x8 a = *(const bf16x8*)(lds + GL_KB + jrow * 272 + (16 * s + 8 * h) * 2);
          X[jb] = mfma32(a, qf[s], X[jb]);
        }
        if (jb == ib) {
#pragma unroll
          for (int gi = 0; gi < 16; ++gi) {
            const int jj = (gi & 3) + 4 * ((gi >> 2) & 1) + 8 * h + 16 * ((gi >> 3) & 1);
            if (jj > r) X[jb][gi] = 0.f;
          }
        }
      }
    }
    f32x16 acc[2];
#pragma unroll
    for (int eb = 0; eb < 2; ++eb)
#pragma unroll
      for (int i = 0; i < 16; ++i) acc[eb][i] = 0.f;
    const int e0 = eq * 64;
#pragma unroll
    for (int jb = 0; jb < 2; ++jb) {
      if (jb <= ib) {
#pragma unroll
        for (int s2 = 0; s2 < 2; ++s2) {
          const bf16x8 pf = pack8(X[jb][8 * s2 + 0], X[jb][8 * s2 + 1], X[jb][8 * s2 + 2], X[jb][8 * s2 + 3],
                                  X[jb][8 * s2 + 4], X[jb][8 * s2 + 5], X[jb][8 * s2 + 6], X[jb][8 * s2 + 7]);
#pragma unroll
          for (int eb = 0; eb < 2; ++eb) {
            const bf16x8 a = *(const bf16x8*)(lds + GL_VT + (e0 + eb * 32 + r) * 144 + (jb * 32 + 16 * s2 + 8 * h) * 2);
            acc[eb] = mfma32(a, pf, acc[eb]);
          }
        }
      }
    }
#pragma unroll
    for (int s = 0; s < 8; ++s)
#pragma unroll
      for (int eb = 0; eb < 2; ++eb) {
        const bf16x8 a = *(const bf16x8*)(lds + GL_ST + (e0 + eb * 32 + r) * 272 + (16 * s + 8 * h) * 2);
        acc[eb] = mfma32(a, qf[s], acc[eb]);
      }
    float ss = 0.f;
#pragma unroll
    for (int eb = 0; eb < 2; ++eb)
#pragma unroll
      for (int i = 0; i < 16; ++i) ss += acc[eb][i] * acc[eb][i];
    ss += shx(ss, 32, lane);
    if (h == 0) red[eq * 64 + ib * 32 + r] = ss;
    __syncthreads();
    const int il = ib * 32 + r;
    const float tsum = red[il] + red[64 + il] + red[128 + il] + red[192 + il];
    const float rstd = rsqrtf(tsum * (1.0f / 256.0f) + EPS);
    const int token = chunk * 64 + il;
#pragma unroll
    for (int eb = 0; eb < 2; ++eb)
#pragma unroll
      for (int g4 = 0; g4 < 4; ++g4) {
        const int eb0 = e0 + eb * 32 + 8 * g4 + 4 * h;
        const u32x2 gt = *(const u32x2*)(PROJ + (size_t)token * 4096 + 1024 + head * 256 + eb0);
        const f32x4 gn = *(const f32x4*)(gnorm + eb0);
        float gv[4] = {bflo(gt[0]), bfhi(gt[0]), bflo(gt[1]), bfhi(gt[1])};
        float y[4];
#pragma unroll
        for (int j = 0; j < 4; ++j) { const float sg = gv[j] * __builtin_amdgcn_rcpf(1.0f + __expf(-gv[j])); y[j] = acc[eb][g4 * 4 + j] * rstd * gn[j] * sg; }
        u32x2 w = {pk_bf16(y[0], y[1]), pk_bf16(y[2], y[3])};
        *(u32x2*)(O + (size_t)token * DM + head * 256 + eb0) = w;
      }
  }
  __syncthreads();
}

#define LDSADDR(p) ((unsigned)(unsigned long)(p))
DI void lds_rd128(bf16x8& dst, const unsigned addr) { asm volatile("ds_read_b128 %0, %1" : "=v"(dst) : "v"(addr)); }
DI void lgkm_wait(const int n, bf16x8& reg) {
  switch (n) {
    case 0: asm volatile("s_waitcnt lgkmcnt(0)" : "+v"(reg)); break;
    case 1: asm volatile("s_waitcnt lgkmcnt(1)" : "+v"(reg)); break;
    case 2: asm volatile("s_waitcnt lgkmcnt(2)" : "+v"(reg)); break;
    case 3: asm volatile("s_waitcnt lgkmcnt(3)" : "+v"(reg)); break;
    case 4: asm volatile("s_waitcnt lgkmcnt(4)" : "+v"(reg)); break;
    case 5: asm volatile("s_waitcnt lgkmcnt(5)" : "+v"(reg)); break;
    case 6: asm volatile("s_waitcnt lgkmcnt(6)" : "+v"(reg)); break;
    default: asm volatile("s_waitcnt lgkmcnt(7)" : "+v"(reg)); break;
  }
}
__device__ __forceinline__ void attn_finish(f32x16 (&o)[8], const float l, const Params& p, unsigned char* lds, const int tid, const int pr, const int comp, const int q0, const int head) {
  bf16_t* O = (bf16_t*)(p.ws + WS_O); const float* dnorm = p.in[10];
  {
      int t3 = tid; asm volatile("" : "+v"(t3));
      const float lt = l + __builtin_bit_cast(float, __builtin_amdgcn_ds_bpermute(((t3 & 63) ^ 32) << 2, __builtin_bit_cast(int, l)));
      float* ex = (float*)lds + (size_t)pr * 8192;
      const int lane_e = t3 & 63, h_e = lane_e >> 5, qrow_e = q0 + pr * 32 + (lane_e & 31);
      if (comp == 1) {
        float lam;
        {
          const float* q1 = p.in[6]; const float* k1 = p.in[7]; const float* q2 = p.in[8]; const float* k2 = p.in[9];
          float s1 = q1[lane_e] * k1[lane_e] + q1[lane_e + 64] * k1[lane_e + 64];
          float s2 = q2[lane_e] * k2[lane_e] + q2[lane_e + 64] * k2[lane_e + 64];
          s1 = wave_sum_l(s1, lane_e); s2 = wave_sum_l(s2, lane_e);
          lam = expf(s1) - expf(s2) + 0.2f;
        }
        const float sc = lam / lt;
#pragma unroll
        for (int dvb = 0; dvb < 8; ++dvb)
#pragma unroll
          for (int gi = 0; gi < 16; ++gi) ex[(dvb * 16 + gi) * 64 + lane_e] = o[dvb][gi] * sc;
      }
      __syncthreads();
      if (comp == 0) {
        const float sc = 1.0f / lt;
        float ss = 0.f;
#pragma unroll
        for (int dvb = 0; dvb < 8; ++dvb) {
#pragma unroll
          for (int gi = 0; gi < 16; ++gi) { const float dv = o[dvb][gi] * sc - ex[(dvb * 16 + gi) * 64 + lane_e]; o[dvb][gi] = dv; ss += dv * dv; }
          asm volatile("" : "+v"(o[dvb]), "+v"(ss) :: "memory");
        }
        ss += __builtin_bit_cast(float, __builtin_amdgcn_ds_bpermute((lane_e ^ 32) << 2, __builtin_bit_cast(int, ss)));
        const float rstd = rsqrtf(ss * (1.0f / 256.0f) + EPS) * 0.8f;
#pragma unroll
        for (int dvb = 0; dvb < 8; ++dvb)
#pragma unroll
          for (int g4 = 0; g4 < 4; ++g4) {
            const int dv0 = dvb * 32 + 8 * g4 + 4 * h_e;
            const f32x4 gn = *(const f32x4*)(dnorm + dv0);
            u32x2 w = {pk_bf16(o[dvb][g4 * 4 + 0] * rstd * gn[0], o[dvb][g4 * 4 + 1] * rstd * gn[1]),
                       pk_bf16(o[dvb][g4 * 4 + 2] * rstd * gn[2], o[dvb][g4 * 4 + 3] * rstd * gn[3])};
            *(u32x2*)(O + (size_t)qrow_e * DM + 1024 + head * 256 + dv0) = w;
          }
      }
      __syncthreads();
  }
}

__device__ __forceinline__ void attn_norms(const Params& p, const int g_wave64) {
  extern __shared__ __attribute__((aligned(16))) unsigned char lds[];
  const bf16_t* PROJ = (const bf16_t*)(p.ws + WS_PROJ); unsigned* NRM = (unsigned*)(p.ws + WS_NRM);
  OPAQUE_TID(tid); const int lane = tid & 63, wave = tid >> 6;
  float* red = (float*)lds;
  float mx0 = 0.f, mx1 = 0.f, mx2 = 0.f;
  for (int rb = blockIdx.x; rb < SEQ / 64; rb += gridDim.x) {
    const int row = rb * 64 + (tid >> 3), j = tid & 7;
    const bf16_t* qp = PROJ + (size_t)row * 4096 + 2048 + j * 128;
    const bf16_t* kp = qp + 1024;
    float qq = 0.f, kk = 0.f, qk = 0.f;
#pragma unroll
    for (int c = 0; c < 16; ++c) { const u32x4 v = *(const u32x4*)(qp + c * 8), w = *(const u32x4*)(kp + c * 8);
#pragma unroll
      for (int e = 0; e < 4; ++e) { const float a = bflo(v[e]), bb = bfhi(v[e]), c2 = bflo(w[e]), d2 = bfhi(w[e]); qq += a * a + bb * bb; kk += c2 * c2 + d2 * d2; qk += a * c2 + bb * d2; } }
    mx0 = fmaxf(mx0, qq); mx1 = fmaxf(mx1, kk); mx2 = fmaxf(mx2, -qk);
  }
  for (int o = 8; o < 64; o <<= 1) { mx0 = fmaxf(mx0, shx(mx0, o, lane)); mx1 = fmaxf(mx1, shx(mx1, o, lane)); mx2 = fmaxf(mx2, shx(mx2, o, lane)); }
  __syncthreads();
  if (lane < 8) { red[wave * 24 + lane] = mx0; red[wave * 24 + 8 + lane] = mx1; red[wave * 24 + 16 + lane] = mx2; }
  __syncthreads();
  if (tid < 24) { float mm = 0.f; for (int w = 0; w < 8; ++w) mm = fmaxf(mm, red[w * 24 + tid]); atomicMax(NRM + tid, __float_as_uint(mm)); }
  __syncthreads();
}
__device__ __forceinline__ void attn_plan(const Params& p, int (&dh)[4]) {
  unsigned* NRM = (unsigned*)(p.ws + WS_NRM);
#pragma unroll
  for (int hh = 0; hh < 4; ++hh) {
    float bound = 0.f;
#pragma unroll
    for (int c = 0; c < 2; ++c) {
      const float qn = __uint_as_float(__hip_atomic_load(NRM + hh * 2 + c, __ATOMIC_RELAXED, __HIP_MEMORY_SCOPE_AGENT));
      const float kn = __uint_as_float(__hip_atomic_load(NRM + 8 + hh * 2 + c, __ATOMIC_RELAXED, __HIP_MEMORY_SCOPE_AGENT));
      const float dg = __uint_as_float(__hip_atomic_load(NRM + 16 + hh * 2 + c, __ATOMIC_RELAXED, __HIP_MEMORY_SCOPE_AGENT));
      bound = fmaxf(bound, (sqrtf(qn * kn) + dg) * (0.08838834764831845f * LOG2E * 1.02f));
    }
    const float slope2 = exp2f(-2.0f * (float)(hh + 1)) * LOG2E;
    const float D = (bound + 152.0f) / slope2;
    dh[hh] = __builtin_amdgcn_readfirstlane((D < 1.0e9f) ? (int)D : 1000000000);
  }
}
__device__ __forceinline__ int attn_nsteps(const int head, const int qb, const int (&dh)[4]) {
  const int d = dh[0] * (head == 0) + dh[1] * (head == 1) + dh[2] * (head == 2) + dh[3] * (head == 3);
  int ttmin = (128 * qb - d) / 64 - 1; ttmin = ttmin < 0 ? 0 : ttmin;
  return 2 * qb + 2 - ttmin;
}
constexpr int ATT_TAB = 132096;
__device__ __forceinline__ void attn_build_plan(const Params& p, unsigned char* lds, const int tid) {
  int* tab = (int*)(lds + ATT_TAB);
  __syncthreads();
  int dh[4]; attn_plan(p, dh);
  if (tid < 256) {
    const int r = tid >> 5, j = tid & 31;
    int v = attn_nsteps(r >> 1, 127 - (r & 1) * 32 - j, dh) + attn_nsteps(r >> 1, (r & 1) * 32 + j, dh) + 2 * OVH;
    for (int o = 1; o < 32; o <<= 1) { const int w = __builtin_amdgcn_ds_bpermute(((tid & 63) ^ o) << 2, v); v = w > v ? w : v; }
    if (j == 0) tab[128 + r] = v;
  }
  __syncthreads();
  if (tid == 0) {
    const int xg = (int)blockIdx.x & 7, jq = (int)blockIdx.x >> 3;
    int R = 0;
#pragma unroll 1
    for (int r = 0; r < 8; ++r) R += tab[128 + r];
    const int Xa = (xg * R) / 8, Xb = ((xg + 1) * R) / 8;
    int P = 0; int first = 1;
#pragma unroll 1
    for (int r = 0; r < 8; ++r) {
      const int head = r >> 1, pg = r & 1, rlen = tab[128 + r];
      const int ra = (Xa > P ? Xa : P) - P, rb = (Xb < P + rlen ? Xb : P + rlen) - P;
      int off = 0;
#pragma unroll 1
      for (int part = 0; part < 2; ++part) {
        const int qb = part == 0 ? pg * 32 + jq : 127 - pg * 32 - jq;
        const int nst = attn_nsteps(head, qb, dh);
        int t_lo = ra - off, t_hi = rb - off;
        t_lo = t_lo < 0 ? 0 : t_lo; t_hi = t_hi > nst ? nst : t_hi;
        int* e = tab + (r * 2 + part) * 8;
        e[2] = nst; e[6] = qb;
        if (ra >= rb || t_lo >= t_hi) { e[0] = 0; e[1] = 0; e[3] = 0; e[4] = 0; e[5] = 0; }
        else {
          e[0] = t_lo; e[1] = t_hi; e[3] = 2 * (int)blockIdx.x + (first ? 0 : 1); first = 0;
          int cflag = 0, xend = xg;
          if (t_lo == 0 && t_hi < nst) {
            cflag = 1;
            for (int xx = xg + 1; xx < 8; ++xx) { if ((xx * R) / 8 - (P + off) >= nst) break; xend = xx; }
          }
          e[4] = cflag; e[5] = xend;
        }
        off += nst + OVH;
      }
      P += rlen;
    }
  }
  __syncthreads();
}
__device__ __forceinline__ void attn_phase(const Params& p, const int g_wave64) {
  extern __shared__ __attribute__((aligned(16))) unsigned char lds[];
  const bf16_t* PROJ = (const bf16_t*)(p.ws + WS_PROJ); const bf16_t* VT = (const bf16_t*)(p.ws + WS_VT);
  OPAQUE_TID(tid); const int lane = tid & 63, wave = __builtin_amdgcn_readfirstlane(tid >> 6), r = lane & 31, h = lane >> 5;
  const int comp = wave & 1, pr = wave >> 1;
  LAS unsigned char* L = (LAS unsigned char*)lds;
  const int pr_r = perm23(r);
  const unsigned kbase = (unsigned)pr_r * 256u, khs_c = (unsigned)((h ^ (pr_r & 15)) << 4);
  const unsigned vbase = (unsigned)r * 128u, vhs_c = (unsigned)((h ^ ((r >> 1) & 7)) << 4);
  const float C1 = 0.08838834764831845f * LOG2E;
  attn_build_plan(p, lds, tid);
  const int jq = (int)blockIdx.x >> 3;
#pragma unroll 1
  for (int rr = 0; rr < 16; ++rr) {
    const int* e = (const int*)(lds + ATT_TAB) + rr * 8;
    const int t_lo = __builtin_amdgcn_readfirstlane(e[0]), t_hi = __builtin_amdgcn_readfirstlane(e[1]), nst = __builtin_amdgcn_readfirstlane(e[2]), slot = __builtin_amdgcn_readfirstlane(e[3]);
    if (t_lo >= t_hi) continue;
    const int head = rr >> 2, qb = __builtin_amdgcn_readfirstlane(e[6]);
    const float slope2 = exp2f(-2.0f * (float)(head + 1)) * LOG2E;
    {
      const int q0 = qb * 128, ntiles = 2 * qb + 2;
      const int qrow = q0 + pr * 32 + r;
      bf16x8 qf[8];
      {
        int t4 = tid; asm volatile("" : "+v"(t4));
        const bf16_t* qp = PROJ + (size_t)(q0 + pr * 32 + (t4 & 31)) * 4096 + 2048 + head * 256 + comp * 128 + 8 * ((t4 >> 5) & 1);
#pragma unroll
        for (int s = 0; s < 8; ++s) {
          const u32x4 raw = *(const u32x4*)(qp + 16 * s);
          u32x4 sc;
#pragma unroll
          for (int j = 0; j < 4; ++j) sc[j] = pk_bf16(bflo(raw[j]) * C1, bfhi(raw[j]) * C1);
          qf[s] = __builtin_bit_cast(bf16x8, sc);
        }
      }
      f32x16 o[8];
#pragma unroll
      for (int dvb = 0; dvb < 8; ++dvb)
#pragma unroll
        for (int i = 0; i < 16; ++i) o[dvb][i] = 0.f;
      float m = -1e30f, l = 0.f;
#define ISSUE_TILE(T, BUF) do { int _t2 = tid; asm volatile("" : "+v"(_t2)); \
      const char* _kg = (const char*)PROJ + ((size_t)(T) * 64 * 4096 + 3072 + head * 256) * 2; \
      const char* _vg = (const char*)VT + ((size_t)(1024 + head * 256) * SEQ + (size_t)(T) * 64) * 2; \
      LAS unsigned char* _b = L + (BUF) * 65536 + wave * 1024; \
      _Pragma("unroll") for (int _i = 0; _i < 4; ++_i) { const int _slot = _t2 + NT * _i, _cmp = _slot >> 10, _sl = _slot & 1023, _row = _sl >> 4, _c = (_sl & 15) ^ (_row & 15); \
        __builtin_amdgcn_global_load_lds((const unsigned*)(_kg + (unsigned)((_row * 4096 + _cmp * 128 + _c * 8) * 2)), (LAS unsigned*)(_b + _i * 8192), 16, 0, 0); } \
      _Pragma("unroll") for (int _i = 0; _i < 4; ++_i) { const int _slot = _t2 + NT * _i, _row = _slot >> 3, _c = (_slot & 7) ^ ((_row >> 1) & 7); \
        __builtin_amdgcn_global_load_lds((const unsigned*)(_vg + (unsigned)((_row * SEQ + _c * 8) * 2)), (LAS unsigned*)(_b + 32768 + _i * 8192), 16, 0, 0); } } while (0)
#define ISSUE_PIECE(T, BUF, I) do { int _t2 = tid; asm volatile("" : "+v"(_t2)); LAS unsigned char* _b = L + (BUF) * 65536 + wave * 1024; \
      if ((I) < 4) { const int _slot = _t2 + NT * (I), _cmp = _slot >> 10, _sl = _slot & 1023, _row = _sl >> 4, _c = (_sl & 15) ^ (_row & 15); \
        const char* _kg = (const char*)PROJ + ((size_t)(T) * 64 * 4096 + 3072 + head * 256) * 2; \
        __builtin_amdgcn_global_load_lds((const unsigned*)(_kg + (unsigned)((_row * 4096 + _cmp * 128 + _c * 8) * 2)), (LAS unsigned*)(_b + (I) * 8192), 16, 0, 0); } \
      else { const int _slot = _t2 + NT * ((I) - 4), _row = _slot >> 3, _c = (_slot & 7) ^ ((_row >> 1) & 7); \
        const char* _vg = (const char*)VT + ((size_t)(1024 + head * 256) * SEQ + (size_t)(T) * 64) * 2; \
        __builtin_amdgcn_global_load_lds((const unsigned*)(_vg + (unsigned)((_row * SEQ + _c * 8) * 2)), (LAS unsigned*)(_b + 32768 + ((I) - 4) * 8192), 16, 0, 0); } } while (0)
      __syncthreads();
      ISSUE_TILE(ntiles - 1 - t_lo, 0);
      asm volatile("s_waitcnt vmcnt(0)" ::: "memory");
      __syncthreads();
      for (int t = t_lo; t < t_hi; ++t) {
        const int buf = (t - t_lo) & 1, tt = ntiles - 1 - t;
        const bool do_issue = (t + 1 < t_hi);
        const int k0 = tt * 64;
        const bool act = (k0 <= q0 + pr * 32 + 31);
        if (do_issue && !act) ISSUE_TILE(tt - 1, buf ^ 1);
        if (act) {
          LAS unsigned char* kb = L + (buf * 65536 + comp * 16384);
          LAS unsigned char* vb = L + (buf * 65536 + 32768);
#define KADDR(f) (kb + ((f) & 1) * 8192 + (kbase + ((unsigned)(((f) >> 1) * 32) ^ khs)))
#define VADDR(f) (vb + ((f) & 7) * 4096 + (vbase + ((unsigned)(((f) >> 3) * 32) ^ vhs)))
          unsigned khs = khs_c, vhs = vhs_c; asm volatile("" : "+v"(khs), "+v"(vhs));
          bf16x8 kf[KR];
#pragma unroll
          for (int f = 0; f < KR; ++f) lds_rd128(kf[f], LDSADDR(KADDR(f)));
          float sl2 = slope2; asm volatile("" : "+v"(sl2));
          const float mref = (m > -1e29f) ? m : 0.f;
          const float tb = sl2 * (float)(k0 + 8 * h - q0) - mref;
          f32x16 sa0, sa1;
          {
            const float s4x = sl2 * 4.0f, s16x = s4x * 4.0f, s32x = s16x + s16x;
            sa0[0] = tb; sa0[1] = tb + sl2; sa0[2] = sa0[1] + sl2; sa0[3] = sa0[2] + sl2;
#pragma unroll
            for (int gi = 0; gi < 4; ++gi) sa0[4 + gi] = sa0[gi] + s4x;
#pragma unroll
            for (int gi = 0; gi < 8; ++gi) sa0[8 + gi] = sa0[gi] + s16x;
#pragma unroll
            for (int gi = 0; gi < 16; ++gi) sa1[gi] = sa0[gi] + s32x;
          }
#pragma unroll
          for (int f = 0; f < 16; ++f) {
            lgkm_wait((15 - f) < (KR - 1) ? (15 - f) : (KR - 1), kf[f % KR]);
            if (f & 1) sa1 = mfma32(kf[f % KR], qf[f >> 1], sa1); else sa0 = mfma32(kf[f % KR], qf[f >> 1], sa0);
            if (f + KR < 16) lds_rd128(kf[f % KR], LDSADDR(KADDR(f + KR)));
            __builtin_amdgcn_sched_barrier(0);
          }
          bf16x8 vf[VR];
#pragma unroll
          for (int f = 0; f < VR; ++f) lds_rd128(vf[f], LDSADDR(VADDR(f)));
          __builtin_amdgcn_sched_barrier(0);
          if (do_issue) { ISSUE_PIECE(tt - 1, buf ^ 1, 0); ISSUE_PIECE(tt - 1, buf ^ 1, 1); ISSUE_PIECE(tt - 1, buf ^ 1, 2); ISSUE_PIECE(tt - 1, buf ^ 1, 3); }
          __builtin_amdgcn_sched_barrier(0);
          if (k0 + 63 > q0 + pr * 32) {
#pragma unroll
            for (int gi = 0; gi < 16; ++gi) {
              const int koff = (gi & 3) + 4 * ((gi >> 2) & 1) + 16 * ((gi >> 3) & 1);
              if (k0 + koff + 8 * h > qrow) sa0[gi] = -1e30f;
              if (k0 + koff + 32 + 8 * h > qrow) sa1[gi] = -1e30f;
            }
          }
          float mloc = fmaxf(sa0[0], sa1[0]);
#pragma unroll
          for (int gi = 1; gi < 16; ++gi) mloc = fmaxf(mloc, fmaxf(sa0[gi], sa1[gi]));
          mloc = fmaxf(mloc, shx(mloc, 32, lane));
          const float mrel = m - mref;
          const float delta = fmaxf(mrel, mloc);
          if (__ballot(delta > mrel) != 0ull) {
            const float alpha = __builtin_amdgcn_exp2f(mrel - delta);
            l *= alpha;
#pragma unroll
            for (int dvb = 0; dvb < 8; ++dvb) o[dvb] = o[dvb] * alpha;
#pragma unroll
            for (int gi = 0; gi < 16; ++gi) { sa0[gi] -= delta; sa1[gi] -= delta; }
          }
          m = mref + delta;
          float ps = 0.f;
#pragma unroll
          for (int gi = 0; gi < 16; ++gi) {
            const float p0 = __builtin_amdgcn_exp2f(sa0[gi]), p1 = __builtin_amdgcn_exp2f(sa1[gi]);
            sa0[gi] = p0; sa1[gi] = p1; ps += p0 + p1;
          }
          l += ps;
          __builtin_amdgcn_sched_barrier(0);
          if (do_issue) { ISSUE_PIECE(tt - 1, buf ^ 1, 4); ISSUE_PIECE(tt - 1, buf ^ 1, 5); ISSUE_PIECE(tt - 1, buf ^ 1, 6); ISSUE_PIECE(tt - 1, buf ^ 1, 7); }
          __builtin_amdgcn_sched_barrier(0);
          bf16x8 pf[4];
          pf[0] = pack8(sa0[0], sa0[1], sa0[2], sa0[3], sa0[4], sa0[5], sa0[6], sa0[7]);
          pf[1] = pack8(sa0[8], sa0[9], sa0[10], sa0[11], sa0[12], sa0[13], sa0[14], sa0[15]);
          pf[2] = pack8(sa1[0], sa1[1], sa1[2], sa1[3], sa1[4], sa1[5], sa1[6], sa1[7]);
          pf[3] = pack8(sa1[8], sa1[9], sa1[10], sa1[11], sa1[12], sa1[13], sa1[14], sa1[15]);
          __builtin_amdgcn_sched_barrier(0);
#pragma unroll
          for (int f = 0; f < 32; ++f) {
            lgkm_wait((31 - f) < (VR - 1) ? (31 - f) : (VR - 1), vf[f % VR]);
            o[f & 7] = mfma32(vf[f % VR], pf[f >> 3], o[f & 7]);
            if (f + VR < 32) lds_rd128(vf[f % VR], LDSADDR(VADDR(f + VR)));
            __builtin_amdgcn_sched_barrier(0);
          }
#undef KADDR
#undef VADDR
        }
        asm volatile("s_waitcnt vmcnt(0)" ::: "memory");
        __syncthreads();
      }
#undef ISSUE_TILE
#undef ISSUE_PIECE
      if (t_lo == 0 && t_hi == nst) {
        attn_finish(o, l, p, lds, tid, pr, comp, q0, head);
      } else {
        int t5 = tid; asm volatile("" : "+v"(t5));
        float* ps = part_slot(p, slot) + wave * 8192 + (t5 & 63);
#pragma unroll
        for (int dvb = 0; dvb < 8; ++dvb)
#pragma unroll
          for (int gi = 0; gi < 16; ++gi) ps[(dvb * 16 + gi) * 64] = o[dvb][gi];
        float* ml = (float*)(p.ws + WS_ML) + ((size_t)slot * 8 + wave) * 128 + (t5 & 63);
        ml[0] = m; ml[64] = l;
      }
    }
  }
  __syncthreads();
}

__device__ __forceinline__ void attn_combine(const Params& p, const int g_wave64) {
  extern __shared__ __attribute__((aligned(16))) unsigned char lds[];
  OPAQUE_TID(tid); const int lane = tid & 63, wave = __builtin_amdgcn_readfirstlane(tid >> 6);
  const int comp = wave & 1, pr = wave >> 1;
  __syncthreads();
  const int xg = (int)blockIdx.x & 7, jq = (int)blockIdx.x >> 3;
#pragma unroll 1
  for (int rr = 0; rr < 16; ++rr) {
    const int* e = (const int*)(lds + ATT_TAB) + rr * 8;
    const int cflag = __builtin_amdgcn_readfirstlane(e[4]), xend = __builtin_amdgcn_readfirstlane(e[5]), slot0 = __builtin_amdgcn_readfirstlane(e[3]);
    if (!cflag) continue;
    const int head = rr >> 2, qb = __builtin_amdgcn_readfirstlane(e[6]);
    f32x16 o[8]; float m, l;
    {
      const int slot = slot0;
      const float* ps = part_slot(p, slot) + wave * 8192 + lane;
#pragma unroll
      for (int dvb = 0; dvb < 8; ++dvb)
#pragma unroll
        for (int gi = 0; gi < 16; ++gi) o[dvb][gi] = ps[(dvb * 16 + gi) * 64];
      const float* ml = (const float*)(p.ws + WS_ML) + ((size_t)slot * 8 + wave) * 128 + lane;
      m = ml[0]; l = ml[64];
    }
    for (int xx = xg + 1; xx <= xend; ++xx) {
      const int slot = 2 * (jq * 8 + xx);
      const float* ml = (const float*)(p.ws + WS_ML) + ((size_t)slot * 8 + wave) * 128 + lane;
      const float ms = ml[0], ls = ml[64];
      const float mn = fmaxf(m, ms);
      const float a0 = __builtin_amdgcn_exp2f(m - mn), a1 = __builtin_amdgcn_exp2f(ms - mn);
      const float* ps = part_slot(p, slot) + wave * 8192 + lane;
#pragma unroll
      for (int dvb = 0; dvb < 8; ++dvb) {
#pragma unroll
        for (int gi = 0; gi < 16; ++gi) o[dvb][gi] = o[dvb][gi] * a0 + ps[(dvb * 16 + gi) * 64] * a1;
        asm volatile("" : "+v"(o[dvb]) :: "memory");
      }
      l = l * a0 + ls * a1; m = mn;
    }
    attn_finish(o, l, p, lds, tid, pr, comp, qb * 128, head);
  }
  __syncthreads();
}

__device__ __forceinline__ void p6_post_attn(const Params& p, const int g_wave64) {
  const float* x = p.in[0]; const float* gp = p.in[12]; const float* gf = p.in[13];
  const bf16_t* Mb = (const bf16_t*)(p.ws + WS_M); bf16_t* H = (bf16_t*)(p.ws + WS_H);
  OPAQUE_TID(tid); const int lane = tid & 63, wave = tid >> 6;
  for (int row = blockIdx.x * 8 + wave; row < SEQ; row += gridDim.x * 8) {
    f32x4 mv[8];
    float s = 0.f;
#pragma unroll
    for (int ii = 0; ii < 8; ++ii) { const u32x2 rw = *(const u32x2*)(Mb + (size_t)row * DM + ii * 256 + lane * 4); mv[ii] = (f32x4){bflo(rw[0]), bfhi(rw[0]), bflo(rw[1]), bfhi(rw[1])}; s += mv[ii][0] * mv[ii][0] + mv[ii][1] * mv[ii][1] + mv[ii][2] * mv[ii][2] + mv[ii][3] * mv[ii][3]; }
    s = wave_sum_l(s, lane);
    const float rs = rsqrtf(s * (1.0f / DM) + EPS);
    float s2 = 0.f;
#pragma unroll
    for (int ii = 0; ii < 8; ++ii) {
      const f32x4 xv = *(const f32x4*)(x + (size_t)row * DM + ii * 256 + lane * 4);
      const f32x4 g = *(const f32x4*)(gp + ii * 256 + lane * 4);
      mv[ii] = xv + mv[ii] * rs * g;
      s2 += mv[ii][0] * mv[ii][0] + mv[ii][1] * mv[ii][1] + mv[ii][2] * mv[ii][2] + mv[ii][3] * mv[ii][3];
    }
    s2 = wave_sum_l(s2, lane);
    const float rs2 = rsqrtf(s2 * (1.0f / DM) + EPS);
#pragma unroll
    for (int ii = 0; ii < 8; ++ii) {
      const f32x4 g = *(const f32x4*)(gf + ii * 256 + lane * 4);
      const f32x4 hv = mv[ii] * rs2 * g;
      u32x2 w = {pk_bf16(hv[0], hv[1]), pk_bf16(hv[2], hv[3])};
      *(u32x2*)(H + (size_t)row * DM + ii * 256 + lane * 4) = w;
    }
  }
}

__device__ __forceinline__ void p10_final(const Params& p, const int g_wave64) {
  const float* x = p.in[0]; const float* gm = p.in[12]; const float* gp = p.in[18];
  const bf16_t* Mb = (const bf16_t*)(p.ws + WS_M); const bf16_t* F = (const bf16_t*)(p.ws + WS_F); float* out = p.out;
  OPAQUE_TID(tid); const int lane = tid & 63, wave = tid >> 6;
  for (int row = blockIdx.x * 8 + wave; row < SEQ; row += gridDim.x * 8) {
    f32x4 mv[8], fv[8];
    float s = 0.f, sm = 0.f;
#pragma unroll
    for (int ii = 0; ii < 8; ++ii) {
      const u32x2 rw = *(const u32x2*)(F + (size_t)row * DM + ii * 256 + lane * 4); fv[ii] = (f32x4){bflo(rw[0]), bfhi(rw[0]), bflo(rw[1]), bfhi(rw[1])};
      const u32x2 rm = *(const u32x2*)(Mb + (size_t)row * DM + ii * 256 + lane * 4); mv[ii] = (f32x4){bflo(rm[0]), bfhi(rm[0]), bflo(rm[1]), bfhi(rm[1])};
      s += fv[ii][0] * fv[ii][0] + fv[ii][1] * fv[ii][1] + fv[ii][2] * fv[ii][2] + fv[ii][3] * fv[ii][3];
      sm += mv[ii][0] * mv[ii][0] + mv[ii][1] * mv[ii][1] + mv[ii][2] * mv[ii][2] + mv[ii][3] * mv[ii][3];
    }
    s = wave_sum_l(s, lane); sm = wave_sum_l(sm, lane);
    const float rs = rsqrtf(s * (1.0f / DM) + EPS), rsm = rsqrtf(sm * (1.0f / DM) + EPS);
#pragma unroll
    for (int ii = 0; ii < 8; ++ii) {
      const f32x4 xv = *(const f32x4*)(x + (size_t)row * DM + ii * 256 + lane * 4);
      const f32x4 g1 = *(const f32x4*)(gm + ii * 256 + lane * 4);
      const f32x4 g = *(const f32x4*)(gp + ii * 256 + lane * 4);
      *(f32x4*)(out + (size_t)row * DM + ii * 256 + lane * 4) = (xv + mv[ii] * rsm * g1) + fv[ii] * rs * g;
    }
  }
}
__device__ __forceinline__ void p8_fixup(const Params& p, const int g_wave64) {
  const float* SA0 = (const float*)(p.ws + WS_SA0); const float* SB0 = (const float*)(p.ws + WS_SB0); const float* SAL = (const float*)(p.ws + WS_SAL);
  bf16_t* G = (bf16_t*)(p.ws + WS_BUP); const float* cw = p.in[15]; const float* cb = p.in[16];
  OPAQUE_TID(tid);
  constexpr int nM = SEQ / 256, nN = DM / 256, nwg = nM * nN;
  int pmprev = -1;
  for (int L = (int)blockIdx.x; L < nwg; L += (int)gridDim.x) {
    int w = L; { const int q = nwg / NXCD, r = nwg % NXCD, x = w % NXCD, o = w / NXCD; w = (x < r ? x * (q + 1) : r * (q + 1) + (x - r) * q) + o; }
    const int nig = WGM * nN, gid = w / nig, fm = gid * WGM, gsz = min(nM - fm, WGM);
    const int pm = fm + ((w % nig) % gsz);
    if (pm == pmprev) continue;
    pmprev = pm;
    float a0v[11], a1v[11], b0v[11], b1v[11], l0v[11], l1v[11], w0v[11], w1v[11], w2v[11], cbv[11];
#pragma unroll
    for (int i = 0; i < 11; ++i) {
      const int c = tid + NT * i;
      a0v[i] = SA0[(size_t)(pm * 2) * DFF + c]; a1v[i] = SA0[(size_t)(pm * 2 + 1) * DFF + c];
      b0v[i] = SB0[(size_t)(pm * 2) * DFF + c]; b1v[i] = SB0[(size_t)(pm * 2 + 1) * DFF + c];
      l0v[i] = pm > 0 ? SAL[((size_t)(pm - 1) * 2 + 0) * DFF + c] : 0.f; l1v[i] = pm > 0 ? SAL[((size_t)(pm - 1) * 2 + 1) * DFF + c] : 0.f;
      w0v[i] = cw[c]; w1v[i] = cw[DFF + c]; w2v[i] = cw[2 * DFF + c]; cbv[i] = cb[c];
    }
#pragma unroll
    for (int i = 0; i < 11; ++i) {
      const int c = tid + NT * i;
      const float y0 = w0v[i] * l0v[i] + w1v[i] * l1v[i] + w2v[i] * a0v[i] + cbv[i];
      const float y1 = w0v[i] * l1v[i] + w1v[i] * a0v[i] + w2v[i] * a1v[i] + cbv[i];
      const float e0 = __builtin_amdgcn_exp2f(-2.302208198f * (y0 + 0.044715f * y0 * y0 * y0));
      const float e1 = __builtin_amdgcn_exp2f(-2.302208198f * (y1 + 0.044715f * y1 * y1 * y1));
      const float g0 = y0 * __builtin_amdgcn_rcpf(1.0f + e0) * b0v[i], g1 = y1 * __builtin_amdgcn_rcpf(1.0f + e1) * b1v[i];
      G[(size_t)(pm * 256) * DFF + c] = (bf16_t)(pk_bf16(g0, 0.f) & 0xffffu);
      G[(size_t)(pm * 256 + 1) * DFF + c] = (bf16_t)(pk_bf16(g1, 0.f) & 0xffffu);
    }
  }
  asm volatile("s_waitcnt vmcnt(0)" ::: "memory");
  __syncthreads();
}

__device__ __forceinline__ void p8_conv_glu(const Params& p, const int g_wave64) {
  const bf16_t* Aup = (const bf16_t*)(p.ws + WS_AUP); bf16_t* Bup = (bf16_t*)(p.ws + WS_BUP);
  const float* cw = p.in[15]; const float* cb = p.in[16];
  constexpr int NCG = DFF / 8, RUN = 32, NRUN = SEQ / RUN;
  OPAQUE_TID(tid);
  for (int item = blockIdx.x * NT + tid; item < NCG * NRUN; item += gridDim.x * NT) {
    const int cgi = item % NCG, run = item / NCG, c0 = cgi * 8, t0 = run * RUN;
    float w0[8], w1[8], w2[8], bb[8], am2[8], am1[8];
#pragma unroll
    for (int j = 0; j < 8; ++j) { w0[j] = cw[c0 + j]; w1[j] = cw[DFF + c0 + j]; w2[j] = cw[2 * DFF + c0 + j]; bb[j] = cb[c0 + j]; am2[j] = 0.f; am1[j] = 0.f; }
    if (t0 >= 2) {
      const u32x4 v2 = *(const u32x4*)(Aup + (size_t)(t0 - 2) * DFF + c0), v1 = *(const u32x4*)(Aup + (size_t)(t0 - 1) * DFF + c0);
#pragma unroll
      for (int j = 0; j < 4; ++j) { am2[2 * j] = bflo(v2[j]); am2[2 * j + 1] = bfhi(v2[j]); am1[2 * j] = bflo(v1[j]); am1[2 * j + 1] = bfhi(v1[j]); }
    }
    for (int t = t0; t < t0 + RUN; ++t) {
      const u32x4 va = *(const u32x4*)(Aup + (size_t)t * DFF + c0);
      const u32x4 vb = *(const u32x4*)(Bup + (size_t)t * DFF + c0);
      float ac[8], bv[8], y[8];
#pragma unroll
      for (int j = 0; j < 4; ++j) { ac[2 * j] = bflo(va[j]); ac[2 * j + 1] = bfhi(va[j]); bv[2 * j] = bflo(vb[j]); bv[2 * j + 1] = bfhi(vb[j]); }
#pragma unroll
      for (int j = 0; j < 8; ++j) {
        const float a = w0[j] * am2[j] + w1[j] * am1[j] + w2[j] * ac[j] + bb[j];
        const float uu = 0.7978845608028654f * (a + 0.044715f * a * a * a);
        const float th = 1.0f - 2.0f / (1.0f + __expf(2.0f * uu));
        y[j] = 0.5f * a * (1.0f + th) * bv[j];
        am2[j] = am1[j]; am1[j] = ac[j];
      }
      u32x4 w = {pk_bf16(y[0], y[1]), pk_bf16(y[2], y[3]), pk_bf16(y[4], y[5]), pk_bf16(y[6], y[7])};
      *(u32x4*)(Bup + (size_t)t * DFF + c0) = w;
    }
  }
}


#define XB_TMO      128
#define XB_XCNT(j)  (256  + 64 * (j))
#define XB_XSUB(j)  (1280 + 64 * (j))
#define XB_XGEN(j)  (2304 + 64 * (j))
#define XB_TOP      3328
#define XB_TOPGEN   3392
#define XCD_BAR_WORDS 3456
#define XB_SPIN_CAP (1u << 18)
DI unsigned xb_ld(unsigned* p) { return __hip_atomic_load(p, __ATOMIC_RELAXED, __HIP_MEMORY_SCOPE_AGENT); }
DI unsigned xb_add(unsigned* p, unsigned v) { return __hip_atomic_fetch_add(p, v, __ATOMIC_RELAXED, __HIP_MEMORY_SCOPE_AGENT); }
DI unsigned xb_xcc_id() { return (unsigned)__builtin_amdgcn_s_getreg((3 << 11) | 20) & 0xFu; }
#define XB_SPIN(cond, bar) do { unsigned _sp = 0; while (cond) { __builtin_amdgcn_s_sleep(1); \
    if ((++_sp & 255u) == 0u) { if (xb_ld(&(bar)[XB_TMO])) break; if (_sp > XB_SPIN_CAP) { atomicAdd(&(bar)[XB_TMO], 1u); break; } } } } while (0)
DI void xcd_barrier_complete(unsigned* bar, unsigned x, unsigned& nloc, unsigned& nx) {
  const unsigned G = gridDim.x;
  unsigned sum, cnt, mine, sp = 0u;
  for (;;) {
    sum = 0u; cnt = 0u; mine = 0u;
#pragma unroll
    for (unsigned j = 0; j < 16; ++j) { const unsigned c = xb_ld(&bar[XB_XCNT(j)]); sum += c; cnt += (c > 0u) ? 1u : 0u; mine = (j == x) ? c : mine; }
    if (sum == G) break;
    __builtin_amdgcn_s_sleep(1);
    if ((++sp & 255u) == 0u) { if (xb_ld(&bar[XB_TMO])) break; if (sp > XB_SPIN_CAP) { atomicAdd(&bar[XB_TMO], 1u); break; } }
  }
  nloc = mine > 0u ? mine : 1u; nx = cnt > 0u ? cnt : 1u;
}
__device__ __forceinline__ void xcd_barrier(unsigned* bar, volatile LAS unsigned* st) {
  asm volatile("s_waitcnt vmcnt(0)" ::: "memory");
  __syncthreads();
  if (threadIdx.x == 0) {
    const unsigned x = xb_xcc_id();
    __builtin_amdgcn_s_waitcnt(0);
    unsigned nloc = st[0], nx = st[1];
    if (nloc == 0u) { xcd_barrier_complete(bar, x, nloc, nx); st[0] = nloc; st[1] = nx; }
    const unsigned old = xb_add(&bar[XB_XSUB(x)], 1u);
    const unsigned gen = old / nloc;
    if (old + 1u == (gen + 1u) * nloc) {
      __builtin_amdgcn_fence(__ATOMIC_RELEASE, "agent");
      asm volatile("s_waitcnt vmcnt(0)" ::: "memory");
      const unsigned og = xb_add(&bar[XB_TOP], 1u);
      const unsigned tg = og / nx;
      if (og + 1u == (tg + 1u) * nx) xb_add(&bar[XB_TOPGEN], 1u);
      else XB_SPIN(xb_ld(&bar[XB_TOPGEN]) == tg, bar);
      __builtin_amdgcn_fence(__ATOMIC_ACQUIRE, "agent");
      xb_add(&bar[XB_XGEN(x)], 1u);
      asm volatile("s_waitcnt vmcnt(0)" ::: "memory");
    } else {
      XB_SPIN(xb_ld(&bar[XB_XGEN(x)]) == gen, bar);
      __builtin_amdgcn_fence(__ATOMIC_ACQUIRE, "agent");
      asm volatile("s_waitcnt vmcnt(0)" ::: "memory");
    }
  }
  __syncthreads();
}
__global__ void __launch_bounds__(NT, 2) mega(Params p) {
  cg::grid_group grid = cg::this_grid();
  extern __shared__ __attribute__((aligned(16))) unsigned char lds_all[];
  volatile LAS unsigned* xb_st = (volatile LAS unsigned*)((LAS unsigned char*)lds_all + (LDS_BYTES - 16));
  unsigned* xb_bar = (unsigned*)(p.ws + WS_BAR);
  if (threadIdx.x == 0) { xb_st[0] = 0u; xb_st[1] = 0u; (void)xb_add(&xb_bar[XB_XCNT(xb_xcc_id())], 1u); }
  __syncthreads();
  const int g_wave64 = __builtin_amdgcn_readfirstlane((int)threadIdx.x & ~63);
  unsigned char* ws = p.ws;
  bf16_t* H = (bf16_t*)(ws + WS_H);
#ifndef PH
#define PH -1
#endif
#define ON(k) (PH < 0 || PH == (k))
  if (ON(0)) { p0_norm_ga(p, g_wave64); }
  if (ON(1)) { p0_transposes(p, g_wave64); }
  if (p.ws == nullptr) grid.sync();
  xcd_barrier(xb_bar, xb_st);
  if (ON(2)) {
  gemm_phase<false, SEQ, 4096, DM, 4096, 1 << 20>(H, (const bf16_t*)(ws + WS_WIN), ws + WS_PROJ, ws + WS_PROJ, g_wave64);
  gemm_phase<false, 2048, SEQ, DM, SEQ, 1 << 20>((const bf16_t*)(ws + WS_WV), H, ws + WS_VT, ws + WS_VT, g_wave64);
  }
  xcd_barrier(xb_bar, xb_st);
  if (ON(3)) { attn_norms(p, g_wave64); gla_g1(p, g_wave64); }
  xcd_barrier(xb_bar, xb_st);
  if (ON(4)) gla_g2(p, g_wave64);
  xcd_barrier(xb_bar, xb_st);
  if (ON(5)) gla_g3(p, g_wave64);
  if (ON(6)) { attn_phase(p, g_wave64); xcd_barrier(xb_bar, xb_st); attn_combine(p, g_wave64); }
  xcd_barrier(xb_bar, xb_st);
  if (ON(7)) gemm_phase<false, SEQ, DM, DM, DM, 1 << 20>((const bf16_t*)(ws + WS_O), (const bf16_t*)(ws + WS_WO), ws + WS_M, ws + WS_M, g_wave64);
  xcd_barrier(xb_bar, xb_st);
  if (ON(8)) p6_post_attn(p, g_wave64);
  xcd_barrier(xb_bar, xb_st);
  if (ON(2)) gemm_phase<false, SEQ, 2 * DFF, DM, DFF, 1 << 20, 2>(H, (const bf16_t*)(ws + WS_WFI), ws + WS_BUP, ws + WS_BUP, g_wave64,
                                                                ConvEpi{p.in[15], p.in[16], (float*)(ws + WS_SA0), (float*)(ws + WS_SB0), (float*)(ws + WS_SAL)});
  xcd_barrier(xb_bar, xb_st);
  if (ON(9)) p8_fixup(p, g_wave64);
  if (ON(7)) gemm_phase<false, SEQ, DM, DFF, DM, 1 << 20>((const bf16_t*)(ws + WS_BUP), (const bf16_t*)(ws + WS_WFO), ws + WS_F, ws + WS_F, g_wave64);
  xcd_barrier(xb_bar, xb_st);
  if (ON(10)) p10_final(p, g_wave64);
}

extern "C" void kernel_launch(void* const* d_in, const int* in_sizes, int n_in, void* d_out, int out_size, void* d_ws, size_t ws_size,
                              hipStream_t stream) {
  static int grid_blocks = 0;
  if (!grid_blocks) {
    int dev = 0, cus = 0, per_cu = 0;
    hipGetDevice(&dev);
    hipDeviceGetAttribute(&cus, hipDeviceAttributeMultiprocessorCount, dev);
    hipFuncSetAttribute((const void*)mega, hipFuncAttributeMaxDynamicSharedMemorySize, LDS_BYTES);
    hipOccupancyMaxActiveBlocksPerMultiprocessor(&per_cu, (const void*)mega, NT, LDS_BYTES);
    (void)hipGetLastError();
    if (per_cu < 1) per_cu = 1;
    grid_blocks = 256;
    if (cus != 256) fprintf(stderr, "kernel_launch: built for 256 CUs, device reports %d\n", cus);
    if (ws_size < WS_END2) fprintf(stderr, "kernel_launch: workspace too small: %zu < %zu\n", ws_size, (size_t)WS_END);
  }
  Params p{};
  for (int i = 0; i < 19; ++i) p.in[i] = (const float*)d_in[i];
  p.out = (float*)d_out; p.ws = (unsigned char*)d_ws;
  (void)hipMemsetAsync((unsigned char*)d_ws + WS_BAR, 0, 16384 + 128, stream);
  void* args[] = {&p};
  hipError_t e = hipLaunchCooperativeKernel((const void*)mega, dim3(grid_blocks), dim3(NT), args, LDS_BYTES, stream);
  if (e != hipSuccess) fprintf(stderr, "cooperative launch failed: %s (grid %d)\n", hipGetErrorString(e), grid_blocks);
}
```
